# Optimizing an MI355X kernel written in HIP

```python
import jax
import jax.numpy as jnp
from jax import lax
import numpy as np

D_MODEL = 1024
BATCH = 8
SEQ = 2048
DEPTH = 2
DEC_BATCH = 128
DEC_SEQ = 4
PAST_LEN = 16384
PAGE_SIZE = 128

D_MIX = D_MODEL
HG_HEADS = 4
HG_DK = D_MIX // 16
HG_DV = D_MIX // 16
HG_WIDTH = HG_HEADS * HG_DV
HG_FDIM = HG_HEADS * HG_DK
GDN_HEADS = 4
GDN_DK = D_MIX // 8
GDN_DV = D_MIX // 8
GDN_WIDTH = GDN_HEADS * GDN_DV
GDN_QKV = 2 * GDN_HEADS * GDN_DK + GDN_WIDTH
LRU_WIDTH = D_MIX - HG_WIDTH - GDN_WIDTH
LRU_BLOCKS = 4
LRU_BLOCK = LRU_WIDTH // LRU_BLOCKS
LRU_C = 8.0
CONV_QKV = 4
CONV_LRU = 4
CONV_FFN = 3
D_FF = 128 * ((8 * D_MODEL // 3 + 127) // 128)
CHUNK = 64
EPS = 1e-6
IN_SPLITS = (HG_FDIM, HG_FDIM, HG_WIDTH, HG_WIDTH,
             GDN_QKV, GDN_WIDTH, GDN_HEADS, GDN_HEADS,
             LRU_WIDTH, LRU_WIDTH)
D_IN = sum(IN_SPLITS)

kernel_name = "hymba_style_hgrn2_gdn_rglru_convffn_step"


def _rmsnorm(x, g):
    xf = x.astype(jnp.float32)
    y = xf * lax.rsqrt(jnp.mean(xf * xf, axis=-1, keepdims=True) + EPS)
    return (y * g.astype(jnp.float32)).astype(x.dtype)


def _l2norm(x):
    return x * lax.rsqrt(jnp.sum(x * x, axis=-1, keepdims=True) + EPS)


def _causal_dwconv(x, prev, w):
    K = w.shape[0]
    T = x.shape[1]
    xp = jnp.concatenate([prev.astype(x.dtype), x], axis=1)
    y = xp[:, 0:T] * w[0]
    for j in range(1, K):
        y = y + xp[:, j:j + T] * w[j]
    return y, xp[:, T:]


def _to_chunks(a, C):
    T = a.shape[2]
    N = -(-T // C)
    a = jnp.pad(a, [(0, 0), (0, 0), (0, N * C - T)] + [(0, 0)] * (a.ndim - 3))
    a = a.reshape(a.shape[:2] + (N, C) + a.shape[3:])
    return jnp.moveaxis(a, 2, 0)


def _from_chunks(o, T):
    o = jnp.moveaxis(o, 0, 2)
    o = o.reshape(o.shape[:2] + (-1, o.shape[-1]))[:, :, :T]
    return jnp.swapaxes(o, 1, 2)


def _hgrn2(q, k, v, logf, S0):
    T = q.shape[1]
    C = min(CHUNK, T)
    xs = tuple(_to_chunks(jnp.swapaxes(a, 1, 2), C) for a in (q, k, v, logf))
    incl = jnp.tril(jnp.ones((C, C), bool))[:, :, None]

    def step(S, inp):
        qc, kc, vc, lc = inp
        G = jnp.cumsum(lc, axis=2)
        diff = G[:, :, :, None, :] - G[:, :, None, :, :]
        decay = jnp.where(incl, jnp.exp(jnp.where(incl, diff, 0.0)), 0.0)
        A = jnp.einsum('bhtsd,bhsd->bhts', qc[:, :, :, None, :] * decay, kc)
        o = (jnp.einsum('bhtd,bhde->bhte', qc * jnp.exp(G), S)
             + jnp.einsum('bhts,bhse->bhte', A, vc))
        Gl = G[:, :, -1]
        S = (S * jnp.exp(Gl)[..., None]
             + jnp.einsum('bhsd,bhse->bhde', kc * jnp.exp(Gl[:, :, None] - G), vc))
        return S, o

    S, o = lax.scan(step, S0, xs)
    return _from_chunks(o, T), S


def _gated_delta(q, k, v, g, beta, S0):
    T = q.shape[1]
    C = min(CHUNK, T)
    xs = tuple(_to_chunks(jnp.swapaxes(a, 1, 2), C) for a in (q, k, v, g, beta))
    incl = jnp.tril(jnp.ones((C, C), bool))
    strict = jnp.tril(jnp.ones((C, C), bool), -1)

    def step(S, inp):
        qc, kc, vc, gc, bc = inp
        gcum = jnp.cumsum(gc, axis=-1)
        diff = gcum[..., :, None] - gcum[..., None, :]
        decay = jnp.where(incl, jnp.exp(jnp.where(incl, diff, 0.0)), 0.0)
        kb = kc * bc[..., None]
        A = jnp.where(strict, jnp.einsum('bhtd,bhsd->bhts', kb, kc) * decay, 0.0)
        rhs = jnp.concatenate([vc * bc[..., None], kb * jnp.exp(gcum)[..., None]], axis=-1)
        sol = lax.linalg.triangular_solve(A, rhs, left_side=True, lower=True,
                                          unit_diagonal=True)
        u, w = sol[..., :GDN_DV], sol[..., GDN_DV:]
        v_new = u - jnp.einsum('bhtd,bhde->bhte', w, S)
        att = jnp.einsum('bhtd,bhsd->bhts', qc, kc) * decay
        o = (jnp.einsum('bhtd,bhde->bhte', qc * jnp.exp(gcum)[..., None], S)
             + jnp.einsum('bhts,bhse->bhte', att, v_new))
        gl = gcum[..., -1]
        S = (S * jnp.exp(gl)[..., None, None]
             + jnp.einsum('bhsd,bhse->bhde', kc * jnp.exp(gl[..., None] - gcum)[..., None], v_new))
        return S, o

    S, o = lax.scan(step, S0, xs)
    return _from_chunks(o, T), S


def _rglru(xc, w_a, b_a, w_x, b_x, lam, h0):
    B, T, W = xc.shape
    xb = xc.reshape(B, T, LRU_BLOCKS, LRU_BLOCK)
    r = jax.nn.sigmoid(jnp.einsum('btni,nij->btnj', xb, w_a).reshape(B, T, W) + b_a)
    i = jax.nn.sigmoid(jnp.einsum('btni,nij->btnj', xb, w_x).reshape(B, T, W) + b_x)
    log_a = -LRU_C * r * jax.nn.softplus(-lam)
    a = jnp.exp(log_a)
    b = jnp.sqrt(-jnp.expm1(2.0 * log_a)) * (i * xc)
    b = b.at[:, 0].add(a[:, 0] * h0)

    def combine(lhs, rhs):
        a1, b1 = lhs
        a2, b2 = rhs
        return a1 * a2, a2 * b1 + b2

    _, h = lax.associative_scan(combine, (a, b), axis=1)
    return h, h[:, -1]


def _layer(x, c, st, p, l, lb):
    s_hg, s_gdn, b_qkv, s_lru, b_lru, b_ffn = st
    B, T, _ = x.shape
    f32 = jnp.float32
    mod = jax.nn.silu(c) @ p['w_ada'][l] + p['b_ada'][l]
    sh1, sc1, g1, sh2, sc2, g2 = [m[:, None, :] for m in jnp.split(mod, 6, axis=-1)]

    h = _rmsnorm(x, p['norm_mix'][l]) * (1 + sc1) + sh1
    u = h @ p['w_in'][l]
    split_idx = np.cumsum(IN_SPLITS)[:-1].tolist()
    hq, hf, hi, hz, qkv, gz, ga, gb, lx, lz = jnp.split(u, split_idx, axis=-1)

    def heads(a, H):
        return a.reshape(B, T, H, -1)

    zf = hf.astype(f32)
    fg = lb + (1 - lb) * jax.nn.sigmoid(zf)
    logf = jnp.log(fg)
    kf = (1 - lb) * jax.nn.sigmoid(-zf)
    o_hg, s_hg = _hgrn2(heads(jax.nn.silu(hq.astype(f32)), HG_HEADS), heads(kf, HG_HEADS),
                        heads(hi.astype(f32), HG_HEADS), heads(logf, HG_HEADS),
                        s_hg.astype(f32))
    o_hg = _rmsnorm(o_hg, p['hg_norm'][l]) * jax.nn.silu(heads(hz.astype(f32), HG_HEADS))

    qkv_c, b_qkv = _causal_dwconv(qkv, b_qkv, p['gdn_conv_w'][l])
    qkv_c = jax.nn.silu(qkv_c.astype(f32))
    q, k, v = jnp.split(qkv_c, [GDN_HEADS * GDN_DK, 2 * GDN_HEADS * GDN_DK], axis=-1)
    q = _l2norm(heads(q, GDN_HEADS)) * (GDN_DK ** -0.5)
    k = _l2norm(heads(k, GDN_HEADS))
    v = heads(v, GDN_HEADS)
    g = -jnp.exp(p['gdn_a_log'][l].astype(f32)) * jax.nn.softplus(ga.astype(f32) + p['gdn_dt_bias'][l])
    beta = jax.nn.sigmoid(gb.astype(f32))
    o_gdn, s_gdn = _gated_delta(q, k, v, g, beta, s_gdn.astype(f32))
    o_gdn = _rmsnorm(o_gdn, p['gdn_norm'][l]) * jax.nn.silu(heads(gz.astype(f32), GDN_HEADS))

    xc, b_lru = _causal_dwconv(lx, b_lru, p['lru_conv_w'][l])
    xc = xc.astype(f32) + p['lru_conv_b'][l]
    hl, s_lru = _rglru(xc, p['lru_w_a'][l], p['lru_b_a'][l], p['lru_w_x'][l], p['lru_b_x'][l],
                       p['lru_lambda'][l], s_lru.astype(f32))
    o_lru = hl * jax.nn.gelu(lz.astype(f32))

    o = jnp.concatenate([o_hg.reshape(B, T, HG_WIDTH), o_gdn.reshape(B, T, GDN_WIDTH), o_lru],
                        axis=-1).astype(x.dtype)
    x = x + g1 * (o @ p['w_out'][l])

    h = _rmsnorm(x, p['norm_ffn'][l]) * (1 + sc2) + sh2
    gate, b_ffn = _causal_dwconv(h @ p['ffn_w_gate'][l], b_ffn, p['ffn_conv_w'][l])
    gate = gate + p['ffn_conv_b'][l]
    x = x + g2 * ((jax.nn.silu(gate) * (h @ p['ffn_w_up'][l])) @ p['ffn_w_down'][l])
    return x, (s_hg, s_gdn, b_qkv, s_lru, b_lru, b_ffn)


def _trunk(x, c, states, p, lbs, final_norm):
    collected = [[] for _ in range(6)]
    for l in range(DEPTH):
        st = tuple(s[l] for s in states)
        x, new = _layer(x, c, st, p, l, lbs[l])
        for lst, s in zip(collected, new):
            lst.append(s)
    y = _rmsnorm(x, final_norm)
    return y, tuple(jnp.stack(lst, axis=0) for lst in collected)


def setup_inputs(seed: int = 0) -> dict:
    key = jax.random.key(seed)
    ks = iter(jax.random.split(key, 48))
    f32 = jnp.float32

    def nrm(shape, s):
        return jax.random.normal(next(ks), shape, f32) * s

    x_prompt = nrm((BATCH, SEQ, D_MODEL), 1.0)
    x_sample = nrm((DEC_BATCH, DEC_SEQ, D_MODEL), 1.0)
    state_hgrn = nrm((DEPTH, DEC_BATCH, HG_HEADS, HG_DK, HG_DV), 0.5)
    state_gdn = nrm((DEPTH, DEC_BATCH, GDN_HEADS, GDN_DK, GDN_DV), 0.1)
    state_gdn_conv = nrm((DEPTH, DEC_BATCH, CONV_QKV - 1, GDN_QKV), 1.0)
    state_lru = nrm((DEPTH, DEC_BATCH, LRU_WIDTH), 0.5)
    state_lru_conv = nrm((DEPTH, DEC_BATCH, CONV_LRU - 1, LRU_WIDTH), 1.0)
    state_ffn_conv = nrm((DEPTH, DEC_BATCH, CONV_FFN - 1, D_FF), 1.0)
    c_prompt = nrm((BATCH, D_MODEL), 1.0)
    c_sample = nrm((DEC_BATCH, D_MODEL), 1.0)
    norm_mix = 1.0 + nrm((DEPTH, D_MODEL), 0.01)
    norm_ffn = 1.0 + nrm((DEPTH, D_MODEL), 0.01)
    w_ada = nrm((DEPTH, D_MODEL, 6 * D_MODEL), 0.5 * D_MODEL ** -0.5)
    b_ada = nrm((DEPTH, 6 * D_MODEL), 0.1)
    w_in = nrm((DEPTH, D_MODEL, D_IN), D_MODEL ** -0.5)
    hg_lower_bound = nrm((DEPTH, HG_FDIM), 1.0)
    hg_norm = 1.0 + nrm((DEPTH, HG_DV), 0.01)
    gdn_conv_w = nrm((DEPTH, CONV_QKV, GDN_QKV), CONV_QKV ** -0.5)
    gdn_a_log = jnp.log(jax.random.uniform(next(ks), (DEPTH, GDN_HEADS), f32, 1.0, 16.0))
    dt = jnp.exp(jax.random.uniform(next(ks), (DEPTH, GDN_HEADS), f32,
                                    float(np.log(1e-3)), float(np.log(1e-1))))
    gdn_dt_bias = dt + jnp.log(-jnp.expm1(-dt))
    gdn_norm = 1.0 + nrm((DEPTH, GDN_DV), 0.01)
    lru_conv_w = nrm((DEPTH, CONV_LRU, LRU_WIDTH), CONV_LRU ** -0.5)
    lru_conv_b = nrm((DEPTH, LRU_WIDTH), 0.02)
    lru_w_a = nrm((DEPTH, LRU_BLOCKS, LRU_BLOCK, LRU_BLOCK), LRU_BLOCK ** -0.5)
    lru_b_a = nrm((DEPTH, LRU_WIDTH), 0.02)
    lru_w_x = nrm((DEPTH, LRU_BLOCKS, LRU_BLOCK, LRU_BLOCK), LRU_BLOCK ** -0.5)
    lru_b_x = nrm((DEPTH, LRU_WIDTH), 0.02)
    a0 = jax.random.uniform(next(ks), (DEPTH, LRU_WIDTH), f32, 0.9, 0.999) ** (1.0 / LRU_C)
    lru_lambda = jnp.log(a0) - jnp.log1p(-a0)
    w_out = nrm((DEPTH, D_MIX, D_MODEL), D_MIX ** -0.5)
    ffn_w_gate = nrm((DEPTH, D_MODEL, D_FF), D_MODEL ** -0.5)
    ffn_w_up = nrm((DEPTH, D_MODEL, D_FF), D_MODEL ** -0.5)
    ffn_conv_w = nrm((DEPTH, CONV_FFN, D_FF), CONV_FFN ** -0.5)
    ffn_conv_b = nrm((DEPTH, D_FF), 0.02)
    ffn_w_down = nrm((DEPTH, D_FF, D_MODEL), D_FF ** -0.5)
    final_norm = 1.0 + nrm((D_MODEL,), 0.01)
    return {
        "x_prompt": x_prompt, "x_sample": x_sample,
        "state_hgrn": state_hgrn, "state_gdn": state_gdn, "state_gdn_conv": state_gdn_conv,
        "state_lru": state_lru, "state_lru_conv": state_lru_conv, "state_ffn_conv": state_ffn_conv,
        "c_prompt": c_prompt, "c_sample": c_sample,
        "norm_mix": norm_mix, "norm_ffn": norm_ffn, "w_ada": w_ada, "b_ada": b_ada,
        "w_in": w_in, "hg_lower_bound": hg_lower_bound, "hg_norm": hg_norm,
        "gdn_conv_w": gdn_conv_w, "gdn_a_log": gdn_a_log, "gdn_dt_bias": gdn_dt_bias,
        "gdn_norm": gdn_norm, "lru_conv_w": lru_conv_w, "lru_conv_b": lru_conv_b,
        "lru_w_a": lru_w_a, "lru_b_a": lru_b_a, "lru_w_x": lru_w_x, "lru_b_x": lru_b_x,
        "lru_lambda": lru_lambda, "w_out": w_out, "ffn_w_gate": ffn_w_gate,
        "ffn_w_up": ffn_w_up, "ffn_conv_w": ffn_conv_w, "ffn_conv_b": ffn_conv_b,
        "ffn_w_down": ffn_w_down, "final_norm": final_norm,
    }


def reference(x_prompt, x_sample, state_hgrn, state_gdn, state_gdn_conv, state_lru,
              state_lru_conv, state_ffn_conv, c_prompt, c_sample, norm_mix, norm_ffn,
              w_ada, b_ada, w_in, hg_lower_bound, hg_norm, gdn_conv_w, gdn_a_log,
              gdn_dt_bias, gdn_norm, lru_conv_w, lru_conv_b, lru_w_a, lru_b_a, lru_w_x,
              lru_b_x, lru_lambda, w_out, ffn_w_gate, ffn_w_up, ffn_conv_w, ffn_conv_b,
              ffn_w_down, final_norm):
    f32 = jnp.float32
    p = dict(norm_mix=norm_mix, norm_ffn=norm_ffn, w_ada=w_ada, b_ada=b_ada, w_in=w_in,
             hg_norm=hg_norm, gdn_conv_w=gdn_conv_w, gdn_a_log=gdn_a_log,
             gdn_dt_bias=gdn_dt_bias, gdn_norm=gdn_norm, lru_conv_w=lru_conv_w,
             lru_conv_b=lru_conv_b, lru_w_a=lru_w_a, lru_b_a=lru_b_a, lru_w_x=lru_w_x,
             lru_b_x=lru_b_x, lru_lambda=lru_lambda, w_out=w_out, ffn_w_gate=ffn_w_gate,
             ffn_w_up=ffn_w_up, ffn_conv_w=ffn_conv_w, ffn_conv_b=ffn_conv_b,
             ffn_w_down=ffn_w_down)
    sm = jax.nn.softmax(hg_lower_bound.astype(f32), axis=0)
    lbs = jnp.cumsum(sm, axis=0) - sm[0]

    Bp = x_prompt.shape[0]
    zero_states = (
        jnp.zeros((DEPTH, Bp, HG_HEADS, HG_DK, HG_DV), f32),
        jnp.zeros((DEPTH, Bp, GDN_HEADS, GDN_DK, GDN_DV), f32),
        jnp.zeros((DEPTH, Bp, CONV_QKV - 1, GDN_QKV), x_prompt.dtype),
        jnp.zeros((DEPTH, Bp, LRU_WIDTH), f32),
        jnp.zeros((DEPTH, Bp, CONV_LRU - 1, LRU_WIDTH), x_prompt.dtype),
        jnp.zeros((DEPTH, Bp, CONV_FFN - 1, D_FF), x_prompt.dtype),
    )
    y_prompt, (hg_p, gdn_p, gconv_p, lru_p, lconv_p, fconv_p) = _trunk(
        x_prompt, c_prompt, zero_states, p, lbs, final_norm)
    sample_states = (state_hgrn, state_gdn, state_gdn_conv, state_lru, state_lru_conv,
                     state_ffn_conv)
    y_sample, (hg_s, gdn_s, gconv_s, lru_s, lconv_s, fconv_s) = _trunk(
        x_sample, c_sample, sample_states, p, lbs, final_norm)
    return (y_prompt, y_sample, hg_p, gdn_p, gconv_p, lru_p, lconv_p, fconv_p,
            hg_s, gdn_s, gconv_s, lru_s, lconv_s, fconv_s)
```

```cpp
#include <hip/hip_runtime.h>
#include <cstdio>
#include <cstdint>
namespace pg8 {
#define PG8_LAS __attribute__((address_space(3)))
typedef unsigned short bf16_t;
typedef short bf16x8 __attribute__((ext_vector_type(8)));
typedef float f32x4 __attribute__((ext_vector_type(4)));
typedef unsigned u32x4 __attribute__((ext_vector_type(4)));
constexpr int BM = 256, BK = 64, HALF = 128, HTB = HALF * BK * 2  , STAGE_BYTES = 8 * HTB, NXCD = 8, WGM = 8;

__host__ __device__ __forceinline__ int lds_byte(int r, int c) { const int st = (r >> 4) * 2 + (c >> 5), rr = r & 15, cc = c & 31, ob = rr * 64 + cc * 2; return st * 1024 + (ob ^ (((ob >> 9) & 1) << 5)); }
__host__ __device__ __forceinline__ void stage_rc(int b, int& R, int& C) { const int st = b / 1024, sb = b % 1024, swz = sb ^ (((sb >> 9) & 1) << 5); R = (st >> 1) * 16 + swz / 64; C = (st & 1) * 32 + (swz % 64) / 2; }
__host__ __device__ __forceinline__ int perm32(int rho) { const int n = rho >> 4, i = rho & 15; return 8 * (i >> 2) + 4 * n + (i & 3); }

struct Unit { int pm, pn; };
struct Gemm { const bf16_t* A; const bf16_t* Bt; int M, N, K; };

struct StaticOrder {
    int nM, nN, nwg, G, c;
    __host__ __device__ void init(int M, int N, int G_, int c_) { nM = M / BM; nN = N / BM; nwg = nM * nN; G = G_; c = c_; }
    __host__ __device__ bool next(int i, Unit& u) const {
        const long L = (long)i * G + c; if (L >= nwg) return false;
        int wgid = (int)L; { const int q = nwg / NXCD, r = nwg % NXCD, xcd = wgid % NXCD, off = wgid / NXCD; wgid = (xcd < r ? xcd * (q + 1) : r * (q + 1) + (xcd - r) * q) + off; }
        const int nig = WGM * nN, gid = wgid / nig, fm = gid * WGM, gsz = (nM - fm) < WGM ? (nM - fm) : WGM;
        u.pm = fm + ((wgid % nig) % gsz); u.pn = (wgid % nig) / gsz; return true;
    }
    __device__ __forceinline__ void a_ready(const Unit&) const {}
    __device__ __forceinline__ void done(const Unit&) const {}
};

__device__ __forceinline__ unsigned cvt_pk_bf16(float lo, float hi) { unsigned r; asm volatile("v_cvt_pk_bf16_f32 %0, %1, %2" : "=v"(r) : "v"(lo), "v"(hi)); return r; }
template <class Epi, class Sched, bool ALIGN_EPI = false, bool SP2 = false>
__device__ __forceinline__ void gemm_phase(PG8_LAS unsigned char* lds, const Gemm g, const Sched& S, const Epi& E) {
    int tid_ = threadIdx.x; asm volatile("" : "+v"(tid_)); const int tid = tid_, wid = __builtin_amdgcn_readfirstlane(tid >> 6), lane = tid & 63, wr = wid >> 2, wc = wid & 3, fr = lane & 15, fq = lane >> 4;
    const int K = g.K, nt = K / BK;
    unsigned voffA[2], voffB[2];
#pragma unroll
    for (int i = 0; i < 2; ++i) { int R, C; stage_rc(tid * 16 + i * 8192, R, C); const int Rb = Epi::PERM ? ((R & ~31) + perm32(R & 31)) : R;
        voffA[i] = (unsigned)(R * K + C) * 2u; voffB[i] = (unsigned)(Rb * K + C) * 2u; }
    const size_t kstep = (size_t)(BK * 2);
    const size_t hstep = (size_t)HALF * K * 2;
    const size_t tstep = 2 * hstep;
    const unsigned ldsw = (unsigned)wid * 1024u;
    const int aoff = lds_byte(wr * 64 + fr, fq * 8), boff = lds_byte(wc * 32 + fr, fq * 8);
#define PG8_SA(b, h) (((b) * 2 + (h)) * HTB)
#define PG8_SB(b, h) ((4 + (b) * 2 + (h)) * HTB)
#define PG8_STAGE(bufoff, gbase, voff) do { _Pragma("unroll") for (int _i = 0; _i < 2; ++_i) \
        __builtin_amdgcn_global_load_lds((const unsigned*)((const char*)(gbase) + (voff)[_i]), (PG8_LAS unsigned*)(lds + (bufoff) + ldsw + _i * 8192), 16, 0, 0); } while (0)
#define PG8_LDA(dst, b, h) do { _Pragma("unroll") for (int m = 0; m < 4; ++m) _Pragma("unroll") for (int k = 0; k < 2; ++k) dst[m][k] = *(const PG8_LAS bf16x8*)(lds + PG8_SA(b, h) + aoff + m * 2048 + k * 1024); } while (0)
#define PG8_LDB(dst, b, h) do { _Pragma("unroll") for (int n = 0; n < 2; ++n) _Pragma("unroll") for (int k = 0; k < 2; ++k) dst[n][k] = *(const PG8_LAS bf16x8*)(lds + PG8_SB(b, h) + boff + n * 2048 + k * 1024); } while (0)
#define PG8_MMA(ai, bj, At, Bt) do { __builtin_amdgcn_s_setprio(1); _Pragma("unroll") for (int m = 0; m < 4; ++m) _Pragma("unroll") for (int n = 0; n < 2; ++n) _Pragma("unroll") for (int k = 0; k < 2; ++k) \
        acc[ai][bj][m][n] = __builtin_amdgcn_mfma_f32_16x16x32_bf16(Bt[n][k], At[m][k], acc[ai][bj][m][n], 0, 0, 0); __builtin_amdgcn_s_setprio(0); } while (0)
#define PG8_WAIT_V(n) asm volatile("s_waitcnt vmcnt(" #n ")" ::: "memory")
#define PG8_WAIT_L(n) asm volatile("s_waitcnt lgkmcnt(" #n ")" ::: "memory")
#define PG8_BAR __builtin_amdgcn_s_barrier()
#define PG8_SCHED __builtin_amdgcn_sched_barrier(0)
    Unit cur, nxt; int ui = 0;
    if (!S.next(0, cur)) return;
    f32x4 acc[2][2][4][2];
#pragma unroll
    for (int a = 0; a < 2; ++a)
#pragma unroll
        for (int b = 0; b < 2; ++b)
#pragma unroll
            for (int m = 0; m < 4; ++m)
#pragma unroll
                for (int n = 0; n < 2; ++n) acc[a][b][m][n] = (f32x4){0.f, 0.f, 0.f, 0.f};
    bf16x8 At[4][2], B0[2][2], B1[2][2];
    const char* cA = (const char*)g.A + (size_t)cur.pm * tstep; const char* cB = (const char*)g.Bt + (size_t)cur.pn * tstep;
    S.a_ready(cur);
    if constexpr (SP2) {
        PG8_STAGE(PG8_SB(0, 0), cB, voffB); PG8_STAGE(PG8_SB(0, 1), cB + hstep, voffB); PG8_STAGE(PG8_SA(0, 0), cA, voffA); PG8_STAGE(PG8_SA(0, 1), cA + hstep, voffA);
        if (wr == 1) PG8_BAR;
        PG8_WAIT_V(2); PG8_BAR;
        PG8_STAGE(PG8_SB(1, 0), cB + kstep, voffB); PG8_STAGE(PG8_SA(1, 0), cA + kstep, voffA); PG8_STAGE(PG8_SB(1, 1), cB + hstep + kstep, voffB);
        PG8_WAIT_V(6); PG8_BAR;
    } else {
        PG8_STAGE(PG8_SB(0, 0), cB, voffB); PG8_STAGE(PG8_SA(0, 0), cA, voffA); PG8_STAGE(PG8_SB(0, 1), cB + hstep, voffB); PG8_STAGE(PG8_SA(0, 1), cA + hstep, voffA);
        if (wr == 1) PG8_BAR;
        PG8_WAIT_V(4); PG8_BAR;
        PG8_STAGE(PG8_SB(1, 0), cB + kstep, voffB); PG8_STAGE(PG8_SA(1, 0), cA + kstep, voffA); PG8_STAGE(PG8_SB(1, 1), cB + hstep + kstep, voffB);
        PG8_WAIT_V(6); PG8_BAR;
    }
    for (;;) {
        const bool has_next = S.next(ui + 1, nxt);
        const char* nA = has_next ? (const char*)g.A + (size_t)nxt.pm * tstep : cA; const char* nB = has_next ? (const char*)g.Bt + (size_t)nxt.pn * tstep : cB;
        for (int t = 0; t < nt; t += 2) {
            const bool last = (t == nt - 2);
            const char* a1 = cA + (size_t)(t + 1) * kstep;
            const char* a2 = last ? nA : cA + (size_t)(t + 2) * kstep; const char* b2 = last ? nB : cB + (size_t)(t + 2) * kstep;
            const char* a3 = a2 + kstep; const char* b3 = b2 + kstep;
            if (last && has_next) S.a_ready(nxt);
            if constexpr (SP2) {
            PG8_LDB(B0, 0, 0); PG8_LDB(B1, 0, 1); PG8_SCHED; PG8_LDA(At, 0, 0); PG8_STAGE(PG8_SA(1, 1), a1 + hstep, voffA);
            PG8_WAIT_V(8); PG8_WAIT_L(0); PG8_BAR; PG8_MMA(0, 0, At, B0); PG8_MMA(0, 1, At, B1); PG8_BAR; PG8_SCHED;
            PG8_LDA(At, 0, 1); PG8_STAGE(PG8_SB(0, 0), b2, voffB); PG8_STAGE(PG8_SB(0, 1), b2 + hstep, voffB); PG8_STAGE(PG8_SA(0, 0), a2, voffA);
            PG8_WAIT_V(8); PG8_WAIT_L(0); PG8_BAR; PG8_MMA(1, 0, At, B0); PG8_MMA(1, 1, At, B1); PG8_BAR; PG8_SCHED;
            PG8_LDB(B0, 1, 0); PG8_LDB(B1, 1, 1); PG8_SCHED; PG8_LDA(At, 1, 0); PG8_STAGE(PG8_SA(0, 1), a2 + hstep, voffA);
            PG8_WAIT_V(8); PG8_WAIT_L(0); PG8_BAR; PG8_MMA(0, 0, At, B0); PG8_MMA(0, 1, At, B1); PG8_BAR; PG8_SCHED;
            PG8_LDA(At, 1, 1); PG8_STAGE(PG8_SB(1, 0), b3, voffB); PG8_STAGE(PG8_SB(1, 1), b3 + hstep, voffB); PG8_STAGE(PG8_SA(1, 0), a3, voffA);
            PG8_WAIT_V(8); PG8_WAIT_L(0); PG8_BAR; PG8_MMA(1, 0, At, B0); PG8_MMA(1, 1, At, B1); PG8_BAR; PG8_SCHED;
            } else {
            PG8_LDB(B0, 0, 0); PG8_SCHED; PG8_LDA(At, 0, 0); PG8_STAGE(PG8_SA(1, 1), a1 + hstep, voffA);
            PG8_WAIT_L(8); PG8_BAR; PG8_WAIT_L(0); PG8_MMA(0, 0, At, B0); PG8_BAR; PG8_SCHED;
            PG8_LDB(B1, 0, 1); PG8_STAGE(PG8_SB(0, 0), b2, voffB);
            PG8_BAR; PG8_WAIT_L(0); PG8_MMA(0, 1, At, B1); PG8_BAR;
            PG8_LDA(At, 0, 1); PG8_STAGE(PG8_SA(0, 0), a2, voffA);
            PG8_BAR; PG8_WAIT_L(0); PG8_MMA(1, 0, At, B0); PG8_BAR; PG8_SCHED;
            PG8_STAGE(PG8_SB(0, 1), b2 + hstep, voffB);
            PG8_WAIT_V(6); PG8_BAR; PG8_MMA(1, 1, At, B1); PG8_BAR;
            PG8_LDB(B0, 1, 0); PG8_SCHED; PG8_LDA(At, 1, 0); PG8_STAGE(PG8_SA(0, 1), a2 + hstep, voffA);
            PG8_WAIT_L(8); PG8_BAR; PG8_WAIT_L(0); PG8_MMA(0, 0, At, B0); PG8_BAR; PG8_SCHED;
            PG8_LDB(B1, 1, 1); PG8_STAGE(PG8_SB(1, 0), b3, voffB);
            PG8_BAR; PG8_WAIT_L(0); PG8_MMA(0, 1, At, B1); PG8_BAR;
            PG8_LDA(At, 1, 1); PG8_STAGE(PG8_SA(1, 0), a3, voffA);
            PG8_BAR; PG8_WAIT_L(0); PG8_MMA(1, 0, At, B0); PG8_BAR; PG8_SCHED;
            PG8_STAGE(PG8_SB(1, 1), b3 + hstep, voffB);
            PG8_WAIT_V(6); PG8_BAR; PG8_MMA(1, 1, At, B1); PG8_BAR;
            }
        }
        if constexpr (ALIGN_EPI) { if (wr == 0) PG8_BAR; }
        if constexpr (!Epi::AFTER_DRAIN) { E(acc, cur, wr, wc, fr, fq); S.done(cur); }
        if (!has_next) break;
#pragma unroll
        for (int a = 0; a < 2; ++a)
#pragma unroll
            for (int b = 0; b < 2; ++b)
#pragma unroll
                for (int m = 0; m < 4; ++m)
#pragma unroll
                    for (int n = 0; n < 2; ++n) acc[a][b][m][n] = (f32x4){0.f, 0.f, 0.f, 0.f};
        cur = nxt; cA = nA; cB = nB; ++ui;
        if constexpr (ALIGN_EPI) { if (wr == 1) PG8_BAR; }
    }
    PG8_WAIT_V(0);
    if constexpr (!ALIGN_EPI) { if (wr == 0) PG8_BAR; }
    PG8_BAR;
    if constexpr (Epi::AFTER_DRAIN) { E.fused(acc, cur, wr, wc, fr, fq, lds, wid, lane); S.done(cur); }
#undef PG8_SA
#undef PG8_SB
#undef PG8_STAGE
#undef PG8_LDA
#undef PG8_LDB
#undef PG8_MMA
#undef PG8_WAIT_V
#undef PG8_WAIT_L
#undef PG8_BAR
#undef PG8_SCHED
}
}
#define GAS __attribute__((address_space(1)))
#define LAS __attribute__((address_space(3)))
typedef unsigned short bf16;
typedef unsigned v4u __attribute__((ext_vector_type(4)));
typedef float f32x4 __attribute__((ext_vector_type(4)));
typedef short bf16x8 __attribute__((ext_vector_type(8)));
typedef GAS unsigned gu32;
typedef GAS unsigned long long gu64;
#define RLX_AGENT __ATOMIC_RELAXED, __HIP_MEMORY_SCOPE_AGENT
#define LDS_WAIT() asm volatile("s_waitcnt lgkmcnt(0)" ::: "memory")
#define VM_WAIT() asm volatile("s_waitcnt vmcnt(0)" ::: "memory")
__device__ __forceinline__ unsigned long long rt() { return __builtin_amdgcn_s_memrealtime(); }
__device__ __forceinline__ unsigned f2bf(float f) { unsigned u = __builtin_bit_cast(unsigned, f); return (u + 0x7fffu + ((u >> 16) & 1u)) >> 16; }
__device__ __forceinline__ unsigned pk2(float lo, float hi) { return f2bf(lo) | (f2bf(hi) << 16); }

#define XB_TMO      128
#define XB_XCNT(j)  (256  + 64 * (j))
#define XB_XSUB(j)  (1280 + 64 * (j))
#define XB_XGEN(j)  (2304 + 64 * (j))
#define XB_TOP      3328
#define XB_TOPGEN   3392
#define XCD_BAR_WORDS 3456
#define XB_SPIN_CAP (1u << 18)

__device__ __forceinline__ unsigned xb_ld(unsigned* p)              { return __hip_atomic_load(p, __ATOMIC_RELAXED, __HIP_MEMORY_SCOPE_AGENT); }
__device__ __forceinline__ unsigned xb_add(unsigned* p, unsigned v) { return __hip_atomic_fetch_add(p, v, __ATOMIC_RELAXED, __HIP_MEMORY_SCOPE_AGENT); }
__device__ __forceinline__ unsigned xb_xcc_id() { return (unsigned)__builtin_amdgcn_s_getreg((3 << 11) | 20) & 0xFu; }
#define XB_SPIN(cond, bar) do { unsigned _sp = 0; while (cond) { __builtin_amdgcn_s_sleep(1); \
    if ((++_sp & 255u) == 0u) { if (xb_ld(&(bar)[XB_TMO])) break; if (_sp > XB_SPIN_CAP) { atomicAdd(&(bar)[XB_TMO], 1u); break; } } } } while (0)

struct XcdBarrier {
    unsigned* bar; unsigned x;
    volatile LAS unsigned* st;
};

__device__ __forceinline__ XcdBarrier xcd_barrier_post(unsigned* bar, volatile LAS unsigned* st) {
    XcdBarrier b; b.bar = bar; b.x = xb_xcc_id(); b.st = st;
    if (threadIdx.x == 0) (void)xb_add(&bar[XB_XCNT(b.x)], 1u);
    return b;
}
__device__ __forceinline__ void xcd_barrier_complete(unsigned* bar, unsigned x, unsigned& nloc, unsigned& nx) {
    const unsigned G = gridDim.x * gridDim.y * gridDim.z;
    unsigned sum, cnt, mine, sp = 0u;
    for (;;) {
        sum = 0u; cnt = 0u; mine = 0u;
#pragma unroll
        for (unsigned j = 0; j < 16; ++j) { const unsigned c = xb_ld(&bar[XB_XCNT(j)]); sum += c; cnt += (c > 0u) ? 1u : 0u; mine = (j == x) ? c : mine; }
        if (sum == G) break;
        __builtin_amdgcn_s_sleep(1);
        if ((++sp & 255u) == 0u) { if (xb_ld(&bar[XB_TMO])) break; if (sp > XB_SPIN_CAP) { atomicAdd(&bar[XB_TMO], 1u); break; } }
    }
    nloc = mine > 0u ? mine : 1u; nx = cnt > 0u ? cnt : 1u;
}

__device__ __forceinline__ void xcd_barrier(const XcdBarrier& b) {
    asm volatile("s_waitcnt vmcnt(0)" ::: "memory");
    __syncthreads();
    if (threadIdx.x == 0) {
        unsigned* bar = b.bar;
        __builtin_amdgcn_s_waitcnt(0);
        unsigned nloc = b.st[0], nx = b.st[1];
        if (nloc == 0u) { xcd_barrier_complete(bar, b.x, nloc, nx); b.st[0] = nloc; b.st[1] = nx; }
        const unsigned old = xb_add(&bar[XB_XSUB(b.x)], 1u);
        const unsigned gen = old / nloc;
        if (old + 1u == (gen + 1u) * nloc) {
            __builtin_amdgcn_fence(__ATOMIC_RELEASE, "agent");
            asm volatile("s_waitcnt vmcnt(0)" ::: "memory");
            const unsigned og = xb_add(&bar[XB_TOP], 1u);
            const unsigned tg = og / nx;
            if (og + 1u == (tg + 1u) * nx) xb_add(&bar[XB_TOPGEN], 1u);
            else XB_SPIN(xb_ld(&bar[XB_TOPGEN]) == tg, bar);
            __builtin_amdgcn_fence(__ATOMIC_ACQUIRE, "agent");
            xb_add(&bar[XB_XGEN(b.x)], 1u);
            asm volatile("s_waitcnt vmcnt(0)" ::: "memory");
        } else {
            XB_SPIN(xb_ld(&bar[XB_XGEN(b.x)]) == gen, bar);
            __builtin_amdgcn_fence(__ATOMIC_ACQUIRE, "agent");
            asm volatile("s_waitcnt vmcnt(0)" ::: "memory");
        }
    }
    __syncthreads();
}
constexpr int NWAVES = 8, NTHR = 512;
constexpr int DM = 1024, TSEQ = 2048, NBP = 8, NSQ = 128, TSMP = 4, NSEQ = 136;
constexpr int MP = 16384, MROWS = 16896;
constexpr int DFF = 2816, LDU = 3840;
constexpr float EPS = 1e-6f;
constexpr int C_HQ = 0, C_HF = 256, C_HI = 512, C_HZ = 768, C_Q = 1024, C_K = 1536, C_V = 2048, C_GZ = 2560, C_LX = 3072, C_LZ = 3328, C_GA = 3584, C_GB = 3588;
enum { I_XP = 0, I_XS, I_SHG, I_SGDN, I_SGC, I_SLRU, I_SLC, I_SFC, I_CP, I_CS, I_NMIX, I_NFFN, I_WADA, I_BADA, I_WIN, I_HGLB, I_HGN, I_GCW, I_GALOG, I_GDTB, I_GNORM,
       I_LCW, I_LCB, I_LWA, I_LBA, I_LWX, I_LBX, I_LLAM, I_WOUT, I_WG, I_WU, I_FCW, I_FCB, I_WD, I_FNORM, N_IN };
constexpr size_t O_YP = 0, O_YS = 16777216, O_HGP = 17301504, O_GDNP = 17563648, O_GCP = 18612224, O_LRUP = 18685952, O_LCP = 18690048, O_FCP = 18702336,
                 O_HGS = 18792448, O_GDNS = 22986752, O_GCS = 39763968, O_LRUS = 40943616, O_LCS = 41009152, O_FCS = 41205760, O_END = 42647552;
constexpr size_t MiB = 1u << 20;
constexpr size_t WS_CTL = 0, CTL_ZERO_BYTES = 1 * MiB;
constexpr size_t WS_WIN = 1 * MiB;
constexpr size_t WS_WOUT = 9 * MiB;
constexpr size_t WS_WG = 11 * MiB;
constexpr size_t WS_WU = 17 * MiB;
constexpr size_t WS_WD = 23 * MiB;
constexpr size_t WS_AC = 29 * MiB;
constexpr size_t WS_ASH = 30 * MiB;
constexpr size_t WS_MOD = 32 * MiB;
constexpr size_t WS_CV1 = 39 * MiB;
constexpr size_t WS_CVG = 41 * MiB;
constexpr size_t WS_CVU = 43 * MiB;
constexpr size_t WS_RSS = 45 * MiB;
constexpr size_t WS_XS = 47 * MiB;
constexpr size_t WS_PQ = 47 * MiB, WS_PK = 63 * MiB;
constexpr size_t WS_U = 80 * MiB;
constexpr size_t WS_O = 204 * MiB;
constexpr size_t WS_WADA = 204 * MiB;
constexpr size_t WS_PW = 237 * MiB, WS_PU = 253 * MiB, WS_PA = 269 * MiB, WS_EGL = 277 * MiB;
constexpr size_t WS_GP = 80 * MiB;
constexpr size_t WS_ACT = 171 * MiB;
constexpr size_t WS_END = 278 * MiB;
constexpr int CW_BAR = 4096;
constexpr int LDS_BYTES = 163840, LDSCTL_OFF = 162816, MISC_OFF = LDSCTL_OFF + 320;

typedef float f32x2 __attribute__((ext_vector_type(2)));
typedef unsigned u32x2 __attribute__((ext_vector_type(2)));
struct Ctx {
    LAS unsigned char* lds;
    int wave, vcu, G;
    float* out_; unsigned char* ws_;
};
__device__ __forceinline__ unsigned char* wsq(const Ctx& C) { unsigned char* p = C.ws_; asm volatile("" : "+s"(p)); return p; }
__device__ __forceinline__ float* outq(const Ctx& C) { float* p = C.out_; asm volatile("" : "+s"(p)); return p; }
__device__ __forceinline__ const float* inptr(int i) {
    unsigned long long ka = (unsigned long long)__builtin_amdgcn_kernarg_segment_ptr();
    asm volatile("" : "+s"(ka));
    return *(const float* const __attribute__((address_space(4)))*)(ka + 8ull * (unsigned)i);
}
__device__ __forceinline__ float bf2f(unsigned short h) { return __builtin_bit_cast(float, (unsigned)h << 16); }
__device__ __forceinline__ float bflo(unsigned w) { return __builtin_bit_cast(float, w << 16); }
__device__ __forceinline__ float bfhi(unsigned w) { return __builtin_bit_cast(float, w & 0xffff0000u); }
__device__ __forceinline__ unsigned short f2bfs(float f) { return (unsigned short)f2bf(f); }
__device__ __forceinline__ float sigm(float x) { return 1.f / (1.f + __expf(-x)); }
__device__ __forceinline__ float siluf(float x) { return x / (1.f + __expf(-x)); }
__device__ __forceinline__ float softplusf(float x) { return x > 20.f ? x : log1pf(__expf(x)); }
__device__ __forceinline__ float gelu_tanh(float x) { const float u = 0.7978845608028654f * (x + 0.044715f * x * x * x); return 0.5f * x * (1.f + tanhf(u)); }
__device__ __forceinline__ int permpos(int d) { return 8 * ((d >> 2) & 3) + 4 * ((d >> 4) & 1) + (d & 3); }
__device__ __forceinline__ int seq_of_row(int row) { return row < MP ? (row >> 11) : NBP + ((row - MP) >> 2); }
__device__ __forceinline__ bf16x8 pack8(const f32x4 a, const f32x4 b) {
    v4u w; w.x = pk2(a.x, a.y); w.y = pk2(a.z, a.w); w.z = pk2(b.x, b.y); w.w = pk2(b.z, b.w); return __builtin_bit_cast(bf16x8, w);
}
__device__ __forceinline__ f32x4 mfma16(const bf16x8 a, const bf16x8 b, const f32x4 c) { return __builtin_amdgcn_mfma_f32_16x16x32_bf16(a, b, c, 0, 0, 0); }
__device__ __forceinline__ void glds16(const void* g, LAS unsigned char* l) { __builtin_amdgcn_global_load_lds((const unsigned*)g, (LAS unsigned*)l, 16, 0, 0); }
__device__ __forceinline__ float rstd_of(const float* rss, int row) {
    const f32x4* p = (const f32x4*)(rss + (size_t)row * 16); const f32x4 a = p[0], b = p[1], c = p[2], d = p[3];
    const float s = ((a.x + a.y) + (a.z + a.w)) + ((b.x + b.y) + (b.z + b.w)) + ((c.x + c.y) + (c.z + c.w)) + ((d.x + d.y) + (d.z + d.w));
    return rsqrtf(s * (1.f / DM) + EPS);
}

struct EpiModCvec {
    static constexpr bool PERM = false, AFTER_DRAIN = false;
    float* C; int ldc; const float* bias; int rowmax; int adaln; bf16* ash;
    __device__ __forceinline__ void operator()(const f32x4 (&acc)[2][2][4][2], const pg8::Unit& u, int wr, int wc, int fr, int fq) const {
        const int colb = u.pn * 256 + wc * 32 + 4 * fq;
#pragma unroll
        for (int ai = 0; ai < 2; ++ai)
#pragma unroll
            for (int m = 0; m < 4; ++m) {
                const int row = ai * 128 + wr * 64 + m * 16 + fr;
                if (row < rowmax) {
#pragma unroll
                    for (int bj = 0; bj < 2; ++bj)
#pragma unroll
                        for (int n = 0; n < 2; ++n) {
                            const int col = colb + bj * 128 + n * 16; f32x4 v = acc[ai][bj][m][n];
                            if (adaln) {
                                const int l = col / 6144, cl = col - l * 6144, chunk = cl >> 10;
                                v = v + *(const f32x4*)(bias + col);
                                *(f32x4*)(C + ((size_t)l * NSEQ + row) * 6144 + cl) = v;
                                if (chunk == 0 || chunk == 3) { u32x2 w; w.x = pk2(v.x, v.y); w.y = pk2(v.z, v.w); *(u32x2*)(ash + ((size_t)(2 * l + (chunk == 3)) * 256 + row) * DM + (cl & 1023)) = w; }
                            } else {
                                *(f32x4*)(C + (size_t)row * ldc + col) = v;
                            }
                        }
                }
            }
    }
};
struct EpiU {
    static constexpr bool PERM = true, AFTER_DRAIN = false;
    bf16* U; const float* rss; const float* cvec; int ldo; int ldcv;
    __device__ __forceinline__ void operator()(const f32x4 (&acc)[2][2][4][2], const pg8::Unit& u, int wr, int wc, int fr, int fq) const {
        const int colb = u.pn * 256 + wc * 32 + 8 * fq;
#pragma unroll
        for (int ai = 0; ai < 2; ++ai)
#pragma unroll
            for (int m = 0; m < 4; ++m) {
                const int row = u.pm * 256 + ai * 128 + wr * 64 + m * 16 + fr;
                const float rs = rstd_of(rss, row); const int s = seq_of_row(row);
                const float* cv = cvec + (size_t)s * ldcv + colb; bf16* op = U + (size_t)row * ldo + colb;
#pragma unroll
                for (int bj = 0; bj < 2; ++bj) {
                    const f32x4 c0 = *(const f32x4*)(cv + bj * 128), c1 = *(const f32x4*)(cv + bj * 128 + 4);
                    const f32x4 v0 = acc[ai][bj][m][0] * rs + c0, v1 = acc[ai][bj][m][1] * rs + c1;
                    v4u w; w.x = pk2(v0.x, v0.y); w.y = pk2(v0.z, v0.w); w.z = pk2(v1.x, v1.y); w.w = pk2(v1.z, v1.w);
                    *(v4u*)(op + bj * 128) = w;
                }
            }
    }
};
struct EpiGate {
    static constexpr bool PERM = true, AFTER_DRAIN = false;
    bf16* GP; const float* rss; const float* cvec; float* fcp; float* fcs;
    __device__ __forceinline__ void operator()(const f32x4 (&acc)[2][2][4][2], const pg8::Unit& u, int wr, int wc, int fr, int fq) const {
        const int colb = u.pn * 256 + wc * 32 + 8 * fq;
#pragma unroll
        for (int ai = 0; ai < 2; ++ai)
#pragma unroll
            for (int m = 0; m < 4; ++m) {
                const int row = u.pm * 256 + ai * 128 + wr * 64 + m * 16 + fr;
                const float rs = rstd_of(rss, row); const int s = seq_of_row(row);
                const float* cv = cvec + (size_t)s * DFF + colb; bf16* op = GP + (size_t)row * DFF + colb;
                float* st = nullptr;
                if (row < MP) { const int tt = row & (TSEQ - 1); if (tt >= TSEQ - 2) st = fcp + ((size_t)s * 2 + (tt - (TSEQ - 2))) * DFF + colb; }
                else { const int tt = row & 3; if (tt >= 2) st = fcs + ((size_t)(s - NBP) * 2 + (tt - 2)) * DFF + colb; }
#pragma unroll
                for (int bj = 0; bj < 2; ++bj) {
                    const f32x4 c0 = *(const f32x4*)(cv + bj * 128), c1 = *(const f32x4*)(cv + bj * 128 + 4);
                    const f32x4 v0 = acc[ai][bj][m][0] * rs + c0, v1 = acc[ai][bj][m][1] * rs + c1;
                    v4u w; w.x = pk2(v0.x, v0.y); w.y = pk2(v0.z, v0.w); w.z = pk2(v1.x, v1.y); w.w = pk2(v1.z, v1.w);
                    *(v4u*)(op + bj * 128) = w;
                    if (st) { *(f32x4*)(st + bj * 128) = v0; *(f32x4*)(st + bj * 128 + 4) = v1; }
                }
            }
    }
};
struct EpiUp {
    static constexpr bool PERM = true, AFTER_DRAIN = false;
    bf16* ACT; const bf16* GP; const float* rss; const float* cvec; const float* cw; const float* cb; const float* sfc;
    __device__ __forceinline__ void operator()(const f32x4 (&acc)[2][2][4][2], const pg8::Unit& u, int wr, int wc, int fr, int fq) const {
        const int colb = u.pn * 256 + wc * 32 + 8 * fq;
#pragma unroll
        for (int ai = 0; ai < 2; ++ai)
#pragma unroll
            for (int m = 0; m < 4; ++m) {
                const int row = u.pm * 256 + ai * 128 + wr * 64 + m * 16 + fr;
                const float rs = rstd_of(rss, row); const int s = seq_of_row(row);
                const int tt = row < MP ? (row & (TSEQ - 1)) : (row & 3);
                const float* cv = cvec + (size_t)s * DFF + colb; bf16* op = ACT + (size_t)row * DFF + colb;
                const bf16* g0p = GP + (size_t)row * DFF + colb;
#pragma unroll
                for (int bj = 0; bj < 2; ++bj) {
                    const int cc = bj * 128;
                    float g0[8], g1[8], g2[8];
                    { const v4u r = *(const v4u*)(g0p + cc); g0[0] = bflo(r.x); g0[1] = bfhi(r.x); g0[2] = bflo(r.y); g0[3] = bfhi(r.y); g0[4] = bflo(r.z); g0[5] = bfhi(r.z); g0[6] = bflo(r.w); g0[7] = bfhi(r.w); }
                    if (tt >= 1) { const v4u r = *(const v4u*)(g0p - DFF + cc); g1[0] = bflo(r.x); g1[1] = bfhi(r.x); g1[2] = bflo(r.y); g1[3] = bfhi(r.y); g1[4] = bflo(r.z); g1[5] = bfhi(r.z); g1[6] = bflo(r.w); g1[7] = bfhi(r.w); }
                    else if (row >= MP) { const float* sp = sfc + ((size_t)(s - NBP) * 2 + 1) * DFF + colb + cc; const f32x4 a = *(const f32x4*)sp, b = *(const f32x4*)(sp + 4); g1[0] = a.x; g1[1] = a.y; g1[2] = a.z; g1[3] = a.w; g1[4] = b.x; g1[5] = b.y; g1[6] = b.z; g1[7] = b.w; }
                    else {
#pragma unroll
                        for (int i = 0; i < 8; ++i) g1[i] = 0.f; }
                    if (tt >= 2) { const v4u r = *(const v4u*)(g0p - 2 * DFF + cc); g2[0] = bflo(r.x); g2[1] = bfhi(r.x); g2[2] = bflo(r.y); g2[3] = bfhi(r.y); g2[4] = bflo(r.z); g2[5] = bfhi(r.z); g2[6] = bflo(r.w); g2[7] = bfhi(r.w); }
                    else if (row >= MP) { const float* sp = sfc + ((size_t)(s - NBP) * 2 + tt) * DFF + colb + cc; const f32x4 a = *(const f32x4*)sp, b = *(const f32x4*)(sp + 4); g2[0] = a.x; g2[1] = a.y; g2[2] = a.z; g2[3] = a.w; g2[4] = b.x; g2[5] = b.y; g2[6] = b.z; g2[7] = b.w; }
                    else {
#pragma unroll
                        for (int i = 0; i < 8; ++i) g2[i] = 0.f; }
                    const f32x4 c0 = *(const f32x4*)(cv + cc), c1 = *(const f32x4*)(cv + cc + 4);
                    const f32x4 u0 = acc[ai][bj][m][0] * rs + c0, u1 = acc[ai][bj][m][1] * rs + c1;
                    const float up[8] = {u0.x, u0.y, u0.z, u0.w, u1.x, u1.y, u1.z, u1.w};
                    float a8[8];
#pragma unroll
                    for (int i = 0; i < 8; ++i) {
                        const int col = colb + cc + i;
                        const float gate = cw[col] * g2[i] + cw[DFF + col] * g1[i] + cw[2 * DFF + col] * g0[i] + cb[col];
                        a8[i] = siluf(gate) * up[i];
                    }
                    v4u w; w.x = pk2(a8[0], a8[1]); w.y = pk2(a8[2], a8[3]); w.z = pk2(a8[4], a8[5]); w.w = pk2(a8[6], a8[7]);
                    *(v4u*)(op + cc) = w;
                }
            }
    }
};
struct EpiRes {
    static constexpr bool PERM = false, AFTER_DRAIN = false;
    const float* xinP; const float* xinS; float* xout; const float* gvec; const float* scn; const float* gamma; bf16* XS; float* rss;
    __device__ __forceinline__ void operator()(const f32x4 (&acc)[2][2][4][2], const pg8::Unit& u, int wr, int wc, int fr, int fq) const {
        const int colb = u.pn * 256 + wc * 32 + 4 * fq;
#pragma unroll
        for (int ai = 0; ai < 2; ++ai)
#pragma unroll
            for (int m = 0; m < 4; ++m) {
                const int row = u.pm * 256 + ai * 128 + wr * 64 + m * 16 + fr;
                const int s = seq_of_row(row);
                const float* xi = row < MP ? xinP + (size_t)row * DM : xinS + (size_t)(row - MP) * DM;
                float* xo = xout + (size_t)row * DM; const float* gv = gvec + (size_t)s * 6144;
                float ss = 0.f;
#pragma unroll
                for (int bj = 0; bj < 2; ++bj)
#pragma unroll
                    for (int n = 0; n < 2; ++n) {
                        const int col = colb + bj * 128 + n * 16;
                        const f32x4 xn = *(const f32x4*)(xi + col) + *(const f32x4*)(gv + col) * acc[ai][bj][m][n];
                        *(f32x4*)(xo + col) = xn;
                        ss += (xn.x * xn.x + xn.y * xn.y) + (xn.z * xn.z + xn.w * xn.w);
                        if (scn) { const f32x4 sc = *(const f32x4*)(scn + (size_t)s * 6144 + col), gm = *(const f32x4*)(gamma + col); const f32x4 v = xn * gm * (sc + 1.f);
                            u32x2 w; w.x = pk2(v.x, v.y); w.y = pk2(v.z, v.w); *(u32x2*)(XS + (size_t)row * DM + col) = w; }
                    }
                ss += __shfl_xor(ss, 16); ss += __shfl_xor(ss, 32);
                if (fq == 0) rss[(size_t)row * 16 + u.pn * 4 + wc] = ss;
            }
    }
};
struct OneUnit {
    int pn;
    __device__ __forceinline__ bool next(int i, pg8::Unit& u) const { if (i > 0 || pn < 0) return false; u.pm = 0; u.pn = pn; return true; }
    __device__ __forceinline__ void a_ready(const pg8::Unit&) const {}
    __device__ __forceinline__ void done(const pg8::Unit&) const {}
};

__device__ __forceinline__ float wave_sum(float v) {
#pragma unroll
    for (int o = 1; o < 64; o <<= 1) v += __shfl_xor(v, o);
    return v;
}
template <int MODE>
__device__ __forceinline__ void tr_item(const float* W, int N, int K, bf16* WT, int nblk, LAS float* scr, int item, int lane) {
    const int kb = item / nblk, nb = item - kb * nblk, k0 = 64 * kb, n0 = 32 * nb;
    int sc = n0 + (lane & 31);
    if (MODE == 1) { const int np = sc; sc = np < 3072 ? np : (np < 3584 ? np + 8 : (np < 3592 ? np - 512 : -1)); }
#pragma unroll 8
    for (int i = 0; i < 32; ++i) { const int kk = 2 * i + (lane >> 5); scr[kk * 33 + (lane & 31)] = sc >= 0 ? W[(size_t)(k0 + kk) * N + sc] : 0.f; }
    LDS_WAIT(); asm volatile("" ::: "memory");
    const int c = lane & 7;
#pragma unroll
    for (int j = 0; j < 4; ++j) { const int n = (lane >> 3) + 8 * j; const LAS float* s = scr + (8 * c) * 33 + n;
        v4u o; o.x = pk2(s[0 * 33], s[1 * 33]); o.y = pk2(s[2 * 33], s[3 * 33]); o.z = pk2(s[4 * 33], s[5 * 33]); o.w = pk2(s[6 * 33], s[7 * 33]);
        *(GAS v4u*)(WT + (size_t)(n0 + n) * K + k0 + 8 * c) = o; }
    LDS_WAIT(); asm volatile("" ::: "memory");
}
__device__ __forceinline__ void tr_job(Ctx& C, const float* W, bf16* WT, int N, int K, int mode, int ndest, int gw, int ngw, int& base) {
    int tid_ = threadIdx.x; asm volatile("" : "+v"(tid_)); const int lane = tid_ & 63; (void)lane;
    LAS float* scr = (LAS float*)(C.lds + C.wave * 16384);
    const int nblk = ndest / 32, nit = nblk * (K / 64);
    int it = gw - (base % ngw); if (it < 0) it += ngw;
    for (; it < nit; it += ngw) { if (mode == 1) tr_item<1>(W, N, K, WT, nblk, scr, it, lane); else tr_item<0>(W, N, K, WT, nblk, scr, it, lane); }
    base += nit;
}
__device__ __forceinline__ void phase_p0(Ctx& C) {
    const int gw = C.vcu * NWAVES + C.wave, ngw = C.G * NWAVES;
    bf16* wada = (bf16*)(wsq(C) + WS_WADA);
    int base = 0;
    tr_job(C, inptr(I_WADA), wada, 6144, DM, 0, 6144, gw, ngw, base);
    tr_job(C, inptr(I_WADA) + (size_t)DM * 6144, wada + (size_t)6144 * DM, 6144, DM, 0, 6144, gw, ngw, base);
    tr_job(C, inptr(I_WIN), (bf16*)(wsq(C) + WS_WIN), 3592, DM, 1, LDU, gw, ngw, base);
    tr_job(C, inptr(I_WG), (bf16*)(wsq(C) + WS_WG), DFF, DM, 0, DFF, gw, ngw, base);
    tr_job(C, inptr(I_WU), (bf16*)(wsq(C) + WS_WU), DFF, DM, 0, DFF, gw, ngw, base);
    bf16* ac = (bf16*)(wsq(C) + WS_AC);
    int tid_ = threadIdx.x; asm volatile("" : "+v"(tid_)); const int lane = tid_ & 63; (void)lane;
    for (int r = gw; r < NSEQ; r += ngw) {
        const float* src = r < NBP ? inptr(I_CP) + (size_t)r * DM : inptr(I_CS) + (size_t)(r - NBP) * DM;
#pragma unroll
        for (int j = 0; j < 4; ++j) { const f32x4 v = *(const f32x4*)(src + 256 * j + 4 * lane);
            u32x2 w; w.x = pk2(siluf(v.x), siluf(v.y)); w.y = pk2(siluf(v.z), siluf(v.w)); *(u32x2*)(ac + (size_t)r * DM + 256 * j + 4 * lane) = w; }
    }
}
__device__ __forceinline__ void x_to_xs(Ctx& C, int gw, int ngw) {
    const float* mod = (const float*)(wsq(C) + WS_MOD); bf16* xs = (bf16*)(wsq(C) + WS_XS); float* rss = (float*)(wsq(C) + WS_RSS);
    const float* gam = inptr(I_NMIX); const float* xp_ = inptr(I_XP); const float* xs_ = inptr(I_XS);
    int tid_ = threadIdx.x; asm volatile("" : "+v"(tid_)); const int lane = tid_ & 63; (void)lane;
    for (int row = gw; row < MROWS; row += ngw) {
        const float* src = row < MP ? xp_ + (size_t)row * DM : xs_ + (size_t)(row - MP) * DM;
        const int s = seq_of_row(row); const float* sc = mod + (size_t)s * 6144 + 1024;
        float ss = 0.f;
#pragma unroll
        for (int j = 0; j < 4; ++j) { const int col = 256 * j + 4 * lane; const f32x4 v = *(const f32x4*)(src + col);
            ss += (v.x * v.x + v.y * v.y) + (v.z * v.z + v.w * v.w);
            const f32x4 o = v * *(const f32x4*)(gam + col) * (*(const f32x4*)(sc + col) + 1.f);
            u32x2 w; w.x = pk2(o.x, o.y); w.y = pk2(o.z, o.w); *(u32x2*)(xs + (size_t)row * DM + col) = w; }
        ss = wave_sum(ss);
        if (lane < 16) rss[(size_t)row * 16 + lane] = lane == 0 ? ss : 0.f;
    }
}
__device__ __forceinline__ void phase_final(Ctx& C) {
    const int gw = C.vcu * NWAVES + C.wave, ngw = C.G * NWAVES;
    const float* rss = (const float*)(wsq(C) + WS_RSS); const float* gam = inptr(I_FNORM);
    int tid_ = threadIdx.x; asm volatile("" : "+v"(tid_)); const int lane = tid_ & 63; (void)lane;
    for (int row = gw; row < MROWS; row += ngw) {
        const float rs = rstd_of(rss, row); float* p = outq(C) + (size_t)row * DM;
#pragma unroll
        for (int j = 0; j < 4; ++j) { const int col = 256 * j + 4 * lane; *(f32x4*)(p + col) = *(const f32x4*)(p + col) * rs * *(const f32x4*)(gam + col); }
    }
}

__device__ __forceinline__ void gdn_prep_item(Ctx& C, int l, int b, int h, int n) {
    int tid_ = threadIdx.x; asm volatile("" : "+v"(tid_)); const int tid = tid_, lane = tid & 63, wave = __builtin_amdgcn_readfirstlane(tid >> 6);
    LAS float* F32 = (LAS float*)(C.lds);
    LAS unsigned short* KH = (LAS unsigned short*)(C.lds + 99328);
    LAS unsigned short* QH = (LAS unsigned short*)(C.lds + 116736);
    LAS float* AM = (LAS float*)(C.lds + 134144);
    LAS float* SC = (LAS float*)(C.lds + 151552);
    const bf16* U = (const bf16*)(wsq(C) + WS_U);
    const int row0 = b * TSEQ + n * 64;
    const int idx = (b * 4 + h) * 32 + n;
    if (tid < 384) {
        const int cg = tid % 48, rs = tid / 48, which = cg >> 4, cc = (cg & 15) * 8;
        const int ucol = C_Q + which * 512 + h * 128 + cc, wcol = which * 512 + h * 128 + cc;
        const float* cw = inptr(I_GCW) + (size_t)l * 4 * 1536 + wcol;
        float w[4][8];
#pragma unroll
        for (int k = 0; k < 4; ++k) { const f32x4 a = *(const f32x4*)(cw + k * 1536), bq = *(const f32x4*)(cw + k * 1536 + 4);
            w[k][0] = a.x; w[k][1] = a.y; w[k][2] = a.z; w[k][3] = a.w; w[k][4] = bq.x; w[k][5] = bq.y; w[k][6] = bq.z; w[k][7] = bq.w; }
        float x0[8], x1[8], x2[8], x3[8];
        const int t0 = 8 * rs;
#define LOADROW(dst, t) do { const int tg_ = n * 64 + (t); if (tg_ >= 0) { const v4u r_ = *(const v4u*)(U + (size_t)(b * TSEQ + tg_) * LDU + ucol); \
            dst[0] = bflo(r_.x); dst[1] = bfhi(r_.x); dst[2] = bflo(r_.y); dst[3] = bfhi(r_.y); dst[4] = bflo(r_.z); dst[5] = bfhi(r_.z); dst[6] = bflo(r_.w); dst[7] = bfhi(r_.w); } \
            else { _Pragma("unroll") for (int i_ = 0; i_ < 8; ++i_) dst[i_] = 0.f; } } while (0)
        LOADROW(x0, t0 - 3); LOADROW(x1, t0 - 2); LOADROW(x2, t0 - 1);
#pragma unroll
        for (int j = 0; j < 8; ++j) {
            LOADROW(x3, t0 + j);
            if (n == 31 && rs == 7 && j >= 5) {
                float* gp = outq(C) + O_GCP + ((size_t)(l * NBP + b) * 3 + (j - 5)) * 1536 + wcol;
                *(f32x4*)gp = (f32x4){x3[0], x3[1], x3[2], x3[3]}; *(f32x4*)(gp + 4) = (f32x4){x3[4], x3[5], x3[6], x3[7]};
            }
            LAS float* dst = F32 + (t0 + j) * 388 + cg * 8;
#pragma unroll
            for (int i = 0; i < 8; ++i) { const float y = w[0][i] * x0[i] + w[1][i] * x1[i] + w[2][i] * x2[i] + w[3][i] * x3[i]; dst[i] = siluf(y); x0[i] = x1[i]; x1[i] = x2[i]; x2[i] = x3[i]; }
        }
#undef LOADROW
    }
    __syncthreads();
    {
        const int p = tid >> 2, sub = tid & 3, t = p & 63, which = p >> 6;
        const LAS f32x4* src = (const LAS f32x4*)(F32 + t * 388 + which * 128 + sub * 32);
        float s = 0.f;
#pragma unroll
        for (int i = 0; i < 8; ++i) { const f32x4 v = src[i]; s += (v.x * v.x + v.y * v.y) + (v.z * v.z + v.w * v.w); }
        s += __shfl_xor(s, 1); s += __shfl_xor(s, 2);
        if (sub == 0) SC[which * 64 + t] = rsqrtf(s + EPS) * (which == 0 ? 0.08838834764831845f : 1.f);
    }
    if (wave == 0) {
        const int t = lane; const bf16* ur = U + (size_t)(row0 + t) * LDU;
        const float ga = bf2f(ur[C_GA + h]), gb = bf2f(ur[C_GB + h]);
        const float g = -__expf(inptr(I_GALOG)[l * 4 + h]) * softplusf(ga + inptr(I_GDTB)[l * 4 + h]);
        float cs = g;
#pragma unroll
        for (int o = 1; o < 64; o <<= 1) { const float v = __shfl_up(cs, o); if (lane >= o) cs += v; }
        SC[128 + t] = sigm(gb); SC[192 + t] = cs; SC[256 + t] = __expf(cs);
    }
    __syncthreads();
    {
        const int t = tid >> 3, cs = (tid & 7) * 16; const float rq = SC[t], rk = SC[64 + t];
        LAS f32x4* qrow = (LAS f32x4*)(F32 + t * 388 + cs); LAS f32x4* krow = (LAS f32x4*)(F32 + t * 388 + 128 + cs);
        f32x4 q4[4], k4[4];
#pragma unroll
        for (int i = 0; i < 4; ++i) { q4[i] = qrow[i] * rq; k4[i] = krow[i] * rk; qrow[i] = q4[i]; krow[i] = k4[i]; }
        *(LAS bf16x8*)(QH + t * 136 + cs) = pack8(q4[0], q4[1]); *(LAS bf16x8*)(QH + t * 136 + cs + 8) = pack8(q4[2], q4[3]);
        *(LAS bf16x8*)(KH + t * 136 + cs) = pack8(k4[0], k4[1]); *(LAS bf16x8*)(KH + t * 136 + cs + 8) = pack8(k4[2], k4[3]);
    }
    __syncthreads();
    {
        const int g = lane >> 4, c = lane & 15;
        bf16* ATT = (bf16*)(wsq(C) + WS_PA) + (size_t)idx * 4096;
        for (int job = wave; job < 26; job += 8) {
            int which, mt, nt;
            if (job < 16) { which = 1; mt = job >> 2; nt = job & 3; }
            else { const int k = job - 16; which = 0; mt = (k >= 6) ? 3 : (k >= 3) ? 2 : (k >= 1) ? 1 : 0; nt = k - (mt * (mt + 1)) / 2; }
            f32x4 acc = (f32x4){0.f, 0.f, 0.f, 0.f};
            if (mt >= nt) {
                const LAS unsigned short* ap = (which ? QH : KH) + (16 * mt + c) * 136 + 8 * g;
                const LAS unsigned short* bp = KH + (16 * nt + c) * 136 + 8 * g;
#pragma unroll
                for (int s = 0; s < 4; ++s) acc = mfma16(*(const LAS bf16x8*)(ap + 32 * s), *(const LAS bf16x8*)(bp + 32 * s), acc);
            }
            const int sidx = 16 * nt + c; const float gcs = SC[192 + sidx];
#pragma unroll
            for (int r = 0; r < 4; ++r) {
                const int t = 16 * mt + 4 * g + r; const float dec = __expf(SC[192 + t] - gcs);
                if (which == 0) AM[t * 68 + (sidx & 1) * 32 + (sidx >> 1)] = (sidx < t) ? SC[128 + t] * acc[r] * dec : 0.f;
                else ATT[t * 64 + (sidx & 32) + permpos(sidx & 31)] = f2bfs((sidx <= t) ? acc[r] * dec : 0.f);
            }
        }
    }
    __syncthreads();
    {
        const int c = tid >> 1, half = tid & 1; const bool isv = c < 128; const int fcol = isv ? 256 + c : c;
        float mine[32];
#pragma unroll
        for (int i = 0; i < 32; ++i) mine[i] = 0.f;
#pragma unroll
        for (int i = 0; i < 64; ++i) {
            float rhs = F32[i * 388 + fcol] * SC[128 + i]; if (!isv) rhs *= SC[256 + i];
            float part = 0.f;
            constexpr int dummy = 0; (void)dummy;
            const int nj = (i + 1) >> 1;
#pragma unroll
            for (int q = 0; q * 4 < nj; ++q) {
                const f32x4 a = *(const LAS f32x4*)(AM + i * 68 + half * 32 + 4 * q);
                part += a.x * mine[4 * q]; if (4 * q + 1 < nj) part += a.y * mine[4 * q + 1]; if (4 * q + 2 < nj) part += a.z * mine[4 * q + 2]; if (4 * q + 3 < nj) part += a.w * mine[4 * q + 3];
            }
            const float tot = part + __shfl_xor(part, 1);
            const float sol = rhs - tot;
            mine[i >> 1] = ((i & 1) == half) ? sol : mine[i >> 1];
        }
        bf16* UT = (bf16*)(wsq(C) + WS_PU) + (size_t)idx * 8192; bf16* NW = (bf16*)(wsq(C) + WS_PW) + (size_t)idx * 8192;
        const int d = c - 128; const int dpos = (d & ~31) + permpos(d & 31);
#pragma unroll
        for (int jj = 0; jj < 32; ++jj) { const int t = 2 * jj + half; if (isv) UT[t * 128 + c] = f2bfs(mine[jj]); else NW[t * 128 + dpos] = f2bfs(-mine[jj]); }
    }
    {
        const int t = tid >> 3, ds = (tid & 7) * 16; const float e = SC[256 + t];
        bf16* QT = (bf16*)(wsq(C) + WS_PQ) + (size_t)idx * 8192 + t * 128;
#pragma unroll
        for (int gq = 0; gq < 4; ++gq) { const f32x4 v = *(const LAS f32x4*)(F32 + t * 388 + ds + 4 * gq) * e;
            u32x2 w; w.x = pk2(v.x, v.y); w.y = pk2(v.z, v.w); *(u32x2*)(QT + (ds & ~31) + 8 * gq + 4 * ((ds >> 4) & 1)) = w; }
    }
    {
        const int d = tid & 127, tq = tid >> 7; const float gl = SC[192 + 63];
        bf16* KT = (bf16*)(wsq(C) + WS_PK) + (size_t)idx * 8192 + d * 64;
#pragma unroll
        for (int gq = 0; gq < 4; ++gq) {
            float v[4];
#pragma unroll
            for (int i = 0; i < 4; ++i) { const int t = 16 * tq + 4 * gq + i; v[i] = F32[t * 388 + 128 + d] * __expf(gl - SC[192 + t]); }
            u32x2 w; w.x = pk2(v[0], v[1]); w.y = pk2(v[2], v[3]); *(u32x2*)(KT + ((16 * tq) & ~31) + 8 * gq + 4 * (tq & 1)) = w;
        }
        if (tid == 0) ((float*)(wsq(C) + WS_EGL))[idx] = __expf(gl);
    }
    __syncthreads();
}

constexpr int GC_NW = 0, GC_QT = 16384, GC_KT = 32768, GC_AT = 49152, GC_UT = 57344, GC_BUF = 73728, GC_PART = 147456;
__device__ __forceinline__ void gdn_chain_issue(LAS unsigned char* lds, const unsigned char* ws, int idx, int buf, int tid, int wave) {
    LAS unsigned char* base = lds + buf * GC_BUF;
    const unsigned char* nw = ws + WS_PW + (size_t)idx * 16384; const unsigned char* qt = ws + WS_PQ + (size_t)idx * 16384;
    const unsigned char* kt = ws + WS_PK + (size_t)idx * 16384; const unsigned char* at = ws + WS_PA + (size_t)idx * 8192; const unsigned char* ut = ws + WS_PU + (size_t)idx * 16384;
#pragma unroll
    for (int i = 0; i < 2; ++i) {
        const int L = tid + 512 * i; const int wb = (i * 512 + wave * 64) * 16;
        { const int r = L >> 4, ps = L & 15, q = ps ^ (r & 15); glds16(nw + r * 256 + q * 16, base + GC_NW + wb); glds16(qt + r * 256 + q * 16, base + GC_QT + wb); }
        glds16(ut + L * 16, base + GC_UT + wb);
        { const int r = L >> 3, ps = L & 7, q = ps ^ ((r >> 1) & 7); glds16(kt + r * 128 + q * 16, base + GC_KT + wb); }
    }
    { const int L = tid; const int r = L >> 3, ps = L & 7, q = ps ^ ((r >> 1) & 7); glds16(at + r * 128 + q * 16, base + GC_AT + wave * 1024); }
}
__device__ __forceinline__ void gdn_chain(Ctx& C, int l, int b, int h) {
    int tid_ = threadIdx.x; asm volatile("" : "+v"(tid_)); const int tid = tid_, lane = tid & 63, w = __builtin_amdgcn_readfirstlane(tid >> 6), g = lane >> 4, c = lane & 15, e0 = 16 * w;
    LAS unsigned char* lds = C.lds;
    const bf16* U = (const bf16*)(wsq(C) + WS_U); bf16* O = (bf16*)(wsq(C) + WS_O);
    const float* egl_p = (const float*)(wsq(C) + WS_EGL);
    const int idx0 = (b * 4 + h) * 32;
    const float gnorm = inptr(I_GNORM)[l * 128 + e0 + c];
    f32x4 S[8];
#pragma unroll
    for (int i = 0; i < 8; ++i) S[i] = (f32x4){0.f, 0.f, 0.f, 0.f};
    gdn_chain_issue(lds, wsq(C), idx0, 0, tid, w);
    for (int n = 0; n < 32; ++n) {
        const int buf = n & 1; const int row0 = b * TSEQ + n * 64;
        unsigned short gz[4][4];
#pragma unroll
        for (int mt = 0; mt < 4; ++mt)
#pragma unroll
            for (int r = 0; r < 4; ++r) gz[mt][r] = U[(size_t)(row0 + 16 * mt + 4 * g + r) * LDU + C_GZ + h * 128 + e0 + c];
        const float egl = egl_p[idx0 + n];
        asm volatile("s_waitcnt vmcnt(0)" ::: "memory");
        __syncthreads();
        if (n + 1 < 32) gdn_chain_issue(lds, wsq(C), idx0 + n + 1, buf ^ 1, tid, w);
        LAS unsigned char* B = lds + buf * GC_BUF;
        bf16x8 Sb[4];
#pragma unroll
        for (int s = 0; s < 4; ++s) Sb[s] = pack8(S[2 * s], S[2 * s + 1]);
        f32x4 vn[4], o[4];
#pragma unroll
        for (int mt = 0; mt < 4; ++mt) {
            const LAS unsigned short* up = (const LAS unsigned short*)(B + GC_UT) + (16 * mt + 4 * g) * 128 + e0 + c;
            vn[mt] = (f32x4){bf2f(up[0]), bf2f(up[128]), bf2f(up[256]), bf2f(up[384])}; o[mt] = (f32x4){0.f, 0.f, 0.f, 0.f};
        }
#pragma unroll
        for (int mt = 0; mt < 4; ++mt)
#pragma unroll
            for (int s = 0; s < 4; ++s) {
                const int off = (16 * mt + c) * 256 + (((4 * s + g) ^ c) << 4);
                vn[mt] = mfma16(*(const LAS bf16x8*)(B + GC_NW + off), Sb[s], vn[mt]);
                o[mt] = mfma16(*(const LAS bf16x8*)(B + GC_QT + off), Sb[s], o[mt]);
            }
        bf16x8 vb[2];
        vb[0] = pack8(vn[0], vn[1]); vb[1] = pack8(vn[2], vn[3]);
#pragma unroll
        for (int mt = 0; mt < 4; ++mt)
#pragma unroll
            for (int s = 0; s < 2; ++s) {
                const int off = (16 * mt + c) * 128 + (((4 * s + g) ^ ((c >> 1) & 7)) << 4);
                o[mt] = mfma16(*(const LAS bf16x8*)(B + GC_AT + off), vb[s], o[mt]);
            }
#pragma unroll
        for (int md = 0; md < 8; ++md) {
            S[md] = S[md] * egl;
#pragma unroll
            for (int s = 0; s < 2; ++s) {
                const int off = (16 * md + c) * 128 + (((4 * s + g) ^ ((c >> 1) & 7)) << 4);
                S[md] = mfma16(*(const LAS bf16x8*)(B + GC_KT + off), vb[s], S[md]);
            }
        }
        LAS float* PART = (LAS float*)(lds + GC_PART + buf * 2048);
#pragma unroll
        for (int mt = 0; mt < 4; ++mt)
#pragma unroll
            for (int r = 0; r < 4; ++r) {
                float ss = o[mt][r] * o[mt][r];
                ss += __shfl_xor(ss, 1); ss += __shfl_xor(ss, 2); ss += __shfl_xor(ss, 4); ss += __shfl_xor(ss, 8);
                if (c == 0) PART[(16 * mt + 4 * g + r) * 8 + w] = ss;
            }
        __syncthreads();
#pragma unroll
        for (int mt = 0; mt < 4; ++mt)
#pragma unroll
            for (int r = 0; r < 4; ++r) {
                const int t = 16 * mt + 4 * g + r;
                const f32x4 p0 = *(const LAS f32x4*)(PART + t * 8), p1 = *(const LAS f32x4*)(PART + t * 8 + 4);
                const float tot = ((p0.x + p0.y) + (p0.z + p0.w)) + ((p1.x + p1.y) + (p1.z + p1.w));
                const float rs = rsqrtf(tot * (1.f / 128.f) + EPS);
                O[(size_t)(row0 + t) * DM + 256 + h * 128 + e0 + c] = f2bfs(o[mt][r] * rs * gnorm * siluf(bf2f(gz[mt][r])));
            }
    }
    float* sp = outq(C) + O_GDNP + (size_t)((l * NBP + b) * 4 + h) * 128 * 128;
#pragma unroll
    for (int i = 0; i < 8; ++i)
#pragma unroll
        for (int r = 0; r < 4; ++r) sp[(size_t)(16 * i + 4 * g + r) * 128 + e0 + c] = S[i][r];
    __syncthreads();
}

constexpr int HC_QM = 0, HC_KM = 9216, HC_QE = 18432, HC_VT = 27648, HC_KLT = 36864, HC_BUF = 46080, HC_SEG = 92160, HC_GLS = 94208, HC_PART = 94720;
__device__ __forceinline__ void hgrn_chain(Ctx& C, int l, int b, int h) {
    int tid_ = threadIdx.x; asm volatile("" : "+v"(tid_)); const int tid = tid_, lane = tid & 63, w = __builtin_amdgcn_readfirstlane(tid >> 6), g = lane >> 4, c = lane & 15, d = lane, ts = w;
    LAS unsigned char* lds = C.lds;
    const bf16* U = (const bf16*)(wsq(C) + WS_U); bf16* O = (bf16*)(wsq(C) + WS_O);
    float lb = 0.f;
    if (l == 1) { const float b0 = inptr(I_HGLB)[h * 64 + d], b1 = inptr(I_HGLB)[256 + h * 64 + d]; lb = 1.f / (1.f + __expf(b0 - b1)); }
    const float oml = 1.f - lb;
    const int nt = w >> 1, ep = w & 1;
    f32x4 S[4][2];
#pragma unroll
    for (int i = 0; i < 4; ++i) { S[i][0] = (f32x4){0.f, 0.f, 0.f, 0.f}; S[i][1] = (f32x4){0.f, 0.f, 0.f, 0.f}; }
    float hgn[2][4];
#pragma unroll
    for (int mi = 0; mi < 2; ++mi)
#pragma unroll
        for (int r = 0; r < 4; ++r) hgn[mi][r] = inptr(I_HGN)[l * 64 + 16 * (2 * ep + mi) + 4 * g + r];
    LAS float* SEG = (LAS float*)(lds + HC_SEG);
    unsigned short rq[8], rf[8], ri[8];
    {
        const bf16* up = U + (size_t)(b * TSEQ + 8 * ts) * LDU + h * 64 + d;
#pragma unroll
        for (int j = 0; j < 8; ++j) { rq[j] = up[(size_t)j * LDU + C_HQ]; rf[j] = up[(size_t)j * LDU + C_HF]; ri[j] = up[(size_t)j * LDU + C_HI]; }
    }
    for (int n = 0; n < 32; ++n) {
        const int buf = n & 1; const int row0 = b * TSEQ + n * 64;
        float q[8], kk[8], cs[8], v[8];
        float run = 0.f;
#pragma unroll
        for (int j = 0; j < 8; ++j) {
            const float z = bf2f(rf[j]); const float ez = __expf(-z); const float sg = 1.f / (1.f + ez);
            const float f = lb + oml * sg; run += __logf(f); cs[j] = run;
            kk[j] = oml * (1.f - sg);
            q[j] = siluf(bf2f(rq[j])); v[j] = bf2f(ri[j]);
        }
        SEG[ts * 64 + d] = run;
        u32x2 hz[2];
#pragma unroll
        for (int mi = 0; mi < 2; ++mi) hz[mi] = *(const u32x2*)(U + (size_t)(row0 + 16 * nt + c) * LDU + C_HZ + h * 64 + 16 * (2 * ep + mi) + 4 * g);
        if (n + 1 < 32) {
            const bf16* up = U + (size_t)(row0 + 64 + 8 * ts) * LDU + h * 64 + d;
#pragma unroll
            for (int j = 0; j < 8; ++j) { rq[j] = up[(size_t)j * LDU + C_HQ]; rf[j] = up[(size_t)j * LDU + C_HF]; ri[j] = up[(size_t)j * LDU + C_HI]; }
        }
        __syncthreads();
        float base = 0.f, gmid = 0.f, gl = 0.f;
#pragma unroll
        for (int k = 0; k < 8; ++k) { const float sv = SEG[k * 64 + d]; if (k < ts) base += sv; if (k < 4) gmid += sv; gl += sv; }
        LAS unsigned short* T = (LAS unsigned short*)(lds + buf * HC_BUF);
        {
            const int dpos = (d & ~31) + permpos(d & 31);
            float klv[8];
#pragma unroll
            for (int j = 0; j < 8; ++j) {
                const int t = 8 * ts + j; const float G = base + cs[j];
                const float e1 = fminf(fmaxf(G - gmid, -80.f), 80.f);
                T[HC_QM / 2 + t * 72 + d] = f2bfs(q[j] * __expf(e1));
                T[HC_KM / 2 + t * 72 + d] = f2bfs(kk[j] * __expf(-e1));
                T[HC_QE / 2 + t * 72 + dpos] = f2bfs(q[j] * __expf(G));
                klv[j] = kk[j] * __expf(gl - G);
            }
            const int p0 = 32 * (ts >> 2) + 16 * (ts & 1) + 4 * ((ts >> 1) & 1);
            u32x2 wv0, wv1, wk0, wk1;
            wv0.x = pk2(v[0], v[1]); wv0.y = pk2(v[2], v[3]); wv1.x = pk2(v[4], v[5]); wv1.y = pk2(v[6], v[7]);
            wk0.x = pk2(klv[0], klv[1]); wk0.y = pk2(klv[2], klv[3]); wk1.x = pk2(klv[4], klv[5]); wk1.y = pk2(klv[6], klv[7]);
            *(LAS u32x2*)(T + HC_VT / 2 + d * 72 + p0) = wv0; *(LAS u32x2*)(T + HC_VT / 2 + d * 72 + p0 + 8) = wv1;
            *(LAS u32x2*)(T + HC_KLT / 2 + d * 72 + p0) = wk0; *(LAS u32x2*)(T + HC_KLT / 2 + d * 72 + p0 + 8) = wk1;
            if (ts == 0) ((LAS float*)(lds + HC_GLS))[buf * 64 + d] = gl;
        }
        __syncthreads();
        f32x4 at[4];
#pragma unroll
        for (int ms = 0; ms < 4; ++ms) {
            at[ms] = (f32x4){0.f, 0.f, 0.f, 0.f};
            if (ms <= nt) {
#pragma unroll
                for (int s = 0; s < 2; ++s)
                    at[ms] = mfma16(*(const LAS bf16x8*)(T + HC_KM / 2 + (16 * ms + c) * 72 + 32 * s + 8 * g), *(const LAS bf16x8*)(T + HC_QM / 2 + (16 * nt + c) * 72 + 32 * s + 8 * g), at[ms]);
                if (ms == nt) {
#pragma unroll
                    for (int r = 0; r < 4; ++r) at[ms][r] = (4 * g + r <= c) ? at[ms][r] : 0.f;
                }
            }
        }
        bf16x8 atb[2]; atb[0] = pack8(at[0], at[1]); atb[1] = pack8(at[2], at[3]);
        f32x4 oT[2];
#pragma unroll
        for (int mi = 0; mi < 2; ++mi) {
            const int me = 2 * ep + mi; f32x4 acc = (f32x4){0.f, 0.f, 0.f, 0.f};
#pragma unroll
            for (int s = 0; s < 2; ++s)
                acc = mfma16(pack8(S[2 * s][mi], S[2 * s + 1][mi]), *(const LAS bf16x8*)(T + HC_QE / 2 + (16 * nt + c) * 72 + 32 * s + 8 * g), acc);
#pragma unroll
            for (int s = 0; s < 2; ++s)
                acc = mfma16(*(const LAS bf16x8*)(T + HC_VT / 2 + (16 * me + c) * 72 + 32 * s + 8 * g), atb[s], acc);
            oT[mi] = acc;
        }
        {
            const LAS float* GLS = (const LAS float*)(lds + HC_GLS) + buf * 64;
#pragma unroll
            for (int md = 0; md < 4; ++md) {
                const f32x4 lg = *(const LAS f32x4*)(GLS + 16 * md + 4 * g);
                const f32x4 lam = (f32x4){__expf(lg.x), __expf(lg.y), __expf(lg.z), __expf(lg.w)};
#pragma unroll
                for (int mi = 0; mi < 2; ++mi) {
                    const int me = 2 * ep + mi; f32x4 acc = S[md][mi] * lam;
#pragma unroll
                    for (int s = 0; s < 2; ++s)
                        acc = mfma16(*(const LAS bf16x8*)(T + HC_KLT / 2 + (16 * md + c) * 72 + 32 * s + 8 * g), *(const LAS bf16x8*)(T + HC_VT / 2 + (16 * me + c) * 72 + 32 * s + 8 * g), acc);
                    S[md][mi] = acc;
                }
            }
        }
        LAS float* PART = (LAS float*)(lds + HC_PART) + buf * 128;
        float ss = 0.f;
#pragma unroll
        for (int mi = 0; mi < 2; ++mi)
#pragma unroll
            for (int r = 0; r < 4; ++r) ss += oT[mi][r] * oT[mi][r];
        ss += __shfl_xor(ss, 16); ss += __shfl_xor(ss, 32);
        if (g == 0) PART[(16 * nt + c) * 2 + ep] = ss;
        __syncthreads();
        const float tot = PART[(16 * nt + c) * 2] + PART[(16 * nt + c) * 2 + 1];
        const float rs = rsqrtf(tot * (1.f / 64.f) + EPS);
#pragma unroll
        for (int mi = 0; mi < 2; ++mi) {
            const float z0 = bflo(hz[mi].x), z1 = bfhi(hz[mi].x), z2 = bflo(hz[mi].y), z3 = bfhi(hz[mi].y);
            u32x2 wv; wv.x = pk2(oT[mi][0] * rs * hgn[mi][0] * siluf(z0), oT[mi][1] * rs * hgn[mi][1] * siluf(z1));
            wv.y = pk2(oT[mi][2] * rs * hgn[mi][2] * siluf(z2), oT[mi][3] * rs * hgn[mi][3] * siluf(z3));
            *(u32x2*)(O + (size_t)(row0 + 16 * nt + c) * DM + h * 64 + 16 * (2 * ep + mi) + 4 * g) = wv;
        }
    }
    if (nt == 0) {
        float* sp = outq(C) + O_HGP + (size_t)((l * NBP + b) * 4 + h) * 64 * 64;
#pragma unroll
        for (int md = 0; md < 4; ++md)
#pragma unroll
            for (int mi = 0; mi < 2; ++mi)
#pragma unroll
                for (int r = 0; r < 4; ++r) sp[(size_t)(16 * md + 4 * g + r) * 64 + 16 * (2 * ep + mi) + c] = S[md][mi][r];
    }
    __syncthreads();
}

constexpr int LC_WT = 0, LC_XC = 18432, LC_XCB = 35072;
__device__ __forceinline__ void lru_chain(Ctx& C, int l, int b, int blk) {
    int tid_ = threadIdx.x; asm volatile("" : "+v"(tid_)); const int tid = tid_, lane = tid & 63, w = __builtin_amdgcn_readfirstlane(tid >> 6), g = lane >> 4, c = lane & 15, j = lane, ts = w;
    LAS unsigned char* lds = C.lds;
    const bf16* U = (const bf16*)(wsq(C) + WS_U); bf16* O = (bf16*)(wsq(C) + WS_O);
    LAS unsigned short* WT = (LAS unsigned short*)(lds + LC_WT);
    LAS float* XC = (LAS float*)(lds + LC_XC);
    LAS unsigned short* XCB = (LAS unsigned short*)(lds + LC_XCB);
    for (int idx = tid; idx < 8192; idx += NTHR) {
        const int gate = idx >> 12, i = (idx >> 6) & 63, jj = idx & 63;
        const float v = (gate ? inptr(I_LWX) : inptr(I_LWA))[((size_t)(l * 4 + blk) * 64 + i) * 64 + jj];
        WT[gate * 4608 + jj * 72 + i] = f2bfs(v);
    }
    const int ch = blk * 64 + j;
    float cw[4];
#pragma unroll
    for (int k = 0; k < 4; ++k) cw[k] = inptr(I_LCW)[(l * 4 + k) * 256 + ch];
    const float cb = inptr(I_LCB)[l * 256 + ch];
    const int jl = 16 * (w & 3) + c, chl = blk * 64 + jl;
    const float ba = inptr(I_LBA)[l * 256 + chl], bx = inptr(I_LBX)[l * 256 + chl], sp = softplusf(-inptr(I_LLAM)[l * 256 + chl]);
    float hc = 0.f;
    for (int n = 0; n < 32; ++n) {
        const int row0 = b * TSEQ + n * 64;
        {
            float x[11];
#pragma unroll
            for (int k = 0; k < 11; ++k) { const int tg = n * 64 + 8 * ts - 3 + k; x[k] = tg >= 0 ? bf2f(U[(size_t)(b * TSEQ + tg) * LDU + C_LX + ch]) : 0.f; }
#pragma unroll
            for (int k = 0; k < 8; ++k) {
                const float xc = cw[0] * x[k] + cw[1] * x[k + 1] + cw[2] * x[k + 2] + cw[3] * x[k + 3] + cb;
                XC[(8 * ts + k) * 65 + j] = xc; XCB[(8 * ts + k) * 72 + j] = f2bfs(xc);
            }
            if (n == 31 && ts == 7) {
#pragma unroll
                for (int k = 0; k < 3; ++k) outq(C)[O_LCP + ((size_t)(l * NBP + b) * 3 + k) * 256 + ch] = x[8 + k];
            }
        }
        __syncthreads();
        if (w < 4) {
            unsigned short lz[4][4];
#pragma unroll
            for (int mt = 0; mt < 4; ++mt)
#pragma unroll
                for (int r = 0; r < 4; ++r) lz[mt][r] = U[(size_t)(row0 + 16 * mt + 4 * g + r) * LDU + C_LZ + chl];
            f32x4 pa[4], px[4];
#pragma unroll
            for (int mt = 0; mt < 4; ++mt) {
                pa[mt] = (f32x4){0.f, 0.f, 0.f, 0.f}; px[mt] = (f32x4){0.f, 0.f, 0.f, 0.f};
#pragma unroll
                for (int s = 0; s < 2; ++s) {
                    const bf16x8 a = *(const LAS bf16x8*)(XCB + (16 * mt + c) * 72 + 32 * s + 8 * g);
                    pa[mt] = mfma16(a, *(const LAS bf16x8*)(WT + jl * 72 + 32 * s + 8 * g), pa[mt]);
                    px[mt] = mfma16(a, *(const LAS bf16x8*)(WT + 4608 + jl * 72 + 32 * s + 8 * g), px[mt]);
                }
            }
#pragma unroll
            for (int mt = 0; mt < 4; ++mt) {
                float a[4], bb[4];
#pragma unroll
                for (int r = 0; r < 4; ++r) {
                    const int t = 16 * mt + 4 * g + r; const float xcv = XC[t * 65 + jl];
                    const float rr = sigm(pa[mt][r] + ba), ii = sigm(px[mt][r] + bx);
                    const float la = -8.f * rr * sp;
                    a[r] = __expf(la); bb[r] = sqrtf(fmaxf(0.f, -expm1f(2.f * la))) * ii * xcv;
                }
                const float P = a[0] * a[1] * a[2] * a[3];
                const float H = ((bb[0] * a[1] + bb[1]) * a[2] + bb[2]) * a[3] + bb[3];
                float hs = hc, hstart = hc;
#pragma unroll
                for (int k = 0; k < 4; ++k) {
                    const float Pk = __shfl(P, c + 16 * k), Hk = __shfl(H, c + 16 * k);
                    hs = Pk * hs + Hk;
                    if (g == k + 1) hstart = hs;
                }
                hc = hs;
                float hh = hstart;
#pragma unroll
                for (int r = 0; r < 4; ++r) {
                    hh = a[r] * hh + bb[r];
                    O[(size_t)(row0 + 16 * mt + 4 * g + r) * DM + 768 + chl] = f2bfs(hh * gelu_tanh(bf2f(lz[mt][r])));
                }
            }
        }
        __syncthreads();
    }
    if (w < 4 && g == 0) outq(C)[O_LRUP + (size_t)(l * NBP + b) * 256 + chl] = hc;
}

__device__ __forceinline__ void gdn_dec_item(Ctx& C, int l, int seq, int h) {
    int tid_ = threadIdx.x; asm volatile("" : "+v"(tid_)); const int tid = tid_, lane = tid & 63, w = __builtin_amdgcn_readfirstlane(tid >> 6);
    LAS float* XQ = (LAS float*)(C.lds);
    LAS float* SCd = (LAS float*)(C.lds + 6144);
    LAS float* RED = (LAS float*)(C.lds + 6400);
    LAS float* SS = (LAS float*)(C.lds + 6400 + 16384);
    const bf16* U = (const bf16*)(wsq(C) + WS_U); bf16* O = (bf16*)(wsq(C) + WS_O);
    const int row0 = MP + seq * 4;
    if (tid < 384) {
        const int which = tid >> 7, cc = tid & 127, ucol = C_Q + which * 512 + h * 128 + cc, wcol = which * 512 + h * 128 + cc;
        float xs[7], cw[4];
#pragma unroll
        for (int k = 0; k < 3; ++k) xs[k] = inptr(I_SGC)[((size_t)(l * NSQ + seq) * 3 + k) * 1536 + wcol];
#pragma unroll
        for (int t = 0; t < 4; ++t) xs[3 + t] = bf2f(U[(size_t)(row0 + t) * LDU + ucol]);
#pragma unroll
        for (int k = 0; k < 4; ++k) cw[k] = inptr(I_GCW)[(size_t)(l * 4 + k) * 1536 + wcol];
#pragma unroll
        for (int t = 0; t < 4; ++t) XQ[t * 384 + tid] = siluf(cw[0] * xs[t] + cw[1] * xs[t + 1] + cw[2] * xs[t + 2] + cw[3] * xs[t + 3]);
#pragma unroll
        for (int k = 0; k < 3; ++k) outq(C)[O_GCS + ((size_t)(l * NSQ + seq) * 3 + k) * 1536 + wcol] = xs[4 + k];
    }
    __syncthreads();
    {
        const int t = w & 3, which = w >> 2;
        const float a = XQ[t * 384 + which * 128 + lane], bq = XQ[t * 384 + which * 128 + 64 + lane];
        const float s = wave_sum(a * a + bq * bq);
        if (lane == 0) SCd[which * 4 + t] = rsqrtf(s + EPS) * (which == 0 ? 0.08838834764831845f : 1.f);
        if (tid < 4) {
            const bf16* ur = U + (size_t)(row0 + tid) * LDU;
            const float g = -__expf(inptr(I_GALOG)[l * 4 + h]) * softplusf(bf2f(ur[C_GA + h]) + inptr(I_GDTB)[l * 4 + h]);
            SCd[8 + tid] = __expf(g); SCd[12 + tid] = sigm(bf2f(ur[C_GB + h]));
        }
    }
    __syncthreads();
    const int e = tid & 127, dq = tid >> 7;
    const size_t sbase = ((size_t)((l * NSQ + seq) * 4 + h) * 128 + dq * 32) * 128 + e;
    float S[32];
#pragma unroll
    for (int i = 0; i < 32; ++i) S[i] = inptr(I_SGDN)[sbase + (size_t)i * 128];
#pragma unroll
    for (int t = 0; t < 4; ++t) {
        const float a = SCd[8 + t], beta = SCd[12 + t], rk = SCd[4 + t], rq = SCd[t];
        const LAS float* kp = XQ + t * 384 + 128 + dq * 32; const LAS float* qp = XQ + t * 384 + dq * 32;
        float part = 0.f;
#pragma unroll
        for (int i = 0; i < 32; ++i) { S[i] *= a; part += kp[i] * S[i]; }
        RED[((t * 2 + 0) * 4 + dq) * 128 + e] = part * rk;
        __syncthreads();
        const float kS = (RED[((t * 2) * 4 + 0) * 128 + e] + RED[((t * 2) * 4 + 1) * 128 + e]) + (RED[((t * 2) * 4 + 2) * 128 + e] + RED[((t * 2) * 4 + 3) * 128 + e]);
        const float dv = beta * (XQ[t * 384 + 256 + e] - kS) * rk;
        float part2 = 0.f;
#pragma unroll
        for (int i = 0; i < 32; ++i) { S[i] += kp[i] * dv; part2 += qp[i] * S[i]; }
        RED[((t * 2 + 1) * 4 + dq) * 128 + e] = part2 * rq;
    }
    __syncthreads();
    {
        const int t = tid >> 7;
        const float o = (RED[((t * 2 + 1) * 4 + 0) * 128 + e] + RED[((t * 2 + 1) * 4 + 1) * 128 + e]) + (RED[((t * 2 + 1) * 4 + 2) * 128 + e] + RED[((t * 2 + 1) * 4 + 3) * 128 + e]);
        const float ss = wave_sum(o * o);
        if (lane == 0) SS[w] = ss;
        __syncthreads();
        const float rs = rsqrtf((SS[2 * t] + SS[2 * t + 1]) * (1.f / 128.f) + EPS);
        const float gz = bf2f(U[(size_t)(row0 + t) * LDU + C_GZ + h * 128 + e]);
        O[(size_t)(row0 + t) * DM + 256 + h * 128 + e] = f2bfs(o * rs * inptr(I_GNORM)[l * 128 + e] * siluf(gz));
    }
#pragma unroll
    for (int i = 0; i < 32; ++i) outq(C)[O_GDNS + sbase + (size_t)i * 128] = S[i];
    __syncthreads();
}
__device__ __forceinline__ void hl_dec_item(Ctx& C, int l, int seq) {
    int tid_ = threadIdx.x; asm volatile("" : "+v"(tid_)); const int tid = tid_, lane = tid & 63, wv_ = 0; (void)wv_;
    LAS float* QK = (LAS float*)(C.lds);
    LAS float* REDh = (LAS float*)(C.lds + 16384);
    LAS float* XCs = (LAS float*)(C.lds + 24576);
    const bf16* U = (const bf16*)(wsq(C) + WS_U); bf16* O = (bf16*)(wsq(C) + WS_O);
    const int row0 = MP + seq * 4;
    if (tid < 256) {
        const int ch = tid; float lb = 0.f;
        if (l == 1) { const float b0 = inptr(I_HGLB)[ch], b1 = inptr(I_HGLB)[256 + ch]; lb = 1.f / (1.f + __expf(b0 - b1)); }
        const float oml = 1.f - lb;
#pragma unroll
        for (int t = 0; t < 4; ++t) {
            const bf16* ur = U + (size_t)(row0 + t) * LDU;
            const float z = bf2f(ur[C_HF + ch]); const float sg = sigm(z);
            QK[t * 256 + ch] = siluf(bf2f(ur[C_HQ + ch])); QK[1024 + t * 256 + ch] = oml * (1.f - sg); QK[2048 + t * 256 + ch] = lb + oml * sg; QK[3072 + t * 256 + ch] = bf2f(ur[C_HI + ch]);
        }
    } else {
        const int ch = tid - 256; float xs[7], cw[4];
#pragma unroll
        for (int k = 0; k < 3; ++k) xs[k] = inptr(I_SLC)[((size_t)(l * NSQ + seq) * 3 + k) * 256 + ch];
#pragma unroll
        for (int t = 0; t < 4; ++t) xs[3 + t] = bf2f(U[(size_t)(row0 + t) * LDU + C_LX + ch]);
#pragma unroll
        for (int k = 0; k < 4; ++k) cw[k] = inptr(I_LCW)[(l * 4 + k) * 256 + ch];
        const float cb = inptr(I_LCB)[l * 256 + ch];
#pragma unroll
        for (int t = 0; t < 4; ++t) XCs[t * 256 + ch] = cw[0] * xs[t] + cw[1] * xs[t + 1] + cw[2] * xs[t + 2] + cw[3] * xs[t + 3] + cb;
#pragma unroll
        for (int k = 0; k < 3; ++k) outq(C)[O_LCS + ((size_t)(l * NSQ + seq) * 3 + k) * 256 + ch] = xs[4 + k];
    }
    __syncthreads();
    {
        const int hh = tid >> 7, dh = (tid >> 6) & 1, e = tid & 63;
        const size_t sbase = ((size_t)((l * NSQ + seq) * 4 + hh) * 64 + dh * 32) * 64 + e;
        float S[32];
#pragma unroll
        for (int i = 0; i < 32; ++i) S[i] = inptr(I_SHG)[sbase + (size_t)i * 64];
#pragma unroll
        for (int t = 0; t < 4; ++t) {
            const float v = QK[3072 + t * 256 + hh * 64 + e]; const int dd = hh * 64 + dh * 32;
            float part = 0.f;
#pragma unroll
            for (int i = 0; i < 32; ++i) { S[i] = QK[2048 + t * 256 + dd + i] * S[i] + QK[1024 + t * 256 + dd + i] * v; part += QK[t * 256 + dd + i] * S[i]; }
            REDh[((t * 4 + hh) * 2 + dh) * 64 + e] = part;
        }
#pragma unroll
        for (int i = 0; i < 32; ++i) outq(C)[O_HGS + sbase + (size_t)i * 64] = S[i];
    }
    __syncthreads();
#pragma unroll
    for (int rep = 0; rep < 2; ++rep) {
        const int id = tid + 512 * rep, t = id >> 8, hh = (id >> 6) & 3, e = id & 63;
        const float o = REDh[((t * 4 + hh) * 2) * 64 + e] + REDh[((t * 4 + hh) * 2 + 1) * 64 + e];
        const float rs = rsqrtf(wave_sum(o * o) * (1.f / 64.f) + EPS);
        const float hz = bf2f(U[(size_t)(row0 + t) * LDU + C_HZ + hh * 64 + e]);
        O[(size_t)(row0 + t) * DM + hh * 64 + e] = f2bfs(o * rs * inptr(I_HGN)[l * 64 + e] * siluf(hz));
    }
    if (tid < 256) {
        const int ch = tid, blk = ch >> 6, jl = ch & 63;
        float pa[4] = {0.f, 0.f, 0.f, 0.f}, px[4] = {0.f, 0.f, 0.f, 0.f};
        const float* wa = inptr(I_LWA) + (size_t)(l * 4 + blk) * 4096 + jl; const float* wx = inptr(I_LWX) + (size_t)(l * 4 + blk) * 4096 + jl;
#pragma unroll 8
        for (int i = 0; i < 64; ++i) {
            const float a = wa[i * 64], x = wx[i * 64];
#pragma unroll
            for (int t = 0; t < 4; ++t) { const float xc = XCs[t * 256 + blk * 64 + i]; pa[t] += xc * a; px[t] += xc * x; }
        }
        const float ba = inptr(I_LBA)[l * 256 + ch], bx = inptr(I_LBX)[l * 256 + ch], sp = softplusf(-inptr(I_LLAM)[l * 256 + ch]);
        float hcur = inptr(I_SLRU)[(size_t)(l * NSQ + seq) * 256 + ch];
#pragma unroll
        for (int t = 0; t < 4; ++t) {
            const float rr = sigm(pa[t] + ba), ii = sigm(px[t] + bx), la = -8.f * rr * sp;
            hcur = __expf(la) * hcur + sqrtf(fmaxf(0.f, -expm1f(2.f * la))) * ii * XCs[t * 256 + ch];
            const float lz = bf2f(U[(size_t)(row0 + t) * LDU + C_LZ + ch]);
            O[(size_t)(row0 + t) * DM + 768 + ch] = f2bfs(hcur * gelu_tanh(lz));
        }
        outq(C)[O_LRUS + (size_t)(l * NSQ + seq) * 256 + ch] = hcur;
    }
    __syncthreads();
}

__device__ __forceinline__ void phase_m1(Ctx& C, int l) {
    int v_ = C.vcu; asm volatile("" : "+s"(v_));
    for (int it = v_; it < 1024; it += C.G) { const int n = it & 31, bh = it >> 5; gdn_prep_item(C, l, bh >> 2, bh & 3, n); }
    const int gw = C.vcu * NWAVES + C.wave, ngw = C.G * NWAVES; int base = 0;
    if (l == 0) {
        tr_job(C, inptr(I_WOUT), (bf16*)(wsq(C) + WS_WOUT), DM, DM, 0, DM, gw, ngw, base);
        tr_job(C, inptr(I_WD), (bf16*)(wsq(C) + WS_WD), DM, DFF, 0, DM, gw, ngw, base);
        tr_job(C, inptr(I_WIN) + (size_t)DM * 3592, (bf16*)(wsq(C) + WS_WIN), 3592, DM, 1, LDU, gw, ngw, base);
    } else {
        tr_job(C, inptr(I_WOUT) + (size_t)DM * DM, (bf16*)(wsq(C) + WS_WOUT), DM, DM, 0, DM, gw, ngw, base);
        tr_job(C, inptr(I_WG) + (size_t)DM * DFF, (bf16*)(wsq(C) + WS_WG), DFF, DM, 0, DFF, gw, ngw, base);
        tr_job(C, inptr(I_WU) + (size_t)DM * DFF, (bf16*)(wsq(C) + WS_WU), DFF, DM, 0, DFF, gw, ngw, base);
        tr_job(C, inptr(I_WD) + (size_t)DFF * DM, (bf16*)(wsq(C) + WS_WD), DM, DFF, 0, DM, gw, ngw, base);
    }
}
__device__ __forceinline__ void cvec_units(Ctx& C, int first, int ashi, int ashi2, bool do1, bool dogu) {
    int vcu_ = C.vcu; asm volatile("" : "+s"(vcu_)); const int r = vcu_ - first; const bf16* ash = (const bf16*)(wsq(C) + WS_ASH) + (size_t)ashi * 256 * DM; const bf16* ash2 = (const bf16*)(wsq(C) + WS_ASH) + (size_t)ashi2 * 256 * DM;
    if (do1) {
        OneUnit S{(r >= 0 && r < 15) ? r : -1};
        pg8::Gemm g{ash, (const bf16*)(wsq(C) + WS_WIN), 256, LDU, DM};
        EpiModCvec E{(float*)(wsq(C) + WS_CV1), LDU, nullptr, NSEQ, 0, nullptr};
        pg8::gemm_phase<EpiModCvec, OneUnit, false, true>(C.lds, g, S, E);
    }
    if (dogu) {
        const int r2 = do1 ? r - 15 : r;
        { OneUnit S{(r2 >= 0 && r2 < 11) ? r2 : -1};
          pg8::Gemm g{ash2, (const bf16*)(wsq(C) + WS_WG), 256, DFF, DM};
          EpiModCvec E{(float*)(wsq(C) + WS_CVG), DFF, nullptr, NSEQ, 0, nullptr};
          pg8::gemm_phase<EpiModCvec, OneUnit, false, true>(C.lds, g, S, E); }
        { OneUnit S{(r2 >= 11 && r2 < 22) ? r2 - 11 : -1};
          pg8::Gemm g{ash2, (const bf16*)(wsq(C) + WS_WU), 256, DFF, DM};
          EpiModCvec E{(float*)(wsq(C) + WS_CVU), DFF, nullptr, NSEQ, 0, nullptr};
          pg8::gemm_phase<EpiModCvec, OneUnit, false, true>(C.lds, g, S, E); }
    }
}
__device__ __forceinline__ void phase_m2(Ctx& C, int l) {
    int v_ = C.vcu; asm volatile("" : "+s"(v_)); const int v = v_;
    if (v < 32) { gdn_chain(C, l, v >> 2, v & 3); }
    else if (v < 64) { const int r = v - 32; hgrn_chain(C, l, r >> 2, r & 3); }
    else if (v < 96) { const int r = v - 64; lru_chain(C, l, r >> 2, r & 3); }
    else {
        if (l == 0) cvec_units(C, 96, 2, 2, true, false);
        else cvec_units(C, 96, 3, 3, false, true);
        const int nw = C.G - 96;
        for (int it = v - 96; it < 640; it += nw) { if (it < 512) gdn_dec_item(C, l, it >> 2, it & 3); else hl_dec_item(C, l, it - 512); }
    }
}

constexpr int NPHASE = 18;
struct Args { const float* in[N_IN]; float* out; unsigned char* ws; int ph_lo, ph_hi; };
static_assert(sizeof(Args) == N_IN * 8 + 24, "Args has no padding");
__global__ void __launch_bounds__(NTHR, 2) mega_fwd(Args args) {
    extern __shared__ __attribute__((aligned(16))) unsigned char lds_raw[];
    Ctx C;
    C.lds = (LAS unsigned char*)lds_raw;
    C.wave = __builtin_amdgcn_readfirstlane((int)threadIdx.x >> 6);
    C.G = gridDim.x; { const int bx = blockIdx.x; C.vcu = (C.G % 8 == 0) ? (bx % 8) * (C.G / 8) + bx / 8 : bx; }
    C.out_ = args.out; C.ws_ = args.ws;
    for (int u = threadIdx.x; u < (LDS_BYTES - LDSCTL_OFF) / 4; u += NTHR) ((LAS unsigned*)(C.lds + LDSCTL_OFF))[u] = 0u;
    __syncthreads();
    const int lo = args.ph_lo, hi = args.ph_hi;
    gu32* ctl = (gu32*)(wsq(C) + WS_CTL);
    XcdBarrier bar; bar.bar = (unsigned*)(ctl + CW_BAR); bar.x = 0; bar.st = nullptr;
    if (hi - lo > 1) bar = xcd_barrier_post((unsigned*)(ctl + CW_BAR), (volatile LAS unsigned*)(C.lds + MISC_OFF) + 8);
#define IN(k) (lo <= (k) && (k) < hi)
#define SEAM(k) do { if (IN(k) && IN((k) + 1)) { XcdBarrier b2_ = bar; asm volatile("" : "+s"(b2_.bar)); xcd_barrier(b2_); } } while (0)
    const float* mod = (const float*)(wsq(C) + WS_MOD);
    float* rss = (float*)(wsq(C) + WS_RSS);
    bf16* XSb = (bf16*)(wsq(C) + WS_XS); bf16* Ub = (bf16*)(wsq(C) + WS_U); bf16* Ob = (bf16*)(wsq(C) + WS_O); bf16* GPb = (bf16*)(wsq(C) + WS_GP); bf16* ACTb = (bf16*)(wsq(C) + WS_ACT);

    if (IN(0)) { phase_p0(C); }
    SEAM(0);
    if (IN(1)) {
        pg8::Gemm g{(const bf16*)(wsq(C) + WS_AC), (const bf16*)(wsq(C) + WS_WADA), 256, 12288, DM};
        pg8::StaticOrder S; S.init(256, 12288, C.G, (int)blockIdx.x);
        EpiModCvec E{(float*)(wsq(C) + WS_MOD), 6144, inptr(I_BADA), NSEQ, 1, (bf16*)(wsq(C) + WS_ASH)};
        pg8::gemm_phase<EpiModCvec, pg8::StaticOrder, false, true>(C.lds, g, S, E);
    }
    SEAM(1);
    if (IN(2)) {
        if (C.vcu < 37) cvec_units(C, 0, 0, 1, true, true);
        else x_to_xs(C, (C.vcu - 37) * NWAVES + C.wave, (C.G - 37) * NWAVES);
    }
    SEAM(2);
#pragma unroll 1
    for (int l = 0; l < 2; ++l) {
        const int p = 3 + 7 * l;
        const float* modl = mod + (size_t)l * NSEQ * 6144;
        if (IN(p)) {
            pg8::Gemm g{XSb, (const bf16*)(wsq(C) + WS_WIN), MROWS, LDU, DM};
            pg8::StaticOrder S; S.init(MROWS, LDU, C.G, (int)blockIdx.x);
            EpiU E{Ub, rss, (const float*)(wsq(C) + WS_CV1), LDU, LDU};
            pg8::gemm_phase<EpiU, pg8::StaticOrder, true, true>(C.lds, g, S, E);
        }
        SEAM(p);
        if (IN(p + 1)) phase_m1(C, l);
        SEAM(p + 1);
        if (IN(p + 2)) phase_m2(C, l);
        SEAM(p + 2);
        if (IN(p + 3)) {
            pg8::Gemm g{Ob, (const bf16*)(wsq(C) + WS_WOUT), MROWS, DM, DM};
            pg8::StaticOrder S; S.init(MROWS, DM, C.G, (int)blockIdx.x);
            EpiRes E{l == 0 ? inptr(I_XP) : outq(C), l == 0 ? inptr(I_XS) : outq(C) + (size_t)MP * DM, outq(C), modl + 2048, modl + 4096, inptr(I_NFFN) + l * DM, XSb, rss};
            pg8::gemm_phase<EpiRes, pg8::StaticOrder, true, true>(C.lds, g, S, E);
        }
        SEAM(p + 3);
        if (IN(p + 4)) {
            pg8::Gemm g{XSb, (const bf16*)(wsq(C) + WS_WG), MROWS, DFF, DM};
            pg8::StaticOrder S; S.init(MROWS, DFF, C.G, (int)blockIdx.x);
            EpiGate E{GPb, rss, (const float*)(wsq(C) + WS_CVG), outq(C) + O_FCP + (size_t)l * NBP * 2 * DFF, outq(C) + O_FCS + (size_t)l * NSQ * 2 * DFF};
            pg8::gemm_phase<EpiGate, pg8::StaticOrder, true, true>(C.lds, g, S, E);
        }
        SEAM(p + 4);
        if (IN(p + 5)) {
            pg8::Gemm g{XSb, (const bf16*)(wsq(C) + WS_WU), MROWS, DFF, DM};
            pg8::StaticOrder S; S.init(MROWS, DFF, C.G, (int)blockIdx.x);
            EpiUp E{ACTb, GPb, rss, (const float*)(wsq(C) + WS_CVU), inptr(I_FCW) + (size_t)l * 3 * DFF, inptr(I_FCB) + (size_t)l * DFF, inptr(I_SFC) + (size_t)l * NSQ * 2 * DFF};
            pg8::gemm_phase<EpiUp, pg8::StaticOrder, true, true>(C.lds, g, S, E);
        }
        SEAM(p + 5);
        if (IN(p + 6)) {
            pg8::Gemm g{ACTb, (const bf16*)(wsq(C) + WS_WD), MROWS, DM, DFF};
            pg8::StaticOrder S; S.init(MROWS, DM, C.G, (int)blockIdx.x);
            const float* mod1 = mod + (size_t)NSEQ * 6144;
            EpiRes E{outq(C), outq(C) + (size_t)MP * DM, outq(C), modl + 5120, l == 0 ? mod1 + 1024 : nullptr, inptr(I_NMIX) + DM, XSb, rss};
            pg8::gemm_phase<EpiRes, pg8::StaticOrder, true, true>(C.lds, g, S, E);
        }
        SEAM(p + 6);
    }
    if (IN(17)) phase_final(C);
#undef IN
#undef SEAM
}

#ifndef MK_PER_PHASE
#define MK_PER_PHASE 0
#endif
extern "C" void kernel_launch(void* const* d_in, const int* in_sizes, int n_in, void* d_out, int out_size, void* d_ws, size_t ws_size, hipStream_t stream) {
    static int grid = 0;
    if (grid == 0) {
        int dev = 0, cus = 0;
        if (n_in != N_IN || (size_t)out_size != O_END || ws_size < WS_END) { fprintf(stderr, "kernel_launch: unexpected problem (n_in %d, out %d, ws %zu)\n", n_in, out_size, ws_size); grid = -1; return; }
        if (hipGetDevice(&dev) != hipSuccess || hipDeviceGetAttribute(&cus, hipDeviceAttributeMultiprocessorCount, dev) != hipSuccess) { grid = -1; return; }
        if (hipFuncSetAttribute((const void*)mega_fwd, hipFuncAttributeMaxDynamicSharedMemorySize, LDS_BYTES) != hipSuccess) { fprintf(stderr, "kernel_launch: hipFuncSetAttribute failed\n"); grid = -1; return; }
        int per_cu = 0;
        if (hipOccupancyMaxActiveBlocksPerMultiprocessor(&per_cu, (const void*)mega_fwd, NTHR, LDS_BYTES) != hipSuccess || per_cu < 1) fprintf(stderr, "kernel_launch: occupancy query says %d blocks per CU\n", per_cu);
        (void)hipGetLastError();
        grid = cus;
    }
    if (grid < 0) return;
    (void)hipMemsetAsync((char*)d_ws + WS_CTL, 0, CTL_ZERO_BYTES, stream);
    Args a{};
    for (int i = 0; i < N_IN; ++i) a.in[i] = (const float*)d_in[i];
    a.out = (float*)d_out; a.ws = (unsigned char*)d_ws;
#if MK_PER_PHASE
    for (int p = 0; p < NPHASE; ++p) { a.ph_lo = p; a.ph_hi = p + 1; hipLaunchKernelGGL(mega_fwd, dim3(grid), dim3(NTHR), LDS_BYTES, stream, a); }
#else
    a.ph_lo = 0; a.ph_hi = NPHASE;
    hipLaunchKernelGGL(mega_fwd, dim3(grid), dim3(NTHR), LDS_BYTES, stream, a);
#endif
}
```

```cpp
#include <hip/hip_runtime.h>
#include <cstdio>
#include <cstdint>
namespace pg8 {
#define PG8_LAS __attribute__((address_space(3)))
typedef unsigned short bf16_t;
typedef short bf16x8 __attribute__((ext_vector_type(8)));
typedef float f32x4 __attribute__((ext_vector_type(4)));
typedef unsigned u32x4 __attribute__((ext_vector_type(4)));
constexpr int BM = 256, BK = 64, HALF = 128, HTB = HALF * BK * 2  , STAGE_BYTES = 8 * HTB, NXCD = 8, WGM = 8;

__host__ __device__ __forceinline__ int lds_byte(int r, int c) { const int st = (r >> 4) * 2 + (c >> 5), rr = r & 15, cc = c & 31, ob = rr * 64 + cc * 2; return st * 1024 + (ob ^ (((ob >> 9) & 1) << 5)); }
__host__ __device__ __forceinline__ void stage_rc(int b, int& R, int& C) { const int st = b / 1024, sb = b % 1024, swz = sb ^ (((sb >> 9) & 1) << 5); R = (st >> 1) * 16 + swz / 64; C = (st & 1) * 32 + (swz % 64) / 2; }
__host__ __device__ __forceinline__ int perm32(int rho) { const int n = rho >> 4, i = rho & 15; return 8 * (i >> 2) + 4 * n + (i & 3); }

struct Unit { int pm, pn; };
struct Gemm { const bf16_t* A; const bf16_t* Bt; int M, N, K; };

struct StaticOrder {
    int nM, nN, nwg, G, c;
    __host__ __device__ void init(int M, int N, int G_, int c_) { nM = M / BM; nN = N / BM; nwg = nM * nN; G = G_; c = c_; }
    __host__ __device__ bool next(int i, Unit& u) const {
        const long L = (long)i * G + c; if (L >= nwg) return false;
        int wgid = (int)L; { const int q = nwg / NXCD, r = nwg % NXCD, xcd = wgid % NXCD, off = wgid / NXCD; wgid = (xcd < r ? xcd * (q + 1) : r * (q + 1) + (xcd - r) * q) + off; }
        const int nig = WGM * nN, gid = wgid / nig, fm = gid * WGM, gsz = (nM - fm) < WGM ? (nM - fm) : WGM;
        u.pm = fm + ((wgid % nig) % gsz); u.pn = (wgid % nig) / gsz; return true;
    }
    __device__ __forceinline__ void a_ready(const Unit&) const {}
    __device__ __forceinline__ void done(const Unit&) const {}
};

__device__ __forceinline__ unsigned cvt_pk_bf16(float lo, float hi) { unsigned r; asm volatile("v_cvt_pk_bf16_f32 %0, %1, %2" : "=v"(r) : "v"(lo), "v"(hi)); return r; }
template <class Epi, class Sched, bool ALIGN_EPI = false, bool SP2 = false>
__device__ __forceinline__ void gemm_phase(PG8_LAS unsigned char* lds, const Gemm g, const Sched& S, const Epi& E) {
    int tid_ = threadIdx.x; asm volatile("" : "+v"(tid_)); const int tid = tid_, wid = __builtin_amdgcn_readfirstlane(tid >> 6), lane = tid & 63, wr = wid >> 2, wc = wid & 3, fr = lane & 15, fq = lane >> 4;
    const int K = g.K, nt = K / BK;
    unsigned voffA[2], voffB[2];
#pragma unroll
    for (int i = 0; i < 2; ++i) { int R, C; stage_rc(tid * 16 + i * 8192, R, C); const int Rb = Epi::PERM ? ((R & ~31) + perm32(R & 31)) : R;
        voffA[i] = (unsigned)(R * K + C) * 2u; voffB[i] = (unsigned)(Rb * K + C) * 2u; }
    const size_t kstep = (size_t)(BK * 2);
    const size_t hstep = (size_t)HALF * K * 2;
    const size_t tstep = 2 * hstep;
    const unsigned ldsw = (unsigned)wid * 1024u;
    const int aoff = lds_byte(wr * 64 + fr, fq * 8), boff = lds_byte(wc * 32 + fr, fq * 8);
#define PG8_SA(b, h) (((b) * 2 + (h)) * HTB)
#define PG8_SB(b, h) ((4 + (b) * 2 + (h)) * HTB)
#define PG8_STAGE(bufoff, gbase, voff) do { _Pragma("unroll") for (int _i = 0; _i < 2; ++_i) \
        __builtin_amdgcn_global_load_lds((const unsigned*)((const char*)(gbase) + (voff)[_i]), (PG8_LAS unsigned*)(lds + (bufoff) + ldsw + _i * 8192), 16, 0, 0); } while (0)
#define PG8_LDA(dst, b, h) do { _Pragma("unroll") for (int m = 0; m < 4; ++m) _Pragma("unroll") for (int k = 0; k < 2; ++k) dst[m][k] = *(const PG8_LAS bf16x8*)(lds + PG8_SA(b, h) + aoff + m * 2048 + k * 1024); } while (0)
#define PG8_LDB(dst, b, h) do { _Pragma("unroll") for (int n = 0; n < 2; ++n) _Pragma("unroll") for (int k = 0; k < 2; ++k) dst[n][k] = *(const PG8_LAS bf16x8*)(lds + PG8_SB(b, h) + boff + n * 2048 + k * 1024); } while (0)
#define PG8_MMA(ai, bj, At, Bt) do { __builtin_amdgcn_s_setprio(1); _Pragma("unroll") for (int m = 0; m < 4; ++m) _Pragma("unroll") for (int n = 0; n < 2; ++n) _Pragma("unroll") for (int k = 0; k < 2; ++k) \
        acc[ai][bj][m][n] = __builtin_amdgcn_mfma_f32_16x16x32_bf16(Bt[n][k], At[m][k], acc[ai][bj][m][n], 0, 0, 0); __builtin_amdgcn_s_setprio(0); } while (0)
#define PG8_WAIT_V(n) asm volatile("s_waitcnt vmcnt(" #n ")" ::: "memory")
#define PG8_WAIT_L(n) asm volatile("s_waitcnt lgkmcnt(" #n ")" ::: "memory")
#define PG8_BAR __builtin_amdgcn_s_barrier()
#define PG8_SCHED __builtin_amdgcn_sched_barrier(0)
    Unit cur, nxt; int ui = 0;
    if (!S.next(0, cur)) return;
    f32x4 acc[2][2][4][2];
#pragma unroll
    for (int a = 0; a < 2; ++a)
#pragma unroll
        for (int b = 0; b < 2; ++b)
#pragma unroll
            for (int m = 0; m < 4; ++m)
#pragma unroll
                for (int n = 0; n < 2; ++n) acc[a][b][m][n] = (f32x4){0.f, 0.f, 0.f, 0.f};
    bf16x8 At[4][2], B0[2][2], B1[2][2];
    const char* cA = (const char*)g.A + (size_t)cur.pm * tstep; const char* cB = (const char*)g.Bt + (size_t)cur.pn * tstep;
    S.a_ready(cur);
    if constexpr (SP2) {
        PG8_STAGE(PG8_SB(0, 0), cB, voffB); PG8_STAGE(PG8_SB(0, 1), cB + hstep, voffB); PG8_STAGE(PG8_SA(0, 0), cA, voffA); PG8_STAGE(PG8_SA(0, 1), cA + hstep, voffA);
        if (wr == 1) PG8_BAR;
        PG8_WAIT_V(2); PG8_BAR;
        PG8_STAGE(PG8_SB(1, 0), cB + kstep, voffB); PG8_STAGE(PG8_SA(1, 0), cA + kstep, voffA); PG8_STAGE(PG8_SB(1, 1), cB + hstep + kstep, voffB);
        PG8_WAIT_V(6); PG8_BAR;
    } else {
        PG8_STAGE(PG8_SB(0, 0), cB, voffB); PG8_STAGE(PG8_SA(0, 0), cA, voffA); PG8_STAGE(PG8_SB(0, 1), cB + hstep, voffB); PG8_STAGE(PG8_SA(0, 1), cA + hstep, voffA);
        if (wr == 1) PG8_BAR;
        PG8_WAIT_V(4); PG8_BAR;
        PG8_STAGE(PG8_SB(1, 0), cB + kstep, voffB); PG8_STAGE(PG8_SA(1, 0), cA + kstep, voffA); PG8_STAGE(PG8_SB(1, 1), cB + hstep + kstep, voffB);
        PG8_WAIT_V(6); PG8_BAR;
    }
    for (;;) {
        const bool has_next = S.next(ui + 1, nxt);
        const char* nA = has_next ? (const char*)g.A + (size_t)nxt.pm * tstep : cA; const char* nB = has_next ? (const char*)g.Bt + (size_t)nxt.pn * tstep : cB;
        for (int t = 0; t < nt; t += 2) {
            const bool last = (t == nt - 2);
            const char* a1 = cA + (size_t)(t + 1) * kstep;
            const char* a2 = last ? nA : cA + (size_t)(t + 2) * kstep; const char* b2 = last ? nB : cB + (size_t)(t + 2) * kstep;
            const char* a3 = a2 + kstep; const char* b3 = b2 + kstep;
            if (last && has_next) S.a_ready(nxt);
            if constexpr (SP2) {
            PG8_LDB(B0, 0, 0); PG8_LDB(B1, 0, 1); PG8_SCHED; PG8_LDA(At, 0, 0); PG8_STAGE(PG8_SA(1, 1), a1 + hstep, voffA);
            PG8_WAIT_V(8); PG8_WAIT_L(0); PG8_BAR; PG8_MMA(0, 0, At, B0); PG8_MMA(0, 1, At, B1); PG8_BAR; PG8_SCHED;
            PG8_LDA(At, 0, 1); PG8_STAGE(PG8_SB(0, 0), b2, voffB); PG8_STAGE(PG8_SB(0, 1), b2 + hstep, voffB); PG8_STAGE(PG8_SA(0, 0), a2, voffA);
            PG8_WAIT_V(8); PG8_WAIT_L(0); PG8_BAR; PG8_MMA(1, 0, At, B0); PG8_MMA(1, 1, At, B1); PG8_BAR; PG8_SCHED;
            PG8_LDB(B0, 1, 0); PG8_LDB(B1, 1, 1); PG8_SCHED; PG8_LDA(At, 1, 0); PG8_STAGE(PG8_SA(0, 1), a2 + hstep, voffA);
            PG8_WAIT_V(8); PG8_WAIT_L(0); PG8_BAR; PG8_MMA(0, 0, At, B0); PG8_MMA(0, 1, At, B1); PG8_BAR; PG8_SCHED;
            PG8_LDA(At, 1, 1); PG8_STAGE(PG8_SB(1, 0), b3, voffB); PG8_STAGE(PG8_SB(1, 1), b3 + hstep, voffB); PG8_STAGE(PG8_SA(1, 0), a3, voffA);
            PG8_WAIT_V(8); PG8_WAIT_L(0); PG8_BAR; PG8_MMA(1, 0, At, B0); PG8_MMA(1, 1, At, B1); PG8_BAR; PG8_SCHED;
            } else {
            PG8_LDB(B0, 0, 0); PG8_SCHED; PG8_LDA(At, 0, 0); PG8_STAGE(PG8_SA(1, 1), a1 + hstep, voffA);
            PG8_WAIT_L(8); PG8_BAR; PG8_WAIT_L(0); PG8_MMA(0, 0, At, B0); PG8_BAR; PG8_SCHED;
            PG8_LDB(B1, 0, 1); PG8_STAGE(PG8_SB(0, 0), b2, voffB);
            PG8_BAR; PG8_WAIT_L(0); PG8_MMA(0, 1, At, B1); PG8_BAR;
            PG8_LDA(At, 0, 1); PG8_STAGE(PG8_SA(0, 0), a2, voffA);
            PG8_BAR; PG8_WAIT_L(0); PG8_MMA(1, 0, At, B0); PG8_BAR; PG8_SCHED;
            PG8_STAGE(PG8_SB(0, 1), b2 + hstep, voffB);
            PG8_WAIT_V(6); PG8_BAR; PG8_MMA(1, 1, At, B1); PG8_BAR;
            PG8_LDB(B0, 1, 0); PG8_SCHED; PG8_LDA(At, 1, 0); PG8_STAGE(PG8_SA(0, 1), a2 + hstep, voffA);
            PG8_WAIT_L(8); PG8_BAR; PG8_WAIT_L(0); PG8_MMA(0, 0, At, B0); PG8_BAR; PG8_SCHED;
            PG8_LDB(B1, 1, 1); PG8_STAGE(PG8_SB(1, 0), b3, voffB);
            PG8_BAR; PG8_WAIT_L(0); PG8_MMA(0, 1, At, B1); PG8_BAR;
            PG8_LDA(At, 1, 1); PG8_STAGE(PG8_SA(1, 0), a3, voffA);
            PG8_BAR; PG8_WAIT_L(0); PG8_MMA(1, 0, At, B0); PG8_BAR; PG8_SCHED;
            PG8_STAGE(PG8_SB(1, 1), b3 + hstep, voffB);
            PG8_WAIT_V(6); PG8_BAR; PG8_MMA(1, 1, At, B1); PG8_BAR;
            }
        }
        if constexpr (ALIGN_EPI) { if (wr == 0) PG8_BAR; }
        if constexpr (!Epi::AFTER_DRAIN) { E(acc, cur, wr, wc, fr, fq); S.done(cur); }
        if (!has_next) break;
#pragma unroll
        for (int a = 0; a < 2; ++a)
#pragma unroll
            for (int b = 0; b < 2; ++b)
#pragma unroll
                for (int m = 0; m < 4; ++m)
#pragma unroll
                    for (int n = 0; n < 2; ++n) acc[a][b][m][n] = (f32x4){0.f, 0.f, 0.f, 0.f};
        cur = nxt; cA = nA; cB = nB; ++ui;
        if constexpr (ALIGN_EPI) { if (wr == 1) PG8_BAR; }
    }
    PG8_WAIT_V(0);
    if constexpr (!ALIGN_EPI) { if (wr == 0) PG8_BAR; }
    PG8_BAR;
    if constexpr (Epi::AFTER_DRAIN) { E.fused(acc, cur, wr, wc, fr, fq, lds, wid, lane); S.done(cur); }
#undef PG8_SA
#undef PG8_SB
#undef PG8_STAGE
#undef PG8_LDA
#undef PG8_LDB
#undef PG8_MMA
#undef PG8_WAIT_V
#undef PG8_WAIT_L
#undef PG8_BAR
#undef PG8_SCHED
}
}
#define GAS __attribute__((address_space(1)))
#define LAS __attribute__((address_space(3)))
typedef unsigned short bf16;
typedef unsigned v4u __attribute__((ext_vector_type(4)));
typedef float f32x4 __attribute__((ext_vector_type(4)));
typedef short bf16x8 __attribute__((ext_vector_type(8)));
typedef GAS unsigned gu32;
typedef GAS unsigned long long gu64;
#define RLX_AGENT __ATOMIC_RELAXED, __HIP_MEMORY_SCOPE_AGENT
#define LDS_WAIT() asm volatile("s_waitcnt lgkmcnt(0)" ::: "memory")
#define VM_WAIT() asm volatile("s_waitcnt vmcnt(0)" ::: "memory")
__device__ __forceinline__ unsigned long long rt() { return __builtin_amdgcn_s_memrealtime(); }
__device__ __forceinline__ unsigned f2bf(float f) { unsigned u = __builtin_bit_cast(unsigned, f); return (u + 0x7fffu + ((u >> 16) & 1u)) >> 16; }
__device__ __forceinline__ unsigned pk2(float lo, float hi) { unsigned r; asm("v_cvt_pk_bf16_f32 %0, %1, %2" : "=v"(r) : "v"(lo), "v"(hi)); return r; }

#define XB_TMO      128
#define XB_XCNT(j)  (256  + 64 * (j))
#define XB_XSUB(j)  (1280 + 64 * (j))
#define XB_XGEN(j)  (2304 + 64 * (j))
#define XB_TOP      3328
#define XB_TOPGEN   3392
#define XCD_BAR_WORDS 3456
#define XB_SPIN_CAP (1u << 18)

__device__ __forceinline__ unsigned xb_ld(unsigned* p)              { return __hip_atomic_load(p, __ATOMIC_RELAXED, __HIP_MEMORY_SCOPE_AGENT); }
__device__ __forceinline__ unsigned xb_add(unsigned* p, unsigned v) { return __hip_atomic_fetch_add(p, v, __ATOMIC_RELAXED, __HIP_MEMORY_SCOPE_AGENT); }
__device__ __forceinline__ unsigned xb_xcc_id() { return (unsigned)__builtin_amdgcn_s_getreg((3 << 11) | 20) & 0xFu; }
#define XB_SPIN(cond, bar) do { unsigned _sp = 0; while (cond) { __builtin_amdgcn_s_sleep(1); \
    if ((++_sp & 255u) == 0u) { if (xb_ld(&(bar)[XB_TMO])) break; if (_sp > XB_SPIN_CAP) { atomicAdd(&(bar)[XB_TMO], 1u); break; } } } } while (0)

struct XcdBarrier {
    unsigned* bar; unsigned x;
    volatile LAS unsigned* st;
};

__device__ __forceinline__ XcdBarrier xcd_barrier_post(unsigned* bar, volatile LAS unsigned* st) {
    XcdBarrier b; b.bar = bar; b.x = xb_xcc_id(); b.st = st;
    if (threadIdx.x == 0) (void)xb_add(&bar[XB_XCNT(b.x)], 1u);
    return b;
}
__device__ __forceinline__ void xcd_barrier_complete(unsigned* bar, unsigned x, unsigned& nloc, unsigned& nx) {
    const unsigned G = gridDim.x * gridDim.y * gridDim.z;
    unsigned sum, cnt, mine, sp = 0u;
    for (;;) {
        sum = 0u; cnt = 0u; mine = 0u;
#pragma unroll
        for (unsigned j = 0; j < 16; ++j) { const unsigned c = xb_ld(&bar[XB_XCNT(j)]); sum += c; cnt += (c > 0u) ? 1u : 0u; mine = (j == x) ? c : mine; }
        if (sum == G) break;
        __builtin_amdgcn_s_sleep(1);
        if ((++sp & 255u) == 0u) { if (xb_ld(&bar[XB_TMO])) break; if (sp > XB_SPIN_CAP) { atomicAdd(&bar[XB_TMO], 1u); break; } }
    }
    nloc = mine > 0u ? mine : 1u; nx = cnt > 0u ? cnt : 1u;
}

__device__ __forceinline__ void xcd_barrier(const XcdBarrier& b) {
    asm volatile("s_waitcnt vmcnt(0)" ::: "memory");
    __syncthreads();
    if (threadIdx.x == 0) {
        unsigned* bar = b.bar;
        __builtin_amdgcn_s_waitcnt(0);
        unsigned nloc = b.st[0], nx = b.st[1];
        if (nloc == 0u) { xcd_barrier_complete(bar, b.x, nloc, nx); b.st[0] = nloc; b.st[1] = nx; }
        const unsigned old = xb_add(&bar[XB_XSUB(b.x)], 1u);
        const unsigned gen = old / nloc;
        if (old + 1u == (gen + 1u) * nloc) {
            __builtin_amdgcn_fence(__ATOMIC_RELEASE, "agent");
            asm volatile("s_waitcnt vmcnt(0)" ::: "memory");
            const unsigned og = xb_add(&bar[XB_TOP], 1u);
            const unsigned tg = og / nx;
            if (og + 1u == (tg + 1u) * nx) xb_add(&bar[XB_TOPGEN], 1u);
            else XB_SPIN(xb_ld(&bar[XB_TOPGEN]) == tg, bar);
            __builtin_amdgcn_fence(__ATOMIC_ACQUIRE, "agent");
            xb_add(&bar[XB_XGEN(b.x)], 1u);
            asm volatile("s_waitcnt vmcnt(0)" ::: "memory");
        } else {
            XB_SPIN(xb_ld(&bar[XB_XGEN(b.x)]) == gen, bar);
            __builtin_amdgcn_fence(__ATOMIC_ACQUIRE, "agent");
            asm volatile("s_waitcnt vmcnt(0)" ::: "memory");
        }
    }
    __syncthreads();
}
constexpr int NWAVES = 8, NTHR = 512;
constexpr int DM = 1024, TSEQ = 2048, NBP = 8, NSQ = 128, TSMP = 4, NSEQ = 136;
constexpr int MP = 16384, MROWS = 16896;
constexpr int DFF = 2816, LDU = 3840;
constexpr float EPS = 1e-6f;
constexpr int C_HQ = 0, C_HF = 256, C_HI = 512, C_HZ = 768, C_Q = 1024, C_K = 1536, C_V = 2048, C_GZ = 2560, C_LX = 3072, C_LZ = 3328, C_GA = 3584, C_GB = 3588;
enum { I_XP = 0, I_XS, I_SHG, I_SGDN, I_SGC, I_SLRU, I_SLC, I_SFC, I_CP, I_CS, I_NMIX, I_NFFN, I_WADA, I_BADA, I_WIN, I_HGLB, I_HGN, I_GCW, I_GALOG, I_GDTB, I_GNORM,
       I_LCW, I_LCB, I_LWA, I_LBA, I_LWX, I_LBX, I_LLAM, I_WOUT, I_WG, I_WU, I_FCW, I_FCB, I_WD, I_FNORM, N_IN };
constexpr size_t O_YP = 0, O_YS = 16777216, O_HGP = 17301504, O_GDNP = 17563648, O_GCP = 18612224, O_LRUP = 18685952, O_LCP = 18690048, O_FCP = 18702336,
                 O_HGS = 18792448, O_GDNS = 22986752, O_GCS = 39763968, O_LRUS = 40943616, O_LCS = 41009152, O_FCS = 41205760, O_END = 42647552;
constexpr size_t MiB = 1u << 20;
constexpr size_t WS_CTL = 0, CTL_ZERO_BYTES = 65536;
constexpr size_t WS_WIN = 1 * MiB;
constexpr size_t WS_WOUT = 9 * MiB;
constexpr size_t WS_WG = 11 * MiB;
constexpr size_t WS_WU = 17 * MiB;
constexpr size_t WS_WD = 23 * MiB;
constexpr size_t WS_AC = 29 * MiB;
constexpr size_t WS_ASH = 30 * MiB;
constexpr size_t WS_MOD = 32 * MiB;
constexpr size_t WS_CV1 = 39 * MiB;
constexpr size_t WS_CVG = 41 * MiB;
constexpr size_t WS_CVU = 43 * MiB;
constexpr size_t WS_RSS = 45 * MiB;
constexpr size_t WS_XS = 47 * MiB;
constexpr size_t WS_PQ = 47 * MiB, WS_PK = 63 * MiB;
constexpr size_t WS_U = 80 * MiB;
constexpr size_t WS_O = 204 * MiB;
constexpr size_t WS_WADA = 204 * MiB;
constexpr size_t WS_PW = 237 * MiB, WS_PU = 253 * MiB, WS_PA = 269 * MiB, WS_EGL = 277 * MiB;
constexpr size_t WS_GP = 80 * MiB;
constexpr size_t WS_ACT = 171 * MiB;
constexpr size_t WS_LSUM = 277 * MiB + 65536;
constexpr size_t WS_ACUM = 278 * MiB, WS_HLOC = 286 * MiB;
constexpr size_t WS_END = 294 * MiB;
constexpr int CW_BAR = 4096;
constexpr int CW_GCNT = 8192;
constexpr int CW_LCNT = 12288;
constexpr int LDS_BYTES = 163840, LDSCTL_OFF = 162816, MISC_OFF = LDSCTL_OFF + 320;

typedef float f32x2 __attribute__((ext_vector_type(2)));
typedef unsigned u32x2 __attribute__((ext_vector_type(2)));
struct Ctx {
    LAS unsigned char* lds_;
    int wave, vcu, G;
    float* out_; unsigned char* ws_;
};
__device__ __forceinline__ LAS unsigned char* ldsq(const Ctx& C) { LAS unsigned char* p = C.lds_; asm volatile("" : "+s"(p)); return p; }
__device__ __forceinline__ int bxq() { int b = (int)blockIdx.x; asm volatile("" : "+s"(b)); return b; }
__device__ __forceinline__ unsigned char* wsq(const Ctx& C) { unsigned char* p = C.ws_; asm volatile("" : "+s"(p)); return p; }
__device__ __forceinline__ float* outq(const Ctx& C) { float* p = C.out_; asm volatile("" : "+s"(p)); return p; }
__device__ __forceinline__ const float* inptr(int i) {
    unsigned long long ka = (unsigned long long)__builtin_amdgcn_kernarg_segment_ptr();
    asm volatile("" : "+s"(ka));
    return *(const float* const __attribute__((address_space(4)))*)(ka + 8ull * (unsigned)i);
}
__device__ __forceinline__ float bf2f(unsigned short h) { return __builtin_bit_cast(float, (unsigned)h << 16); }
__device__ __forceinline__ float bflo(unsigned w) { return __builtin_bit_cast(float, w << 16); }
__device__ __forceinline__ float bfhi(unsigned w) { return __builtin_bit_cast(float, w & 0xffff0000u); }
__device__ __forceinline__ unsigned short f2bfs(float f) { return (unsigned short)(pk2(f, f) & 0xffffu); }
__device__ __forceinline__ float sigm(float x) { return __builtin_amdgcn_rcpf(1.f + __expf(-x)); }
__device__ __forceinline__ float siluf(float x) { return x * __builtin_amdgcn_rcpf(1.f + __expf(-x)); }
__device__ __forceinline__ float softplusf(float x) { return x > 20.f ? x : log1pf(__expf(x)); }
__device__ __forceinline__ float gelu_tanh(float x) { const float u = 0.7978845608028654f * (x + 0.044715f * x * x * x); return x * __builtin_amdgcn_rcpf(1.f + __expf(-2.f * u)); }
__device__ __forceinline__ float dpp_sum16(float v) {
    v += __builtin_bit_cast(float, __builtin_amdgcn_update_dpp(0, __builtin_bit_cast(int, v), 0xB1, 0xF, 0xF, true));
    v += __builtin_bit_cast(float, __builtin_amdgcn_update_dpp(0, __builtin_bit_cast(int, v), 0x4E, 0xF, 0xF, true));
    v += __builtin_bit_cast(float, __builtin_amdgcn_update_dpp(0, __builtin_bit_cast(int, v), 0x141, 0xF, 0xF, true));
    v += __builtin_bit_cast(float, __builtin_amdgcn_update_dpp(0, __builtin_bit_cast(int, v), 0x140, 0xF, 0xF, true));
    return v;
}
__device__ __forceinline__ int permpos(int d) { return 8 * ((d >> 2) & 3) + 4 * ((d >> 4) & 1) + (d & 3); }
__device__ __forceinline__ int seq_of_row(int row) { return row < MP ? (row >> 11) : NBP + ((row - MP) >> 2); }
__device__ __forceinline__ bf16x8 pack8(const f32x4 a, const f32x4 b) {
    v4u w; w.x = pk2(a.x, a.y); w.y = pk2(a.z, a.w); w.z = pk2(b.x, b.y); w.w = pk2(b.z, b.w); return __builtin_bit_cast(bf16x8, w);
}
__device__ __forceinline__ f32x4 mfma16(const bf16x8 a, const bf16x8 b, const f32x4 c) { return __builtin_amdgcn_mfma_f32_16x16x32_bf16(a, b, c, 0, 0, 0); }
__device__ __forceinline__ void glds16(const void* g, LAS unsigned char* l) { __builtin_amdgcn_global_load_lds((const unsigned*)g, (LAS unsigned*)l, 16, 0, 0); }
__device__ __forceinline__ float rstd_of(const float* rss, int row) {
    const f32x4* p = (const f32x4*)(rss + (size_t)row * 16); const f32x4 a = p[0], b = p[1], c = p[2], d = p[3];
    const float s = ((a.x + a.y) + (a.z + a.w)) + ((b.x + b.y) + (b.z + b.w)) + ((c.x + c.y) + (c.z + c.w)) + ((d.x + d.y) + (d.z + d.w));
    return rsqrtf(s * (1.f / DM) + EPS);
}

struct EpiModCvec {
    static constexpr bool PERM = false, AFTER_DRAIN = false;
    float* C; int ldc; const float* bias; int rowmax; int adaln; bf16* ash;
    __device__ __forceinline__ void operator()(const f32x4 (&acc)[2][2][4][2], const pg8::Unit& u, int wr, int wc, int fr, int fq) const {
        const int colb = u.pn * 256 + wc * 32 + 4 * fq;
#pragma unroll
        for (int ai = 0; ai < 2; ++ai)
#pragma unroll
            for (int m = 0; m < 4; ++m) {
                const int row = ai * 128 + wr * 64 + m * 16 + fr;
                if (row < rowmax) {
#pragma unroll
                    for (int bj = 0; bj < 2; ++bj)
#pragma unroll
                        for (int n = 0; n < 2; ++n) {
                            const int col = colb + bj * 128 + n * 16; f32x4 v = acc[ai][bj][m][n];
                            if (adaln) {
                                const int l = col / 6144, cl = col - l * 6144, chunk = cl >> 10;
                                v = v + *(const f32x4*)(bias + col);
                                *(f32x4*)(C + ((size_t)l * NSEQ + row) * 6144 + cl) = v;
                                if (chunk == 0 || chunk == 3) { u32x2 w; w.x = pk2(v.x, v.y); w.y = pk2(v.z, v.w); *(u32x2*)(ash + ((size_t)(2 * l + (chunk == 3)) * 256 + row) * DM + (cl & 1023)) = w; }
                            } else {
                                *(f32x4*)(C + (size_t)row * ldc + col) = v;
                            }
                        }
                }
            }
    }
};
constexpr int EPL_OFF = 131072;
#define EPLP ((LAS float*)(size_t)EPL_OFF)
template <int NV>
__device__ __forceinline__ void epi_stage(LAS float* epl, const float* rss, int pm, int pn, const float* v0, const float* v1, const float* v2, const float* v3, const float* v4) {
    const int tid = threadIdx.x;
    if (tid < 256) { if (rss) epl[tid] = rstd_of(rss, pm * 256 + tid); }
    else {
        const int cl = tid - 256, col = pn * 256 + cl;
        if (NV > 0 && v0) epl[256 + cl] = v0[col];
        if (NV > 1 && v1) epl[512 + cl] = v1[col];
        if (NV > 2 && v2) epl[768 + cl] = v2[col];
        if (NV > 3 && v3) epl[1024 + cl] = v3[col];
        if (NV > 4 && v4) epl[1280 + cl] = v4[col];
    }
    asm volatile("s_waitcnt vmcnt(0) lgkmcnt(0)" ::: "memory");
    __builtin_amdgcn_s_barrier();
    asm volatile("" ::: "memory");
}
struct EpiU {
    static constexpr bool PERM = true, AFTER_DRAIN = false;
    bf16* U; const float* rss; const float* cvec; int ldo; int ldcv;
    __device__ __forceinline__ void operator()(const f32x4 (&acc)[2][2][4][2], const pg8::Unit& u, int wr, int wc, int fr, int fq) const {
        const bool prm = u.pm < 64;
        epi_stage<1>(EPLP, rss, u.pm, u.pn, prm ? cvec + (size_t)(u.pm >> 3) * ldcv : nullptr, nullptr, nullptr, nullptr, nullptr);
        const int cl = wc * 32 + 8 * fq, colb = u.pn * 256 + cl;
#pragma unroll
        for (int ai = 0; ai < 2; ++ai)
#pragma unroll
            for (int m = 0; m < 4; ++m) {
                const int rl = ai * 128 + wr * 64 + m * 16 + fr, row = u.pm * 256 + rl;
                const float rs = EPLP[rl];
                bf16* op = U + (size_t)row * ldo + colb;
#pragma unroll
                for (int bj = 0; bj < 2; ++bj) {
                    f32x4 c0, c1;
                    if (prm) { c0 = *(const LAS f32x4*)(EPLP + 256 + cl + bj * 128); c1 = *(const LAS f32x4*)(EPLP + 256 + cl + bj * 128 + 4); }
                    else { const float* cv = cvec + (size_t)seq_of_row(row) * ldcv + colb + bj * 128; c0 = *(const f32x4*)cv; c1 = *(const f32x4*)(cv + 4); }
                    const f32x4 v0 = acc[ai][bj][m][0] * rs + c0, v1 = acc[ai][bj][m][1] * rs + c1;
                    v4u w; w.x = pk2(v0.x, v0.y); w.y = pk2(v0.z, v0.w); w.z = pk2(v1.x, v1.y); w.w = pk2(v1.z, v1.w);
                    *(v4u*)(op + bj * 128) = w;
                }
            }
    }
};
struct EpiGate {
    static constexpr bool PERM = true, AFTER_DRAIN = false;
    bf16* GP; const float* rss; const float* cvec; float* fcp; float* fcs;
    __device__ __forceinline__ void operator()(const f32x4 (&acc)[2][2][4][2], const pg8::Unit& u, int wr, int wc, int fr, int fq) const {
        const bool prm = u.pm < 64;
        epi_stage<1>(EPLP, rss, u.pm, u.pn, prm ? cvec + (size_t)(u.pm >> 3) * DFF : nullptr, nullptr, nullptr, nullptr, nullptr);
        const int cl = wc * 32 + 8 * fq, colb = u.pn * 256 + cl;
#pragma unroll
        for (int ai = 0; ai < 2; ++ai)
#pragma unroll
            for (int m = 0; m < 4; ++m) {
                const int rl = ai * 128 + wr * 64 + m * 16 + fr, row = u.pm * 256 + rl;
                const float rs = EPLP[rl]; const int s = seq_of_row(row);
                bf16* op = GP + (size_t)row * DFF + colb;
                float* st = nullptr;
                if (row < MP) { const int tt = row & (TSEQ - 1); if (tt >= TSEQ - 2) st = fcp + ((size_t)s * 2 + (tt - (TSEQ - 2))) * DFF + colb; }
                else { const int tt = row & 3; if (tt >= 2) st = fcs + ((size_t)(s - NBP) * 2 + (tt - 2)) * DFF + colb; }
#pragma unroll
                for (int bj = 0; bj < 2; ++bj) {
                    f32x4 c0, c1;
                    if (prm) { c0 = *(const LAS f32x4*)(EPLP + 256 + cl + bj * 128); c1 = *(const LAS f32x4*)(EPLP + 256 + cl + bj * 128 + 4); }
                    else { const float* cv = cvec + (size_t)s * DFF + colb + bj * 128; c0 = *(const f32x4*)cv; c1 = *(const f32x4*)(cv + 4); }
                    const f32x4 v0 = acc[ai][bj][m][0] * rs + c0, v1 = acc[ai][bj][m][1] * rs + c1;
                    v4u w; w.x = pk2(v0.x, v0.y); w.y = pk2(v0.z, v0.w); w.z = pk2(v1.x, v1.y); w.w = pk2(v1.z, v1.w);
                    *(v4u*)(op + bj * 128) = w;
                    if (st) { *(f32x4*)(st + bj * 128) = v0; *(f32x4*)(st + bj * 128 + 4) = v1; }
                }
            }
    }
};
struct EpiUp {
    static constexpr bool PERM = true, AFTER_DRAIN = false;
    bf16* ACT; const bf16* GP; const float* rss; const float* cvec; const float* cw; const float* cb; const float* sfc;
    __device__ __forceinline__ void operator()(const f32x4 (&acc)[2][2][4][2], const pg8::Unit& u, int wr, int wc, int fr, int fq) const {
        const bool prm = u.pm < 64;
        epi_stage<5>(EPLP, rss, u.pm, u.pn, prm ? cvec + (size_t)(u.pm >> 3) * DFF : nullptr, cw, cw + DFF, cw + 2 * DFF, cb);
        const int cl = wc * 32 + 8 * fq, colb = u.pn * 256 + cl;
#pragma unroll
        for (int ai = 0; ai < 2; ++ai)
#pragma unroll
            for (int m = 0; m < 4; ++m) {
                const int rl = ai * 128 + wr * 64 + m * 16 + fr, row = u.pm * 256 + rl;
                const float rs = EPLP[rl]; const int s = seq_of_row(row);
                const int tt = row < MP ? (row & (TSEQ - 1)) : (row & 3);
#pragma unroll
                for (int bj = 0; bj < 2; ++bj) {
                    const int cc = colb + bj * 128, lc = cl + bj * 128;
                    const bf16* g0p = GP + (size_t)row * DFF + cc;
                    f32x4 g0a, g0b, g1a, g1b, g2a, g2b;
                    { const v4u r = *(const v4u*)(g0p); g0a = (f32x4){bflo(r.x), bfhi(r.x), bflo(r.y), bfhi(r.y)}; g0b = (f32x4){bflo(r.z), bfhi(r.z), bflo(r.w), bfhi(r.w)}; }
                    if (tt >= 1) { const v4u r = *(const v4u*)(g0p - DFF); g1a = (f32x4){bflo(r.x), bfhi(r.x), bflo(r.y), bfhi(r.y)}; g1b = (f32x4){bflo(r.z), bfhi(r.z), bflo(r.w), bfhi(r.w)}; }
                    else if (row >= MP) { const float* sp = sfc + ((size_t)(s - NBP) * 2 + 1) * DFF + cc; g1a = *(const f32x4*)sp; g1b = *(const f32x4*)(sp + 4); }
                    else { g1a = (f32x4){0.f, 0.f, 0.f, 0.f}; g1b = g1a; }
                    if (tt >= 2) { const v4u r = *(const v4u*)(g0p - 2 * DFF); g2a = (f32x4){bflo(r.x), bfhi(r.x), bflo(r.y), bfhi(r.y)}; g2b = (f32x4){bflo(r.z), bfhi(r.z), bflo(r.w), bfhi(r.w)}; }
                    else if (row >= MP) { const float* sp = sfc + ((size_t)(s - NBP) * 2 + tt) * DFF + cc; g2a = *(const f32x4*)sp; g2b = *(const f32x4*)(sp + 4); }
                    else { g2a = (f32x4){0.f, 0.f, 0.f, 0.f}; g2b = g2a; }
                    f32x4 c0, c1;
                    if (prm) { c0 = *(const LAS f32x4*)(EPLP + 256 + lc); c1 = *(const LAS f32x4*)(EPLP + 256 + lc + 4); }
                    else { const float* cv = cvec + (size_t)s * DFF + cc; c0 = *(const f32x4*)cv; c1 = *(const f32x4*)(cv + 4); }
                    const f32x4 u0 = acc[ai][bj][m][0] * rs + c0, u1 = acc[ai][bj][m][1] * rs + c1;
                    const f32x4 ga = *(const LAS f32x4*)(EPLP + 512 + lc) * g2a + *(const LAS f32x4*)(EPLP + 768 + lc) * g1a + *(const LAS f32x4*)(EPLP + 1024 + lc) * g0a + *(const LAS f32x4*)(EPLP + 1280 + lc);
                    const f32x4 gb = *(const LAS f32x4*)(EPLP + 512 + lc + 4) * g2b + *(const LAS f32x4*)(EPLP + 768 + lc + 4) * g1b + *(const LAS f32x4*)(EPLP + 1024 + lc + 4) * g0b + *(const LAS f32x4*)(EPLP + 1280 + lc + 4);
                    v4u w; w.x = pk2(siluf(ga.x) * u0.x, siluf(ga.y) * u0.y); w.y = pk2(siluf(ga.z) * u0.z, siluf(ga.w) * u0.w);
                    w.z = pk2(siluf(gb.x) * u1.x, siluf(gb.y) * u1.y); w.w = pk2(siluf(gb.z) * u1.z, siluf(gb.w) * u1.w);
                    *(v4u*)(ACT + (size_t)row * DFF + cc) = w;
                }
            }
    }
};
struct EpiRes {
    static constexpr bool PERM = false, AFTER_DRAIN = false;
    const float* xinP; float* xout; const float* gvec; const float* scn; const float* gamma; bf16* XS; float* rss;
    __device__ __forceinline__ void operator()(const f32x4 (&acc)[2][2][4][2], const pg8::Unit& u, int wr, int wc, int fr, int fq) const {
        const int s0 = u.pm >> 3;
        epi_stage<3>(EPLP, nullptr, u.pm, u.pn, gvec + (size_t)s0 * 6144, scn ? scn + (size_t)s0 * 6144 : nullptr, scn ? gamma : nullptr, nullptr, nullptr);
        const int cl = wc * 32 + 4 * fq, colb = u.pn * 256 + cl;
#pragma unroll
        for (int ai = 0; ai < 2; ++ai)
#pragma unroll
            for (int m = 0; m < 4; ++m) {
                const int row = u.pm * 256 + ai * 128 + wr * 64 + m * 16 + fr;
                const float* xi = xinP + (size_t)row * DM; float* xo = xout + (size_t)row * DM;
                float ss = 0.f;
#pragma unroll
                for (int bj = 0; bj < 2; ++bj)
#pragma unroll
                    for (int n = 0; n < 2; ++n) {
                        const int lc = cl + bj * 128 + n * 16, col = u.pn * 256 + lc;
                        const f32x4 xn = *(const f32x4*)(xi + col) + *(const LAS f32x4*)(EPLP + 256 + lc) * acc[ai][bj][m][n];
                        *(f32x4*)(xo + col) = xn;
                        ss += (xn.x * xn.x + xn.y * xn.y) + (xn.z * xn.z + xn.w * xn.w);
                        if (scn) { const f32x4 v = xn * *(const LAS f32x4*)(EPLP + 768 + lc) * (*(const LAS f32x4*)(EPLP + 512 + lc) + 1.f);
                            u32x2 w; w.x = pk2(v.x, v.y); w.y = pk2(v.z, v.w); *(u32x2*)(XS + (size_t)row * DM + col) = w; }
                    }
                ss += __shfl_xor(ss, 16); ss += __shfl_xor(ss, 32);
                if (fq == 0) rss[(size_t)row * 16 + u.pn * 4 + wc] = ss;
            }
    }
};
struct OneUnit {
    int pn;
    __device__ __forceinline__ bool next(int i, pg8::Unit& u) const { if (i > 0 || pn < 0) return false; u.pm = 0; u.pn = pn; return true; }
    __device__ __forceinline__ void a_ready(const pg8::Unit&) const {}
    __device__ __forceinline__ void done(const pg8::Unit&) const {}
};

#ifndef DBL_LOADS
#define DBL_LOADS 0
#endif
#ifndef PROBE_REGION
#define PROBE_REGION 0
#endif
#ifndef PROBE_VCU
#define PROBE_VCU 0
#endif
#define RB(id) do { if (PROBE_REGION == (id) && C.vcu == PROBE_VCU && threadIdx.x == 0) ((volatile LAS unsigned long long*)(ldsq(C) + MISC_OFF + 64))[0] = __builtin_amdgcn_s_memrealtime(); } while (0)
#define RE(id) do { if (PROBE_REGION == (id) && C.vcu == PROBE_VCU && threadIdx.x == 0) { volatile LAS unsigned long long* q_ = (volatile LAS unsigned long long*)(ldsq(C) + MISC_OFF + 64); q_[1] = q_[1] + (__builtin_amdgcn_s_memrealtime() - q_[0]); } } while (0)
__device__ __forceinline__ void st16_wt(unsigned char* ws, size_t off, const v4u v) {
    const __amdgpu_buffer_rsrc_t r = __builtin_amdgcn_make_buffer_rsrc(ws, (short)0, (int)WS_END, 0x00020000);
    __builtin_amdgcn_raw_buffer_store_b128(v, r, (unsigned)off, 0, 16);
}
__device__ __forceinline__ void st8_wt(void* p, const u32x2 v) { __hip_atomic_store((unsigned long long*)p, (unsigned long long)v.x | ((unsigned long long)v.y << 32), __ATOMIC_RELAXED, __HIP_MEMORY_SCOPE_AGENT); }
__device__ __forceinline__ void st4_wt(float* p, float v) { __hip_atomic_store((unsigned*)p, __builtin_bit_cast(unsigned, v), __ATOMIC_RELAXED, __HIP_MEMORY_SCOPE_AGENT); }
__device__ __forceinline__ void publish_add(unsigned* cnt) {
    if (!cnt) { __syncthreads(); return; }
    asm volatile("s_waitcnt vmcnt(0)" ::: "memory");
    __syncthreads();
    if (threadIdx.x == 0) (void)__hip_atomic_fetch_add(cnt, 1u, __ATOMIC_RELAXED, __HIP_MEMORY_SCOPE_AGENT);
}
__device__ __forceinline__ void poll_acquire(unsigned* cnt, unsigned need) {
    unsigned sp = 0;
    while (__hip_atomic_load(cnt, __ATOMIC_RELAXED, __HIP_MEMORY_SCOPE_AGENT) < need) { __builtin_amdgcn_s_sleep(2); if (++sp > (1u << 22)) break; }
    __builtin_amdgcn_fence(__ATOMIC_ACQUIRE, "agent");
    asm volatile("s_waitcnt vmcnt(0)" ::: "memory");
}
__device__ __forceinline__ float wave_sum(float v) {
#pragma unroll
    for (int o = 1; o < 64; o <<= 1) v += __shfl_xor(v, o);
    return v;
}
template <int MODE>
__device__ __forceinline__ void tr_item(const float* W, int N, int K, bf16* WT, int nblk, LAS float* scr, int item, int lane) {
    const int kb = item / nblk, nb = item - kb * nblk, k0 = 64 * kb, n0 = 64 * nb;
    const int c4 = (lane & 15) * 4, r0 = lane >> 4;
    int sc = n0 + c4;
    if (MODE == 1) { const int np = sc; sc = np < 3072 ? np : (np < 3584 ? np + 8 : (np < 3592 ? np - 512 : -1)); }
#pragma unroll 4
    for (int i = 0; i < 16; ++i) {
        const int kk = 4 * i + r0;
        const f32x4 v = sc >= 0 ? *(const f32x4*)(W + (size_t)(k0 + kk) * N + sc) : (f32x4){0.f, 0.f, 0.f, 0.f};
        LAS float* d = scr + kk * 65 + c4; d[0] = v.x; d[1] = v.y; d[2] = v.z; d[3] = v.w;
    }
    LDS_WAIT(); asm volatile("" ::: "memory");
    const int c = lane & 7;
#pragma unroll
    for (int j = 0; j < 8; ++j) { const int n = (lane >> 3) + 8 * j; const LAS float* s = scr + (8 * c) * 65 + n;
        v4u o; o.x = pk2(s[0 * 65], s[1 * 65]); o.y = pk2(s[2 * 65], s[3 * 65]); o.z = pk2(s[4 * 65], s[5 * 65]); o.w = pk2(s[6 * 65], s[7 * 65]);
        *(GAS v4u*)(WT + (size_t)(n0 + n) * K + k0 + 8 * c) = o; }
    LDS_WAIT(); asm volatile("" ::: "memory");
}
__device__ __forceinline__ void tr_job(Ctx& C, const float* W, bf16* WT, int N, int K, int mode, int ndest, int gw, int ngw, int& base) {
    int tid_ = threadIdx.x; asm volatile("" : "+v"(tid_)); const int lane = tid_ & 63; (void)lane;
    LAS float* scr = (LAS float*)(ldsq(C) + C.wave * 16640);
    const int nblk = ndest / 64, nit = nblk * (K / 64);
    int it = gw - (base % ngw); if (it < 0) it += ngw;
    for (; it < nit; it += ngw) { if (mode == 1) tr_item<1>(W, N, K, WT, nblk, scr, it, lane); else tr_item<0>(W, N, K, WT, nblk, scr, it, lane); }
    base += nit;
}
__device__ __forceinline__ void phase_p0(Ctx& C) {
    const int gw = C.vcu * NWAVES + C.wave, ngw = C.G * NWAVES;
    bf16* wada = (bf16*)(wsq(C) + WS_WADA);
    int base = 0;
    tr_job(C, inptr(I_WADA), wada, 6144, DM, 0, 6144, gw, ngw, base);
    tr_job(C, inptr(I_WADA) + (size_t)DM * 6144, wada + (size_t)6144 * DM, 6144, DM, 0, 6144, gw, ngw, base);
    bf16* ac = (bf16*)(wsq(C) + WS_AC);
    int tid_ = threadIdx.x; asm volatile("" : "+v"(tid_)); const int lane = tid_ & 63; (void)lane;
    for (int r = gw; r < NSEQ; r += ngw) {
        const float* src = r < NBP ? inptr(I_CP) + (size_t)r * DM : inptr(I_CS) + (size_t)(r - NBP) * DM;
#pragma unroll
        for (int j = 0; j < 4; ++j) { const f32x4 v = *(const f32x4*)(src + 256 * j + 4 * lane);
            u32x2 w; w.x = pk2(siluf(v.x), siluf(v.y)); w.y = pk2(siluf(v.z), siluf(v.w)); *(u32x2*)(ac + (size_t)r * DM + 256 * j + 4 * lane) = w; }
    }
}
__device__ __forceinline__ void x_to_xs(Ctx& C, int gw, int ngw) {
    const float* mod = (const float*)(wsq(C) + WS_MOD); bf16* xs = (bf16*)(wsq(C) + WS_XS); float* rss = (float*)(wsq(C) + WS_RSS);
    const float* gam = inptr(I_NMIX); const float* xp_ = inptr(I_XP); const float* xs_ = inptr(I_XS);
    int tid_ = threadIdx.x; asm volatile("" : "+v"(tid_)); const int lane = tid_ & 63; (void)lane;
    for (int row = gw; row < MROWS; row += ngw) {
        const float* src = row < MP ? xp_ + (size_t)row * DM : xs_ + (size_t)(row - MP) * DM;
        const int s = seq_of_row(row); const float* sc = mod + (size_t)s * 6144 + 1024;
        float ss = 0.f;
#pragma unroll
        for (int j = 0; j < 4; ++j) { const int col = 256 * j + 4 * lane; const f32x4 v = *(const f32x4*)(src + col);
            ss += (v.x * v.x + v.y * v.y) + (v.z * v.z + v.w * v.w);
            const f32x4 o = v * *(const f32x4*)(gam + col) * (*(const f32x4*)(sc + col) + 1.f);
            u32x2 w; w.x = pk2(o.x, o.y); w.y = pk2(o.z, o.w); *(u32x2*)(xs + (size_t)row * DM + col) = w; }
        ss = wave_sum(ss);
        if (lane < 16) rss[(size_t)row * 16 + lane] = lane == 0 ? ss : 0.f;
    }
}
__device__ __forceinline__ void phase_final(Ctx& C) {
    const int gw = C.vcu * NWAVES + C.wave, ngw = C.G * NWAVES;
    const float* rss = (const float*)(wsq(C) + WS_RSS); const float* gam = inptr(I_FNORM);
    int tid_ = threadIdx.x; asm volatile("" : "+v"(tid_)); const int lane = tid_ & 63; (void)lane;
    for (int row = gw; row < MROWS; row += ngw) {
        const float rs = rstd_of(rss, row); float* p = outq(C) + (size_t)row * DM;
#pragma unroll
        for (int j = 0; j < 4; ++j) { const int col = 256 * j + 4 * lane; *(f32x4*)(p + col) = *(const f32x4*)(p + col) * rs * *(const f32x4*)(gam + col); }
    }
}

__device__ __forceinline__ void gdn_prep_item(Ctx& C, int l, int b, int h, int n, unsigned* cnt) {
    int tid_ = threadIdx.x; asm volatile("" : "+v"(tid_)); const int tid = tid_, lane = tid & 63, wave = __builtin_amdgcn_readfirstlane(tid >> 6);
    LAS float* F32 = (LAS float*)(ldsq(C));
    LAS unsigned short* KH = (LAS unsigned short*)(ldsq(C) + 99328);
    LAS unsigned short* QH = (LAS unsigned short*)(ldsq(C) + 116736);
    LAS float* AM = (LAS float*)(ldsq(C) + 134144);
    LAS float* SC = (LAS float*)(ldsq(C) + 151552);
    const bf16* U = (const bf16*)(wsq(C) + WS_U);
    const int row0 = b * TSEQ + n * 64;
    const int idx = (b * 4 + h) * 32 + n;
#ifndef REP_STEPA
#define REP_STEPA 1
#endif
    for (int rpa_ = 0; rpa_ < REP_STEPA; ++rpa_)
    if (tid < 384) {
        const int cg = tid % 48, rs = tid / 48, which = cg >> 4, cc = (cg & 15) * 8;
        const int ucol = C_Q + which * 512 + h * 128 + cc, wcol = which * 512 + h * 128 + cc;
        const float* cw = inptr(I_GCW) + (size_t)l * 4 * 1536 + wcol;
        float w[4][8];
#pragma unroll
        for (int k = 0; k < 4; ++k) { const f32x4 a = *(const f32x4*)(cw + k * 1536), bq = *(const f32x4*)(cw + k * 1536 + 4);
            w[k][0] = a.x; w[k][1] = a.y; w[k][2] = a.z; w[k][3] = a.w; w[k][4] = bq.x; w[k][5] = bq.y; w[k][6] = bq.z; w[k][7] = bq.w; }
        float x0[8], x1[8], x2[8], x3[8];
        const int t0 = 8 * rs;
#define LOADROW(dst, t) do { const int tg_ = n * 64 + (t); if (tg_ >= 0) { const v4u r_ = *(const v4u*)(U + (size_t)(b * TSEQ + tg_) * LDU + ucol); \
            dst[0] = bflo(r_.x); dst[1] = bfhi(r_.x); dst[2] = bflo(r_.y); dst[3] = bfhi(r_.y); dst[4] = bflo(r_.z); dst[5] = bfhi(r_.z); dst[6] = bflo(r_.w); dst[7] = bfhi(r_.w); } \
            else { _Pragma("unroll") for (int i_ = 0; i_ < 8; ++i_) dst[i_] = 0.f; } } while (0)
        LOADROW(x0, t0 - 3); LOADROW(x1, t0 - 2); LOADROW(x2, t0 - 1);
#pragma unroll
        for (int j = 0; j < 8; ++j) {
            LOADROW(x3, t0 + j);
            if (n == 31 && rs == 7 && j >= 5) {
                float* gp = outq(C) + O_GCP + ((size_t)(l * NBP + b) * 3 + (j - 5)) * 1536 + wcol;
                *(f32x4*)gp = (f32x4){x3[0], x3[1], x3[2], x3[3]}; *(f32x4*)(gp + 4) = (f32x4){x3[4], x3[5], x3[6], x3[7]};
            }
            LAS float* dst = F32 + (t0 + j) * 388 + cg * 8;
#pragma unroll
            for (int i = 0; i < 8; ++i) { const float y = w[0][i] * x0[i] + w[1][i] * x1[i] + w[2][i] * x2[i] + w[3][i] * x3[i]; dst[i] = siluf(y); x0[i] = x1[i]; x1[i] = x2[i]; x2[i] = x3[i]; }
        }
#undef LOADROW
    }
    __syncthreads();
    {
        const int p = tid >> 2, sub = tid & 3, t = p & 63, which = p >> 6;
        const LAS f32x4* src = (const LAS f32x4*)(F32 + t * 388 + which * 128 + sub * 32);
        float s = 0.f;
#pragma unroll
        for (int i = 0; i < 8; ++i) { const f32x4 v = src[i]; s += (v.x * v.x + v.y * v.y) + (v.z * v.z + v.w * v.w); }
        s += __builtin_bit_cast(float, __builtin_amdgcn_update_dpp(0, __builtin_bit_cast(int, s), 0xB1, 0xF, 0xF, true));
        s += __builtin_bit_cast(float, __builtin_amdgcn_update_dpp(0, __builtin_bit_cast(int, s), 0x4E, 0xF, 0xF, true));
        if (sub == 0) SC[which * 64 + t] = rsqrtf(s + EPS) * (which == 0 ? 0.08838834764831845f : 1.f);
    }
    if (wave == 0) {
        const int t = lane; const bf16* ur = U + (size_t)(row0 + t) * LDU;
        const float ga = bf2f(ur[C_GA + h]), gb = bf2f(ur[C_GB + h]);
        const float g = -__expf(inptr(I_GALOG)[l * 4 + h]) * softplusf(ga + inptr(I_GDTB)[l * 4 + h]);
        float cs = g;
#pragma unroll
        for (int o = 1; o < 64; o <<= 1) { const float v = __shfl_up(cs, o); if (lane >= o) cs += v; }
        SC[128 + t] = sigm(gb); SC[192 + t] = cs; SC[256 + t] = __expf(cs);
    }
    __syncthreads();
    {
        const int t = tid >> 3, cs = (tid & 7) * 16; const float rq = SC[t], rk = SC[64 + t];
        LAS f32x4* qrow = (LAS f32x4*)(F32 + t * 388 + cs); LAS f32x4* krow = (LAS f32x4*)(F32 + t * 388 + 128 + cs);
        f32x4 q4[4], k4[4];
#pragma unroll
        for (int i = 0; i < 4; ++i) { q4[i] = qrow[i] * rq; k4[i] = krow[i] * rk; qrow[i] = q4[i]; krow[i] = k4[i]; }
        *(LAS bf16x8*)(QH + t * 136 + cs) = pack8(q4[0], q4[1]); *(LAS bf16x8*)(QH + t * 136 + cs + 8) = pack8(q4[2], q4[3]);
        *(LAS bf16x8*)(KH + t * 136 + cs) = pack8(k4[0], k4[1]); *(LAS bf16x8*)(KH + t * 136 + cs + 8) = pack8(k4[2], k4[3]);
    }
    __syncthreads();
    {
        const int g = lane >> 4, c = lane & 15;
        LAS unsigned short* ATL = (LAS unsigned short*)(ldsq(C) + 152832);
        for (int job = wave; job < 26; job += 8) {
            int which, mt, nt;
            if (job < 16) { which = 1; mt = job >> 2; nt = job & 3; }
            else { const int k = job - 16; which = 0; mt = (k >= 6) ? 3 : (k >= 3) ? 2 : (k >= 1) ? 1 : 0; nt = k - (mt * (mt + 1)) / 2; }
            f32x4 acc = (f32x4){0.f, 0.f, 0.f, 0.f};
            if (mt >= nt) {
                const LAS unsigned short* ap = (which ? QH : KH) + (16 * mt + c) * 136 + 8 * g;
                const LAS unsigned short* bp = KH + (16 * nt + c) * 136 + 8 * g;
#pragma unroll
                for (int s = 0; s < 4; ++s) acc = mfma16(*(const LAS bf16x8*)(ap + 32 * s), *(const LAS bf16x8*)(bp + 32 * s), acc);
            }
            const int sidx = 16 * nt + c; const float gcs = SC[192 + sidx];
#pragma unroll
            for (int r = 0; r < 4; ++r) {
                const int t = 16 * mt + 4 * g + r; const float dec = __expf(SC[192 + t] - gcs);
                if (which == 0) AM[t * 68 + (sidx & 1) * 32 + (sidx >> 1)] = (sidx < t) ? SC[128 + t] * acc[r] * dec : 0.f;
                else ATL[t * 72 + (sidx & 32) + permpos(sidx & 31)] = f2bfs((sidx <= t) ? acc[r] * dec : 0.f);
            }
        }
    }
    __syncthreads();
#ifndef REP_SOLVE
#define REP_SOLVE 1
#endif
    for (int rps_ = 0; rps_ < REP_SOLVE; ++rps_)
    {
        const int c = tid >> 1, half = tid & 1; const bool isv = c < 128; const int fcol = isv ? 256 + c : c;
        float mine[32];
#pragma unroll
        for (int i = 0; i < 32; ++i) mine[i] = 0.f;
        f32x4 ar[2][8]; float rh[2], rb[2], re[2];
        ar[0][0] = *(const LAS f32x4*)(AM + half * 32); rh[0] = F32[fcol]; rb[0] = SC[128]; re[0] = SC[256];
#pragma unroll
        for (int i = 0; i < 64; ++i) {
            const int cur = i & 1, nxt = cur ^ 1;
            if (i + 1 < 64) {
                const int njn = (i + 2) >> 1;
#pragma unroll
                for (int q = 0; q * 4 < njn; ++q) ar[nxt][q] = *(const LAS f32x4*)(AM + (i + 1) * 68 + half * 32 + 4 * q);
                rh[nxt] = F32[(i + 1) * 388 + fcol]; rb[nxt] = SC[128 + i + 1]; re[nxt] = SC[256 + i + 1];
            }
            float rhs = rh[cur] * rb[cur]; if (!isv) rhs *= re[cur];
            float p0 = 0.f, p1 = 0.f, p2 = 0.f, p3 = 0.f;
            const int nj = (i + 1) >> 1;
#pragma unroll
            for (int q = 0; q * 4 < nj; ++q) {
                const f32x4 a = ar[cur][q];
                p0 += a.x * mine[4 * q]; if (4 * q + 1 < nj) p1 += a.y * mine[4 * q + 1]; if (4 * q + 2 < nj) p2 += a.z * mine[4 * q + 2]; if (4 * q + 3 < nj) p3 += a.w * mine[4 * q + 3];
            }
            const float part = (p0 + p1) + (p2 + p3);
            const float tot = part + __builtin_bit_cast(float, __builtin_amdgcn_update_dpp(0, __builtin_bit_cast(int, part), 0xB1, 0xF, 0xF, true));
            const float sol = rhs - tot;
            mine[i >> 1] = ((i & 1) == half) ? sol : mine[i >> 1];
        }
        const int d = c - 128; const int dpos = (d & ~31) + permpos(d & 31);
#pragma unroll
        for (int jj = 0; jj < 32; ++jj) { const int t = 2 * jj + half; if (isv) QH[t * 136 + c] = f2bfs(mine[jj]); else KH[t * 136 + dpos] = f2bfs(-mine[jj]); }
    }
    {
        const int t = tid >> 3, ds = (tid & 7) * 16; const float e = SC[256 + t];
        bf16* QT = (bf16*)(wsq(C) + WS_PQ) + (size_t)idx * 8192 + t * 128;
#pragma unroll
        for (int gq = 0; gq < 4; ++gq) { const f32x4 v = *(const LAS f32x4*)(F32 + t * 388 + ds + 4 * gq) * e;
            u32x2 w; w.x = pk2(v.x, v.y); w.y = pk2(v.z, v.w); st8_wt(QT + (ds & ~31) + 8 * gq + 4 * ((ds >> 4) & 1), w); }
    }
    {
        const int d = tid & 127, tq = tid >> 7; const float gl = SC[192 + 63];
        float kv[4][4];
#pragma unroll
        for (int gq = 0; gq < 4; ++gq)
#pragma unroll
            for (int i = 0; i < 4; ++i) { const int t = 16 * tq + 4 * gq + i; kv[gq][i] = F32[t * 388 + 128 + d] * __expf(gl - SC[192 + t]); }
        if (tid == 0) st4_wt((float*)(wsq(C) + WS_EGL) + idx, __expf(gl));
        __syncthreads();
        LAS unsigned short* KTL = (LAS unsigned short*)(ldsq(C) + 134144) + d * 64;
#pragma unroll
        for (int gq = 0; gq < 4; ++gq) { u32x2 w; w.x = pk2(kv[gq][0], kv[gq][1]); w.y = pk2(kv[gq][2], kv[gq][3]); *(LAS u32x2*)(KTL + ((16 * tq) & ~31) + 8 * gq + 4 * (tq & 1)) = w; }
    }
    __syncthreads();
    {
        unsigned char* wsb = wsq(C);
        const size_t pu = WS_PU + (size_t)idx * 16384, pw = WS_PW + (size_t)idx * 16384, pk = WS_PK + (size_t)idx * 16384, pa = WS_PA + (size_t)idx * 8192;
        LAS unsigned char* L = ldsq(C);
#pragma unroll
        for (int k = 0; k < 2; ++k) { const int e = tid + 512 * k, r = e >> 4, q = e & 15;
            st16_wt(wsb, pu + e * 16, *(const LAS v4u*)(L + 116736 + r * 272 + q * 16));
            st16_wt(wsb, pw + e * 16, *(const LAS v4u*)(L + 99328 + r * 272 + q * 16));
            st16_wt(wsb, pk + e * 16, *(const LAS v4u*)(L + 134144 + e * 16)); }
        { const int r = tid >> 3, q = tid & 7; st16_wt(wsb, pa + tid * 16, *(const LAS v4u*)(L + 152832 + r * 144 + q * 16)); }
    }
    publish_add(cnt);
}

constexpr int GC_NW = 0, GC_QT = 16384, GC_KT = 32768, GC_AT = 49152, GC_UT = 57344, GC_BUF = 73728, GC_PART = 147456;
__device__ __forceinline__ void gdn_chain_issue(LAS unsigned char* lds, const unsigned char* ws, int idx, int buf, int tid, int wave) {
    LAS unsigned char* base = lds + buf * GC_BUF;
    const unsigned char* nw = ws + WS_PW + (size_t)idx * 16384; const unsigned char* qt = ws + WS_PQ + (size_t)idx * 16384;
    const unsigned char* kt = ws + WS_PK + (size_t)idx * 16384; const unsigned char* at = ws + WS_PA + (size_t)idx * 8192; const unsigned char* ut = ws + WS_PU + (size_t)idx * 16384;
#pragma unroll
    for (int i = 0; i < 2; ++i) {
        const int L = tid + 512 * i; const int wb = (i * 512 + wave * 64) * 16;
        { const int r = L >> 4, ps = L & 15, q = ps ^ (r & 15); glds16(nw + r * 256 + q * 16, base + GC_NW + wb); glds16(qt + r * 256 + q * 16, base + GC_QT + wb); }
        glds16(ut + L * 16, base + GC_UT + wb);
        { const int r = L >> 3, ps = L & 7, q = ps ^ ((r >> 1) & 7); glds16(kt + r * 128 + q * 16, base + GC_KT + wb); }
    }
    { const int L = tid; const int r = L >> 3, ps = L & 7, q = ps ^ ((r >> 1) & 7); glds16(at + r * 128 + q * 16, base + GC_AT + wave * 1024); }
}
template <int PART>
__device__ __forceinline__ void gdn_chain_issue_part(LAS unsigned char* lds, const unsigned char* ws, int idx, int buf, int tid, int wave) {
    LAS unsigned char* base = lds + buf * GC_BUF;
#pragma unroll
    for (int i = 0; i < 2; ++i) {
        const int L = tid + 512 * i; const int wb = (i * 512 + wave * 64) * 16;
        if (PART == 0) { const int r = L >> 4, ps = L & 15, q = ps ^ (r & 15); glds16(ws + WS_PW + (size_t)idx * 16384 + r * 256 + q * 16, base + GC_NW + wb); }
        if (PART == 1) { const int r = L >> 4, ps = L & 15, q = ps ^ (r & 15); glds16(ws + WS_PQ + (size_t)idx * 16384 + r * 256 + q * 16, base + GC_QT + wb); }
        if (PART == 2) glds16(ws + WS_PU + (size_t)idx * 16384 + L * 16, base + GC_UT + wb);
        if (PART == 3) { const int r = L >> 3, ps = L & 7, q = ps ^ ((r >> 1) & 7); glds16(ws + WS_PK + (size_t)idx * 16384 + r * 128 + q * 16, base + GC_KT + wb); }
    }
    if (PART == 2) { const int L = tid; const int r = L >> 3, ps = L & 7, q = ps ^ ((r >> 1) & 7); glds16(ws + WS_PA + (size_t)idx * 8192 + r * 128 + q * 16, base + GC_AT + wave * 1024); }
}
__device__ __forceinline__ void gdn_chain(Ctx& C, int l, int b, int h) {
    int tid_ = threadIdx.x; asm volatile("" : "+v"(tid_)); const int tid = tid_, lane = tid & 63, w = __builtin_amdgcn_readfirstlane(tid >> 6), g = lane >> 4, c = lane & 15, e0 = 16 * w;
    LAS unsigned char* lds = ldsq(C);
    const bf16* U = (const bf16*)(wsq(C) + WS_U); bf16* O = (bf16*)(wsq(C) + WS_O);
    const float* egl_p = (const float*)(wsq(C) + WS_EGL);
    const int idx0 = (b * 4 + h) * 32;
    const float gnorm = inptr(I_GNORM)[l * 128 + e0 + c];
    f32x4 S[8];
#pragma unroll
    for (int i = 0; i < 8; ++i) S[i] = (f32x4){0.f, 0.f, 0.f, 0.f};
    const bf16* gzp = U + (size_t)(b * TSEQ + lane) * LDU + C_GZ + h * 128 + e0;
    bf16* orow = O + (size_t)(b * TSEQ + lane) * DM + 256 + h * 128 + e0;
    v4u gz0 = (v4u){0u, 0u, 0u, 0u}, gz1 = gz0;
    f32x4 op[4];
#pragma unroll
    for (int i = 0; i < 4; ++i) op[i] = (f32x4){0.f, 0.f, 0.f, 0.f};
    const int xa = c * 256 + (((c & 12) + (g ^ (c & 3))) << 4);
    const int m3 = (c >> 1) & 7;
    const int xk = c * 128 + (((m3 & 4) + (g ^ (m3 & 3))) << 4);
    unsigned* gcnt = (unsigned*)((gu32*)(wsq(C) + WS_CTL) + CW_GCNT + l * 32 * 64);
    if (tid == 0) { poll_acquire(gcnt, 32u); poll_acquire(gcnt + 64, 32u); }
    __syncthreads();
    gdn_chain_issue(lds, wsq(C), idx0, 0, tid, w);
    float egl = egl_p[idx0];
    asm volatile("s_waitcnt vmcnt(0)" ::: "memory");
    __syncthreads();
    for (int n = 0; n <= 32; ++n) {
        asm volatile("; GDNCHAIN_STEP_BEGIN");
        const int buf = n & 1;
        LAS unsigned char* B = lds + buf * GC_BUF;
        LAS unsigned short* SL = (LAS unsigned short*)(B + GC_UT) + e0;
        bf16x8 fa[16];
        f32x4 vn[4], o[4];
        v4u gn0 = gz0, gn1 = gz1; float egln = 0.f;
        RB(5);
        if (n < 32) {
#pragma unroll
            for (int mt = 0; mt < 4; ++mt) {
                const LAS unsigned short* up = SL + (16 * mt + 4 * g) * 128 + c;
                vn[mt] = (f32x4){bf2f(up[0]), bf2f(up[128]), bf2f(up[256]), bf2f(up[384])}; o[mt] = (f32x4){0.f, 0.f, 0.f, 0.f};
            }
            { const bf16* gp = gzp + (size_t)n * 64 * LDU; gn0 = *(const v4u*)gp; gn1 = *(const v4u*)(gp + 8); }
            if (n + 1 < 32) egln = egl_p[idx0 + n + 1];
            if (n + 1 < 32) gdn_chain_issue_part<0>(lds, wsq(C), idx0 + n + 1, buf ^ 1, tid, w);
            if (n + 1 < 32) gdn_chain_issue_part<1>(lds, wsq(C), idx0 + n + 1, buf ^ 1, tid, w);
        }
        if (n > 0) {
            asm volatile("s_waitcnt lgkmcnt(0)" ::: "memory");
            const LAS float* PART = (const LAS float*)(lds + GC_PART + (buf ^ 1) * 2048);
            *(LAS v4u*)(SL + lane * 128) = gz0; *(LAS v4u*)(SL + lane * 128 + 8) = gz1;
            unsigned short gzv[4][4];
#pragma unroll
            for (int mt = 0; mt < 4; ++mt)
#pragma unroll
                for (int r = 0; r < 4; ++r) gzv[mt][r] = SL[(16 * mt + 4 * g + r) * 128 + c];
#pragma unroll
            for (int mt = 0; mt < 4; ++mt) {
                f32x4 pr[4][2];
#pragma unroll
                for (int r = 0; r < 4; ++r) { const int t = 16 * mt + 4 * g + r; pr[r][0] = *(const LAS f32x4*)(PART + t * 8); pr[r][1] = *(const LAS f32x4*)(PART + t * 8 + 4); }
                __builtin_amdgcn_sched_barrier(0);
#pragma unroll
                for (int r = 0; r < 4; ++r) {
                    const f32x4 p0 = pr[r][0], p1 = pr[r][1];
                    const float tot = ((p0.x + p0.y) + (p0.z + p0.w)) + ((p1.x + p1.y) + (p1.z + p1.w));
                    const float rs = __builtin_amdgcn_rsqf(tot * (1.f / 128.f) + EPS);
                    SL[(16 * mt + 4 * g + r) * 128 + c] = f2bfs(op[mt][r] * rs * gnorm * siluf(bf2f(gzv[mt][r])));
                }
            }
            const v4u ov0 = *(const LAS v4u*)(SL + lane * 128), ov1 = *(const LAS v4u*)(SL + lane * 128 + 8);
            bf16* od = orow + (size_t)(n - 1) * 64 * DM; *(v4u*)od = ov0; *(v4u*)(od + 8) = ov1;
        }
        RE(5);
        if (n < 32) {
            RB(6);
            __builtin_amdgcn_sched_barrier(0);
#pragma unroll
            for (int mt = 0; mt < 4; ++mt)
#pragma unroll
                for (int s = 0; s < 4; ++s) fa[mt * 4 + s] = *(const LAS bf16x8*)(B + GC_NW + mt * 4096 + (xa ^ (s << 6)));
            bf16x8 Sb[4];
#pragma unroll
            for (int s = 0; s < 4; ++s) Sb[s] = pack8(S[2 * s], S[2 * s + 1]);
            __builtin_amdgcn_sched_barrier(0);
#pragma unroll
            for (int s = 0; s < 4; ++s)
#pragma unroll
                for (int mt = 0; mt < 4; ++mt) vn[mt] = mfma16(fa[mt * 4 + s], Sb[s], vn[mt]);
            if (n + 1 < 32) gdn_chain_issue_part<2>(lds, wsq(C), idx0 + n + 1, buf ^ 1, tid, w);
            __builtin_amdgcn_sched_barrier(0);
            RE(6); RB(7);
#pragma unroll
            for (int mt = 0; mt < 4; ++mt)
#pragma unroll
                for (int s = 0; s < 4; ++s) fa[mt * 4 + s] = *(const LAS bf16x8*)(B + GC_QT + mt * 4096 + (xa ^ (s << 6)));
            __builtin_amdgcn_sched_barrier(0);
#pragma unroll
            for (int s = 0; s < 4; ++s)
#pragma unroll
                for (int mt = 0; mt < 4; ++mt) o[mt] = mfma16(fa[mt * 4 + s], Sb[s], o[mt]);
            if (n + 1 < 32) gdn_chain_issue_part<3>(lds, wsq(C), idx0 + n + 1, buf ^ 1, tid, w);
            bf16x8 vb[2];
            vb[0] = pack8(vn[0], vn[1]); vb[1] = pack8(vn[2], vn[3]);
            __builtin_amdgcn_sched_barrier(0);
            RE(7); RB(8);
#pragma unroll
            for (int mt = 0; mt < 4; ++mt)
#pragma unroll
                for (int s = 0; s < 2; ++s) { fa[mt * 2 + s] = *(const LAS bf16x8*)(B + GC_AT + mt * 2048 + (xk ^ (s << 6))); fa[8 + mt * 2 + s] = *(const LAS bf16x8*)(B + GC_KT + mt * 2048 + (xk ^ (s << 6))); }
#pragma unroll
            for (int i = 0; i < 8; ++i) S[i] = S[i] * egl;
            __builtin_amdgcn_sched_barrier(0);
#pragma unroll
            for (int s = 0; s < 2; ++s)
#pragma unroll
                for (int mt = 0; mt < 4; ++mt) { o[mt] = mfma16(fa[mt * 2 + s], vb[s], o[mt]); S[mt] = mfma16(fa[8 + mt * 2 + s], vb[s], S[mt]); }
            __builtin_amdgcn_sched_barrier(0);
            RE(8); RB(9);
#pragma unroll
            for (int md = 0; md < 4; ++md)
#pragma unroll
                for (int s = 0; s < 2; ++s) fa[md * 2 + s] = *(const LAS bf16x8*)(B + GC_KT + (4 + md) * 2048 + (xk ^ (s << 6)));
            __builtin_amdgcn_sched_barrier(0);
#pragma unroll
            for (int s = 0; s < 2; ++s)
#pragma unroll
                for (int md = 0; md < 4; ++md) S[4 + md] = mfma16(fa[md * 2 + s], vb[s], S[4 + md]);
            LAS float* PARTW = (LAS float*)(lds + GC_PART + buf * 2048);
#pragma unroll
            for (int mt = 0; mt < 4; ++mt)
#pragma unroll
                for (int r = 0; r < 4; ++r) {
                    const float ss = dpp_sum16(o[mt][r] * o[mt][r]);
                    if (c == 4 * mt + r) PARTW[(16 * mt + 4 * g + r) * 8 + w] = ss;
                }
#pragma unroll
            for (int mt = 0; mt < 4; ++mt) op[mt] = o[mt];
            gz0 = gn0; gz1 = gn1; egl = egln;
            RE(9); RB(10);
            asm volatile("; GDNCHAIN_STEP_END");
            if (tid == 0 && n + 2 < 32) poll_acquire(gcnt + 64 * (n + 2), 32u);
            asm volatile("s_waitcnt vmcnt(0)" ::: "memory");
            __syncthreads();
            RE(10);
        }
    }
    float* sp = outq(C) + O_GDNP + (size_t)((l * NBP + b) * 4 + h) * 128 * 128;
#pragma unroll
    for (int i = 0; i < 8; ++i)
#pragma unroll
        for (int r = 0; r < 4; ++r) sp[(size_t)(16 * i + 4 * g + r) * 128 + e0 + c] = S[i][r];
    __syncthreads();
}

constexpr int HC_QM = 0, HC_KM = 9216, HC_QE = 18432, HC_VT = 27648, HC_KLT = 36864, HC_BUF = 46080, HC_SEG = 92160, HC_GLS = 94208, HC_PART = 94720;
__device__ __forceinline__ void hgrn_chain(Ctx& C, int l, int b, int h) {
    int tid_ = threadIdx.x; asm volatile("" : "+v"(tid_)); const int tid = tid_, lane = tid & 63, w = __builtin_amdgcn_readfirstlane(tid >> 6), g = lane >> 4, c = lane & 15, d = lane, ts = w;
    LAS unsigned char* lds = ldsq(C);
    const bf16* U = (const bf16*)(wsq(C) + WS_U); bf16* O = (bf16*)(wsq(C) + WS_O);
    float lb = 0.f;
    if (l == 1) { const float b0 = inptr(I_HGLB)[h * 64 + d], b1 = inptr(I_HGLB)[256 + h * 64 + d]; lb = __builtin_amdgcn_rcpf(1.f + __expf(b0 - b1)); }
    const float oml = 1.f - lb;
    const int nt = w >> 1, ep = w & 1;
    f32x4 S[4][2];
#pragma unroll
    for (int i = 0; i < 4; ++i) { S[i][0] = (f32x4){0.f, 0.f, 0.f, 0.f}; S[i][1] = (f32x4){0.f, 0.f, 0.f, 0.f}; }
    float hgn[2][4];
#pragma unroll
    for (int mi = 0; mi < 2; ++mi)
#pragma unroll
        for (int r = 0; r < 4; ++r) hgn[mi][r] = inptr(I_HGN)[l * 64 + 16 * (2 * ep + mi) + 4 * g + r];
    LAS float* SEG = (LAS float*)(lds + HC_SEG);
    unsigned short rq[8], rf[8], ri[8];
    {
        const bf16* up = U + (size_t)(b * TSEQ + 8 * ts) * LDU + h * 64 + d;
#pragma unroll
        for (int j = 0; j < 8; ++j) { rq[j] = up[(size_t)j * LDU + C_HQ]; rf[j] = up[(size_t)j * LDU + C_HF]; ri[j] = up[(size_t)j * LDU + C_HI]; }
    }
    for (int n = 0; n < 32; ++n) {
        const int buf = n & 1; const int row0 = b * TSEQ + n * 64;
        float q[8], kk[8], cs[8], v[8];
        float run = 0.f;
#pragma unroll
        for (int j = 0; j < 8; ++j) {
            const float z = bf2f(rf[j]); const float ez = __expf(-z); const float sg = __builtin_amdgcn_rcpf(1.f + ez);
            const float f = lb + oml * sg; run += __logf(f); cs[j] = run;
            kk[j] = oml * (1.f - sg);
            q[j] = siluf(bf2f(rq[j])); v[j] = bf2f(ri[j]);
        }
        SEG[ts * 64 + d] = run;
        u32x2 hz[2];
#pragma unroll
        for (int mi = 0; mi < 2; ++mi) hz[mi] = *(const u32x2*)(U + (size_t)(row0 + 16 * nt + c) * LDU + C_HZ + h * 64 + 16 * (2 * ep + mi) + 4 * g);
        if (n + 1 < 32) {
            const bf16* up = U + (size_t)(row0 + 64 + 8 * ts) * LDU + h * 64 + d;
#pragma unroll
            for (int j = 0; j < 8; ++j) { rq[j] = up[(size_t)j * LDU + C_HQ]; rf[j] = up[(size_t)j * LDU + C_HF]; ri[j] = up[(size_t)j * LDU + C_HI]; }
        }
        __syncthreads();
        float base = 0.f, gmid = 0.f, gl = 0.f;
#pragma unroll
        for (int k = 0; k < 8; ++k) { const float sv = SEG[k * 64 + d]; if (k < ts) base += sv; if (k < 4) gmid += sv; gl += sv; }
        LAS unsigned short* T = (LAS unsigned short*)(lds + buf * HC_BUF);
        {
            const int dpos = (d & ~31) + permpos(d & 31);
            float klv[8];
#pragma unroll
            for (int j = 0; j < 8; ++j) {
                const int t = 8 * ts + j; const float G = base + cs[j];
                const float e1 = fminf(fmaxf(G - gmid, -80.f), 80.f);
                T[HC_QM / 2 + t * 72 + d] = f2bfs(q[j] * __expf(e1));
                T[HC_KM / 2 + t * 72 + d] = f2bfs(kk[j] * __expf(-e1));
                T[HC_QE / 2 + t * 72 + dpos] = f2bfs(q[j] * __expf(G));
                klv[j] = kk[j] * __expf(gl - G);
            }
            const int p0 = 32 * (ts >> 2) + 16 * (ts & 1) + 4 * ((ts >> 1) & 1);
            u32x2 wv0, wv1, wk0, wk1;
            wv0.x = pk2(v[0], v[1]); wv0.y = pk2(v[2], v[3]); wv1.x = pk2(v[4], v[5]); wv1.y = pk2(v[6], v[7]);
            wk0.x = pk2(klv[0], klv[1]); wk0.y = pk2(klv[2], klv[3]); wk1.x = pk2(klv[4], klv[5]); wk1.y = pk2(klv[6], klv[7]);
            *(LAS u32x2*)(T + HC_VT / 2 + d * 72 + p0) = wv0; *(LAS u32x2*)(T + HC_VT / 2 + d * 72 + p0 + 8) = wv1;
            *(LAS u32x2*)(T + HC_KLT / 2 + d * 72 + p0) = wk0; *(LAS u32x2*)(T + HC_KLT / 2 + d * 72 + p0 + 8) = wk1;
            if (ts == 0) ((LAS float*)(lds + HC_GLS))[buf * 64 + d] = gl;
        }
        __syncthreads();
        f32x4 at[4];
#pragma unroll
        for (int ms = 0; ms < 4; ++ms) {
            at[ms] = (f32x4){0.f, 0.f, 0.f, 0.f};
            if (ms <= nt) {
#pragma unroll
                for (int s = 0; s < 2; ++s)
                    at[ms] = mfma16(*(const LAS bf16x8*)(T + HC_KM / 2 + (16 * ms + c) * 72 + 32 * s + 8 * g), *(const LAS bf16x8*)(T + HC_QM / 2 + (16 * nt + c) * 72 + 32 * s + 8 * g), at[ms]);
                if (ms == nt) {
#pragma unroll
                    for (int r = 0; r < 4; ++r) at[ms][r] = (4 * g + r <= c) ? at[ms][r] : 0.f;
                }
            }
        }
        bf16x8 atb[2]; atb[0] = pack8(at[0], at[1]); atb[1] = pack8(at[2], at[3]);
        f32x4 oT[2];
#pragma unroll
        for (int mi = 0; mi < 2; ++mi) {
            const int me = 2 * ep + mi; f32x4 acc = (f32x4){0.f, 0.f, 0.f, 0.f};
#pragma unroll
            for (int s = 0; s < 2; ++s)
                acc = mfma16(pack8(S[2 * s][mi], S[2 * s + 1][mi]), *(const LAS bf16x8*)(T + HC_QE / 2 + (16 * nt + c) * 72 + 32 * s + 8 * g), acc);
#pragma unroll
            for (int s = 0; s < 2; ++s)
                acc = mfma16(*(const LAS bf16x8*)(T + HC_VT / 2 + (16 * me + c) * 72 + 32 * s + 8 * g), atb[s], acc);
            oT[mi] = acc;
        }
        {
            const LAS float* GLS = (const LAS float*)(lds + HC_GLS) + buf * 64;
#pragma unroll
            for (int md = 0; md < 4; ++md) {
                const f32x4 lg = *(const LAS f32x4*)(GLS + 16 * md + 4 * g);
                const f32x4 lam = (f32x4){__expf(lg.x), __expf(lg.y), __expf(lg.z), __expf(lg.w)};
#pragma unroll
                for (int mi = 0; mi < 2; ++mi) {
                    const int me = 2 * ep + mi; f32x4 acc = S[md][mi] * lam;
#pragma unroll
                    for (int s = 0; s < 2; ++s)
                        acc = mfma16(*(const LAS bf16x8*)(T + HC_KLT / 2 + (16 * md + c) * 72 + 32 * s + 8 * g), *(const LAS bf16x8*)(T + HC_VT / 2 + (16 * me + c) * 72 + 32 * s + 8 * g), acc);
                    S[md][mi] = acc;
                }
            }
        }
        LAS float* PART = (LAS float*)(lds + HC_PART) + buf * 128;
        float ss = 0.f;
#pragma unroll
        for (int mi = 0; mi < 2; ++mi)
#pragma unroll
            for (int r = 0; r < 4; ++r) ss += oT[mi][r] * oT[mi][r];
        ss += __shfl_xor(ss, 16); ss += __shfl_xor(ss, 32);
        if (g == 0) PART[(16 * nt + c) * 2 + ep] = ss;
        __syncthreads();
        const float tot = PART[(16 * nt + c) * 2] + PART[(16 * nt + c) * 2 + 1];
        const float rs = rsqrtf(tot * (1.f / 64.f) + EPS);
#pragma unroll
        for (int mi = 0; mi < 2; ++mi) {
            const float z0 = bflo(hz[mi].x), z1 = bfhi(hz[mi].x), z2 = bflo(hz[mi].y), z3 = bfhi(hz[mi].y);
            u32x2 wv; wv.x = pk2(oT[mi][0] * rs * hgn[mi][0] * siluf(z0), oT[mi][1] * rs * hgn[mi][1] * siluf(z1));
            wv.y = pk2(oT[mi][2] * rs * hgn[mi][2] * siluf(z2), oT[mi][3] * rs * hgn[mi][3] * siluf(z3));
            *(u32x2*)(O + (size_t)(row0 + 16 * nt + c) * DM + h * 64 + 16 * (2 * ep + mi) + 4 * g) = wv;
        }
    }
    if (nt == 0) {
        float* sp = outq(C) + O_HGP + (size_t)((l * NBP + b) * 4 + h) * 64 * 64;
#pragma unroll
        for (int md = 0; md < 4; ++md)
#pragma unroll
            for (int mi = 0; mi < 2; ++mi)
#pragma unroll
                for (int r = 0; r < 4; ++r) sp[(size_t)(16 * md + 4 * g + r) * 64 + 16 * (2 * ep + mi) + c] = S[md][mi][r];
    }
    __syncthreads();
}

constexpr int L1_WT = 0, L1_XCB = 73728, L1_STA = 0, L1_STH = 32768;
__device__ __forceinline__ void lru_pass1_item(Ctx& C, int l, int b, int n, unsigned* cnt) {
    int tid_ = threadIdx.x; asm volatile("" : "+v"(tid_)); const int tid = tid_, lane = tid & 63, w = __builtin_amdgcn_readfirstlane(tid >> 6), g = lane >> 4, c = lane & 15;
    LAS unsigned char* lds = ldsq(C);
    const bf16* U = (const bf16*)(wsq(C) + WS_U); bf16* O = (bf16*)(wsq(C) + WS_O);
    LAS unsigned short* WT = (LAS unsigned short*)(lds + L1_WT);
    LAS unsigned short* XCB = (LAS unsigned short*)(lds + L1_XCB);
    const int row0 = b * TSEQ + n * 64;
    {
        const float* wa = inptr(I_LWA) + (size_t)l * 16384; const float* wx = inptr(I_LWX) + (size_t)l * 16384;
        for (int idx = tid; idx < 8192; idx += NTHR) {
            const int gate = idx >> 12, rem = idx & 4095, blk = rem >> 10, i = (rem >> 4) & 63, j4 = (rem & 15) * 4;
            const f32x4 v = *(const f32x4*)((gate ? wx : wa) + ((size_t)blk * 64 + i) * 64 + j4);
            LAS unsigned short* dst = WT + ((gate * 4 + blk) * 64 + j4) * 72 + i;
            dst[0] = f2bfs(v.x); dst[72] = f2bfs(v.y); dst[144] = f2bfs(v.z); dst[216] = f2bfs(v.w);
        }
    }
    {
        const int cg = tid & 31, rs = tid >> 5, ch0 = cg * 8, t0 = rs * 4;
        float cw[4][8], cb[8];
        const float* cwp = inptr(I_LCW) + (size_t)l * 4 * 256 + ch0; const float* cbp = inptr(I_LCB) + (size_t)l * 256 + ch0;
#pragma unroll
        for (int k = 0; k < 4; ++k) { const f32x4 a = *(const f32x4*)(cwp + k * 256), bq = *(const f32x4*)(cwp + k * 256 + 4);
            cw[k][0] = a.x; cw[k][1] = a.y; cw[k][2] = a.z; cw[k][3] = a.w; cw[k][4] = bq.x; cw[k][5] = bq.y; cw[k][6] = bq.z; cw[k][7] = bq.w; }
        { const f32x4 a = *(const f32x4*)cbp, bq = *(const f32x4*)(cbp + 4); cb[0] = a.x; cb[1] = a.y; cb[2] = a.z; cb[3] = a.w; cb[4] = bq.x; cb[5] = bq.y; cb[6] = bq.z; cb[7] = bq.w; }
        float x[7][8];
#pragma unroll
        for (int k = 0; k < 7; ++k) {
            const int tg = n * 64 + t0 - 3 + k;
            if (tg >= 0) { const v4u r = *(const v4u*)(U + (size_t)(b * TSEQ + tg) * LDU + C_LX + ch0);
                x[k][0] = bflo(r.x); x[k][1] = bfhi(r.x); x[k][2] = bflo(r.y); x[k][3] = bfhi(r.y); x[k][4] = bflo(r.z); x[k][5] = bfhi(r.z); x[k][6] = bflo(r.w); x[k][7] = bfhi(r.w);
                if (n == 31 && tg >= TSEQ - 3) { float* cp = outq(C) + O_LCP + ((size_t)(l * NBP + b) * 3 + (tg - (TSEQ - 3))) * 256 + ch0;
                    *(f32x4*)cp = (f32x4){x[k][0], x[k][1], x[k][2], x[k][3]}; *(f32x4*)(cp + 4) = (f32x4){x[k][4], x[k][5], x[k][6], x[k][7]}; }
            } else {
#pragma unroll
                for (int i = 0; i < 8; ++i) x[k][i] = 0.f; }
        }
#pragma unroll
        for (int j = 0; j < 4; ++j) {
            float y[8];
#pragma unroll
            for (int i = 0; i < 8; ++i) y[i] = cw[0][i] * x[j][i] + cw[1][i] * x[j + 1][i] + cw[2][i] * x[j + 2][i] + cw[3][i] * x[j + 3][i] + cb[i];
            v4u wv; wv.x = pk2(y[0], y[1]); wv.y = pk2(y[2], y[3]); wv.z = pk2(y[4], y[5]); wv.w = pk2(y[6], y[7]);
            *(LAS v4u*)(XCB + (t0 + j) * 264 + ch0) = wv;
            const v4u r = *(const v4u*)(U + (size_t)(row0 + t0 + j) * LDU + C_LZ + ch0);
            v4u gv; gv.x = pk2(gelu_tanh(bflo(r.x)), gelu_tanh(bfhi(r.x))); gv.y = pk2(gelu_tanh(bflo(r.y)), gelu_tanh(bfhi(r.y)));
            gv.z = pk2(gelu_tanh(bflo(r.z)), gelu_tanh(bfhi(r.z))); gv.w = pk2(gelu_tanh(bflo(r.w)), gelu_tanh(bfhi(r.w)));
            st16_wt(wsq(C), WS_O + ((size_t)(row0 + t0 + j) * DM + 768 + ch0) * 2, gv);
        }
    }
    __syncthreads();
    const int nb = w >> 1, njb = 2 * (w & 1);
    f32x4 pa[4][2], px[4][2];
    {
        bf16x8 fa[8], fb[8];
#pragma unroll
        for (int mt = 0; mt < 4; ++mt)
#pragma unroll
            for (int s = 0; s < 2; ++s) fa[mt * 2 + s] = *(const LAS bf16x8*)(XCB + (16 * mt + c) * 264 + 64 * nb + 32 * s + 8 * g);
#pragma unroll
        for (int gate = 0; gate < 2; ++gate)
#pragma unroll
            for (int q = 0; q < 2; ++q)
#pragma unroll
                for (int s = 0; s < 2; ++s) fb[(gate * 2 + q) * 2 + s] = *(const LAS bf16x8*)(WT + ((gate * 4 + nb) * 64 + 16 * (njb + q) + c) * 72 + 32 * s + 8 * g);
        __builtin_amdgcn_sched_barrier(0);
#pragma unroll
        for (int mt = 0; mt < 4; ++mt)
#pragma unroll
            for (int q = 0; q < 2; ++q) {
                f32x4 a = (f32x4){0.f, 0.f, 0.f, 0.f}, x = a;
#pragma unroll
                for (int s = 0; s < 2; ++s) { a = mfma16(fa[mt * 2 + s], fb[q * 2 + s], a); x = mfma16(fa[mt * 2 + s], fb[(2 + q) * 2 + s], x); }
                pa[mt][q] = a; px[mt][q] = x;
            }
    }
    unsigned short oa[2][4][4], oh[2][4][4];
    const float* bap = inptr(I_LBA) + l * 256; const float* bxp = inptr(I_LBX) + l * 256; const float* lamp = inptr(I_LLAM) + l * 256;
#pragma unroll
    for (int q = 0; q < 2; ++q) {
        const int ch = 64 * nb + 16 * (njb + q) + c;
        const float ba = bap[ch], bx = bxp[ch], sp = softplusf(-lamp[ch]);
        float pc = 1.f, hc = 0.f;
#pragma unroll
        for (int mt = 0; mt < 4; ++mt) {
            float a[4], bb[4];
#pragma unroll
            for (int r = 0; r < 4; ++r) {
                const float xcv = bf2f(XCB[(16 * mt + 4 * g + r) * 264 + ch]);
                const float rr = sigm(pa[mt][q][r] + ba), ii = sigm(px[mt][q][r] + bx);
                const float la = -8.f * rr * sp, x2 = 2.f * la;
                a[r] = __expf(la);
                const float om = -x2 * (1.f + x2 * (0.5f + x2 * (0.16666667f + x2 * (0.041666668f + x2 * 0.0083333338f))));
                bb[r] = sqrtf(fmaxf(om, 0.f)) * ii * xcv;
            }
            const float P = a[0] * a[1] * a[2] * a[3];
            const float H = ((bb[0] * a[1] + bb[1]) * a[2] + bb[2]) * a[3] + bb[3];
            float ps = pc, hs = hc, pstart = pc, hstart = hc;
#pragma unroll
            for (int k = 0; k < 4; ++k) {
                const float Pk = __shfl(P, c + 16 * k), Hk = __shfl(H, c + 16 * k);
                hs = Pk * hs + Hk; ps = Pk * ps;
                if (g == k + 1) { hstart = hs; pstart = ps; }
            }
            pc = ps; hc = hs;
            float pp = pstart, hh = hstart;
#pragma unroll
            for (int r = 0; r < 4; ++r) { pp = pp * a[r]; hh = a[r] * hh + bb[r]; oa[q][mt][r] = f2bfs(pp); oh[q][mt][r] = f2bfs(hh); }
        }
        if (g == 0) { float* sp_ = (float*)(wsq(C) + WS_LSUM) + ((size_t)(b * 32 + n) * 2) * 256 + ch; st4_wt(sp_, pc); st4_wt(sp_ + 256, hc); }
    }
    __syncthreads();
    {
        LAS unsigned short* STA = (LAS unsigned short*)(lds + L1_STA); LAS unsigned short* STH = (LAS unsigned short*)(lds + L1_STH);
#pragma unroll
        for (int q = 0; q < 2; ++q)
#pragma unroll
            for (int mt = 0; mt < 4; ++mt)
#pragma unroll
                for (int r = 0; r < 4; ++r) { const int off = (16 * mt + 4 * g + r) * 256 + 64 * nb + 16 * (njb + q) + c; STA[off] = oa[q][mt][r]; STH[off] = oh[q][mt][r]; }
    }
    __syncthreads();
    {
        unsigned char* wsb = wsq(C);
#pragma unroll
        for (int k = 0; k < 4; ++k) { const int e = (tid + 512 * k) * 8;
            st16_wt(wsb, WS_ACUM + ((size_t)row0 * 256 + e) * 2, *(const LAS v4u*)(lds + L1_STA + e * 2)); st16_wt(wsb, WS_HLOC + ((size_t)row0 * 256 + e) * 2, *(const LAS v4u*)(lds + L1_STH + e * 2)); }
    }
    publish_add(cnt);
}
__device__ __forceinline__ void lru_pass3_item(Ctx& C, int l, int b, int n) {
    int tid_ = threadIdx.x; asm volatile("" : "+v"(tid_)); const int tid = tid_;
    const int cg = tid & 31, rs = tid >> 5, ch0 = cg * 8, row0 = b * TSEQ + n * 64;
    const float* sum = (const float*)(wsq(C) + WS_LSUM) + (size_t)(b * 32) * 2 * 256 + ch0;
    float hin[8];
#pragma unroll
    for (int i = 0; i < 8; ++i) hin[i] = 0.f;
    for (int k = 0; k < n; ++k) {
        const f32x4 p0 = *(const f32x4*)(sum + (size_t)k * 512), p1 = *(const f32x4*)(sum + (size_t)k * 512 + 4), h0 = *(const f32x4*)(sum + (size_t)k * 512 + 256), h1 = *(const f32x4*)(sum + (size_t)k * 512 + 260);
        hin[0] = p0.x * hin[0] + h0.x; hin[1] = p0.y * hin[1] + h0.y; hin[2] = p0.z * hin[2] + h0.z; hin[3] = p0.w * hin[3] + h0.w;
        hin[4] = p1.x * hin[4] + h1.x; hin[5] = p1.y * hin[5] + h1.y; hin[6] = p1.z * hin[6] + h1.z; hin[7] = p1.w * hin[7] + h1.w;
    }
    const bf16* ga = (const bf16*)(wsq(C) + WS_ACUM); const bf16* gh = (const bf16*)(wsq(C) + WS_HLOC); bf16* O = (bf16*)(wsq(C) + WS_O);
#pragma unroll
    for (int j = 0; j < 4; ++j) {
        const int row = row0 + rs * 4 + j;
        const v4u a = *(const v4u*)(ga + (size_t)row * 256 + ch0), h = *(const v4u*)(gh + (size_t)row * 256 + ch0), gl = *(const v4u*)(O + (size_t)row * DM + 768 + ch0);
        v4u o;
        o.x = pk2((bflo(h.x) + bflo(a.x) * hin[0]) * bflo(gl.x), (bfhi(h.x) + bfhi(a.x) * hin[1]) * bfhi(gl.x));
        o.y = pk2((bflo(h.y) + bflo(a.y) * hin[2]) * bflo(gl.y), (bfhi(h.y) + bfhi(a.y) * hin[3]) * bfhi(gl.y));
        o.z = pk2((bflo(h.z) + bflo(a.z) * hin[4]) * bflo(gl.z), (bfhi(h.z) + bfhi(a.z) * hin[5]) * bfhi(gl.z));
        o.w = pk2((bflo(h.w) + bflo(a.w) * hin[6]) * bflo(gl.w), (bfhi(h.w) + bfhi(a.w) * hin[7]) * bfhi(gl.w));
        *(v4u*)(O + (size_t)row * DM + 768 + ch0) = o;
    }
    if (n == 31 && rs == 0) {
        const f32x4 p0 = *(const f32x4*)(sum + (size_t)31 * 512), p1 = *(const f32x4*)(sum + (size_t)31 * 512 + 4), h0 = *(const f32x4*)(sum + (size_t)31 * 512 + 256), h1 = *(const f32x4*)(sum + (size_t)31 * 512 + 260);
        float* lp = outq(C) + O_LRUP + (size_t)(l * NBP + b) * 256 + ch0;
        *(f32x4*)lp = (f32x4){p0.x * hin[0] + h0.x, p0.y * hin[1] + h0.y, p0.z * hin[2] + h0.z, p0.w * hin[3] + h0.w};
        *(f32x4*)(lp + 4) = (f32x4){p1.x * hin[4] + h1.x, p1.y * hin[5] + h1.y, p1.z * hin[6] + h1.z, p1.w * hin[7] + h1.w};
    }
}

__device__ __forceinline__ void gdn_dec_item(Ctx& C, int l, int seq, int h) {
    int tid_ = threadIdx.x; asm volatile("" : "+v"(tid_)); const int tid = tid_, lane = tid & 63, w = __builtin_amdgcn_readfirstlane(tid >> 6);
    LAS float* XQ = (LAS float*)(ldsq(C));
    LAS float* SCd = (LAS float*)(ldsq(C) + 6144);
    LAS float* RED = (LAS float*)(ldsq(C) + 6400);
    LAS float* SS = (LAS float*)(ldsq(C) + 6400 + 16384);
    const bf16* U = (const bf16*)(wsq(C) + WS_U); bf16* O = (bf16*)(wsq(C) + WS_O);
    const int row0 = MP + seq * 4;
    const int e = tid & 127, dq = tid >> 7;
    const size_t sbase = ((size_t)((l * NSQ + seq) * 4 + h) * 128 + dq * 32) * 128 + e;
    float S[32];
    { const float* sp_ = inptr(I_SGDN) + sbase;
#pragma unroll
      for (int i = 0; i < 32; ++i) S[i] = sp_[(size_t)i * 128]; }
    if (tid < 384) {
        const int which = tid >> 7, cc = tid & 127, ucol = C_Q + which * 512 + h * 128 + cc, wcol = which * 512 + h * 128 + cc;
        float xs[7], cw[4];
#pragma unroll
        for (int k = 0; k < 3; ++k) xs[k] = inptr(I_SGC)[((size_t)(l * NSQ + seq) * 3 + k) * 1536 + wcol];
#pragma unroll
        for (int t = 0; t < 4; ++t) xs[3 + t] = bf2f(U[(size_t)(row0 + t) * LDU + ucol]);
#pragma unroll
        for (int k = 0; k < 4; ++k) cw[k] = inptr(I_GCW)[(size_t)(l * 4 + k) * 1536 + wcol];
#pragma unroll
        for (int t = 0; t < 4; ++t) XQ[t * 384 + tid] = siluf(cw[0] * xs[t] + cw[1] * xs[t + 1] + cw[2] * xs[t + 2] + cw[3] * xs[t + 3]);
#pragma unroll
        for (int k = 0; k < 3; ++k) outq(C)[O_GCS + ((size_t)(l * NSQ + seq) * 3 + k) * 1536 + wcol] = xs[4 + k];
    }
    __syncthreads();
    {
        const int t = w & 3, which = w >> 2;
        const float a = XQ[t * 384 + which * 128 + lane], bq = XQ[t * 384 + which * 128 + 64 + lane];
        const float s = wave_sum(a * a + bq * bq);
        if (lane == 0) SCd[which * 4 + t] = rsqrtf(s + EPS) * (which == 0 ? 0.08838834764831845f : 1.f);
        if (tid < 4) {
            const bf16* ur = U + (size_t)(row0 + tid) * LDU;
            const float g = -__expf(inptr(I_GALOG)[l * 4 + h]) * softplusf(bf2f(ur[C_GA + h]) + inptr(I_GDTB)[l * 4 + h]);
            SCd[8 + tid] = __expf(g); SCd[12 + tid] = sigm(bf2f(ur[C_GB + h]));
        }
    }
    __syncthreads();
#pragma unroll
    for (int t = 0; t < 4; ++t) {
        const float a = SCd[8 + t], beta = SCd[12 + t], rk = SCd[4 + t], rq = SCd[t];
        const LAS float* kp = XQ + t * 384 + 128 + dq * 32; const LAS float* qp = XQ + t * 384 + dq * 32;
        float part = 0.f;
#pragma unroll
        for (int i = 0; i < 32; ++i) { S[i] *= a; part += kp[i] * S[i]; }
        RED[((t * 2 + 0) * 4 + dq) * 128 + e] = part * rk;
        __syncthreads();
        const float kS = (RED[((t * 2) * 4 + 0) * 128 + e] + RED[((t * 2) * 4 + 1) * 128 + e]) + (RED[((t * 2) * 4 + 2) * 128 + e] + RED[((t * 2) * 4 + 3) * 128 + e]);
        const float dv = beta * (XQ[t * 384 + 256 + e] - kS) * rk;
        float part2 = 0.f;
#pragma unroll
        for (int i = 0; i < 32; ++i) { S[i] += kp[i] * dv; part2 += qp[i] * S[i]; }
        RED[((t * 2 + 1) * 4 + dq) * 128 + e] = part2 * rq;
    }
    __syncthreads();
    {
        const int t = tid >> 7;
        const float o = (RED[((t * 2 + 1) * 4 + 0) * 128 + e] + RED[((t * 2 + 1) * 4 + 1) * 128 + e]) + (RED[((t * 2 + 1) * 4 + 2) * 128 + e] + RED[((t * 2 + 1) * 4 + 3) * 128 + e]);
        const float ss = wave_sum(o * o);
        if (lane == 0) SS[w] = ss;
        __syncthreads();
        const float rs = rsqrtf((SS[2 * t] + SS[2 * t + 1]) * (1.f / 128.f) + EPS);
        const float gz = bf2f(U[(size_t)(row0 + t) * LDU + C_GZ + h * 128 + e]);
        O[(size_t)(row0 + t) * DM + 256 + h * 128 + e] = f2bfs(o * rs * inptr(I_GNORM)[l * 128 + e] * siluf(gz));
    }
    { float* op_ = outq(C) + O_GDNS + sbase;
#pragma unroll
      for (int i = 0; i < 32; ++i) op_[(size_t)i * 128] = S[i]; }
    __syncthreads();
}
__device__ __forceinline__ void hl_dec_item(Ctx& C, int l, int seq) {
    int tid_ = threadIdx.x; asm volatile("" : "+v"(tid_)); const int tid = tid_, lane = tid & 63, wv_ = 0; (void)wv_;
    LAS float* QK = (LAS float*)(ldsq(C));
    LAS float* REDh = (LAS float*)(ldsq(C) + 16384);
    LAS float* XCs = (LAS float*)(ldsq(C) + 24576);
    const bf16* U = (const bf16*)(wsq(C) + WS_U); bf16* O = (bf16*)(wsq(C) + WS_O);
    const int row0 = MP + seq * 4;
    if (tid < 256) {
        const int ch = tid; float lb = 0.f;
        if (l == 1) { const float b0 = inptr(I_HGLB)[ch], b1 = inptr(I_HGLB)[256 + ch]; lb = __builtin_amdgcn_rcpf(1.f + __expf(b0 - b1)); }
        const float oml = 1.f - lb;
#pragma unroll
        for (int t = 0; t < 4; ++t) {
            const bf16* ur = U + (size_t)(row0 + t) * LDU;
            const float z = bf2f(ur[C_HF + ch]); const float sg = sigm(z);
            QK[t * 256 + ch] = siluf(bf2f(ur[C_HQ + ch])); QK[1024 + t * 256 + ch] = oml * (1.f - sg); QK[2048 + t * 256 + ch] = lb + oml * sg; QK[3072 + t * 256 + ch] = bf2f(ur[C_HI + ch]);
        }
    } else {
        const int ch = tid - 256; float xs[7], cw[4];
#pragma unroll
        for (int k = 0; k < 3; ++k) xs[k] = inptr(I_SLC)[((size_t)(l * NSQ + seq) * 3 + k) * 256 + ch];
#pragma unroll
        for (int t = 0; t < 4; ++t) xs[3 + t] = bf2f(U[(size_t)(row0 + t) * LDU + C_LX + ch]);
#pragma unroll
        for (int k = 0; k < 4; ++k) cw[k] = inptr(I_LCW)[(l * 4 + k) * 256 + ch];
        const float cb = inptr(I_LCB)[l * 256 + ch];
#pragma unroll
        for (int t = 0; t < 4; ++t) XCs[t * 256 + ch] = cw[0] * xs[t] + cw[1] * xs[t + 1] + cw[2] * xs[t + 2] + cw[3] * xs[t + 3] + cb;
#pragma unroll
        for (int k = 0; k < 3; ++k) outq(C)[O_LCS + ((size_t)(l * NSQ + seq) * 3 + k) * 256 + ch] = xs[4 + k];
    }
    __syncthreads();
    {
        const int hh = tid >> 7, dh = (tid >> 6) & 1, e = tid & 63;
        const size_t sbase = ((size_t)((l * NSQ + seq) * 4 + hh) * 64 + dh * 32) * 64 + e;
        float S[32];
#pragma unroll
        for (int i = 0; i < 32; ++i) S[i] = inptr(I_SHG)[sbase + (size_t)i * 64];
#pragma unroll
        for (int t = 0; t < 4; ++t) {
            const float v = QK[3072 + t * 256 + hh * 64 + e]; const int dd = hh * 64 + dh * 32;
            float part = 0.f;
#pragma unroll
            for (int i = 0; i < 32; ++i) { S[i] = QK[2048 + t * 256 + dd + i] * S[i] + QK[1024 + t * 256 + dd + i] * v; part += QK[t * 256 + dd + i] * S[i]; }
            REDh[((t * 4 + hh) * 2 + dh) * 64 + e] = part;
        }
#pragma unroll
        for (int i = 0; i < 32; ++i) outq(C)[O_HGS + sbase + (size_t)i * 64] = S[i];
    }
    __syncthreads();
#pragma unroll
    for (int rep = 0; rep < 2; ++rep) {
        const int id = tid + 512 * rep, t = id >> 8, hh = (id >> 6) & 3, e = id & 63;
        const float o = REDh[((t * 4 + hh) * 2) * 64 + e] + REDh[((t * 4 + hh) * 2 + 1) * 64 + e];
        const float rs = rsqrtf(wave_sum(o * o) * (1.f / 64.f) + EPS);
        const float hz = bf2f(U[(size_t)(row0 + t) * LDU + C_HZ + hh * 64 + e]);
        O[(size_t)(row0 + t) * DM + hh * 64 + e] = f2bfs(o * rs * inptr(I_HGN)[l * 64 + e] * siluf(hz));
    }
    if (tid < 256) {
        const int ch = tid, blk = ch >> 6, jl = ch & 63;
        float pa[4] = {0.f, 0.f, 0.f, 0.f}, px[4] = {0.f, 0.f, 0.f, 0.f};
        const float* wa = inptr(I_LWA) + (size_t)(l * 4 + blk) * 4096 + jl; const float* wx = inptr(I_LWX) + (size_t)(l * 4 + blk) * 4096 + jl;
#pragma unroll 8
        for (int i = 0; i < 64; ++i) {
            const float a = wa[i * 64], x = wx[i * 64];
#pragma unroll
            for (int t = 0; t < 4; ++t) { const float xc = XCs[t * 256 + blk * 64 + i]; pa[t] += xc * a; px[t] += xc * x; }
        }
        const float ba = inptr(I_LBA)[l * 256 + ch], bx = inptr(I_LBX)[l * 256 + ch], sp = softplusf(-inptr(I_LLAM)[l * 256 + ch]);
        float hcur = inptr(I_SLRU)[(size_t)(l * NSQ + seq) * 256 + ch];
#pragma unroll
        for (int t = 0; t < 4; ++t) {
            const float rr = sigm(pa[t] + ba), ii = sigm(px[t] + bx), la = -8.f * rr * sp;
            hcur = __expf(la) * hcur + sqrtf(fmaxf(0.f, -expm1f(2.f * la))) * ii * XCs[t * 256 + ch];
            const float lz = bf2f(U[(size_t)(row0 + t) * LDU + C_LZ + ch]);
            O[(size_t)(row0 + t) * DM + 768 + ch] = f2bfs(hcur * gelu_tanh(lz));
        }
        outq(C)[O_LRUS + (size_t)(l * NSQ + seq) * 256 + ch] = hcur;
    }
    __syncthreads();
}

__device__ __forceinline__ void side_gemm_res(Ctx& C, const bf16* A, const bf16* Bt, int K, const float* xin, float* xout, const float* gvec, const float* scn, const float* gamma, bf16* XS, float* rss) {
    int tid_ = threadIdx.x; asm volatile("" : "+v"(tid_)); const int tid = tid_, lane = tid & 63, w = __builtin_amdgcn_readfirstlane(tid >> 6), g = lane >> 4, c = lane & 15;
    int bx_ = (int)blockIdx.x; asm volatile("" : "+s"(bx_));
    const int rb = bx_ >> 4, cb = bx_ & 15, rt = w >> 2, ct = w & 3;
    if (bx_ >= 256) return;
    const int row = rb * 32 + rt * 16 + c;
    const int ncol = cb * 64 + ct * 16 + c;
    const bf16* ap = A + (size_t)row * K + 8 * g; const bf16* bp = Bt + (size_t)ncol * K + 8 * g;
    f32x4 acc0 = (f32x4){0.f, 0.f, 0.f, 0.f}, acc1 = acc0;
    bf16x8 fa[8], fb[8], ga[8], gb[8];
#pragma unroll
    for (int j = 0; j < 8; ++j) { fa[j] = *(const bf16x8*)(ap + 32 * j); fb[j] = *(const bf16x8*)(bp + 32 * j); }
    for (int k0 = 0; k0 < K; k0 += 512) {
        const bool h2 = k0 + 256 < K, h3 = k0 + 512 < K;
        if (h2) {
#pragma unroll
            for (int j = 0; j < 8; ++j) { ga[j] = *(const bf16x8*)(ap + k0 + 256 + 32 * j); gb[j] = *(const bf16x8*)(bp + k0 + 256 + 32 * j); }
        }
        __builtin_amdgcn_sched_barrier(0);
#pragma unroll
        for (int j = 0; j < 8; j += 2) { acc0 = mfma16(fb[j], fa[j], acc0); acc1 = mfma16(fb[j + 1], fa[j + 1], acc1); }
        __builtin_amdgcn_sched_barrier(0);
        if (h3) {
#pragma unroll
            for (int j = 0; j < 8; ++j) { fa[j] = *(const bf16x8*)(ap + k0 + 512 + 32 * j); fb[j] = *(const bf16x8*)(bp + k0 + 512 + 32 * j); }
        }
        __builtin_amdgcn_sched_barrier(0);
        if (h2) {
#pragma unroll
            for (int j = 0; j < 8; j += 2) { acc0 = mfma16(gb[j], ga[j], acc0); acc1 = mfma16(gb[j + 1], ga[j + 1], acc1); }
        }
        __builtin_amdgcn_sched_barrier(0);
    }
    const f32x4 acc = acc0 + acc1;
    const int col = cb * 64 + ct * 16 + 4 * g, grow = MP + row, s = NBP + (row >> 2);
    const f32x4 xn = *(const f32x4*)(xin + (size_t)row * DM + col) + *(const f32x4*)(gvec + (size_t)s * 6144 + col) * acc;
    *(f32x4*)(xout + (size_t)grow * DM + col) = xn;
    if (scn) { const f32x4 v = xn * *(const f32x4*)(gamma + col) * (*(const f32x4*)(scn + (size_t)s * 6144 + col) + 1.f);
        u32x2 wv; wv.x = pk2(v.x, v.y); wv.y = pk2(v.z, v.w); *(u32x2*)(XS + (size_t)grow * DM + col) = wv; }
    float ss = (xn.x * xn.x + xn.y * xn.y) + (xn.z * xn.z + xn.w * xn.w);
    ss += __shfl_xor(ss, 16); ss += __shfl_xor(ss, 32);
    LAS float* red = (LAS float*)(ldsq(C));
    if (g == 0) red[(rt * 16 + c) * 4 + ct] = ss;
    __syncthreads();
    if (tid < 32) { const f32x4 p = *(const LAS f32x4*)(red + tid * 4); rss[(size_t)(MP + rb * 32 + tid) * 16 + cb] = (p.x + p.y) + (p.z + p.w); }
    __syncthreads();
}

__device__ __forceinline__ void cvec_units(Ctx& C, int r, int ashi, int ashi2, bool do1, bool dogu) {
    const bf16* ash = (const bf16*)(wsq(C) + WS_ASH) + (size_t)ashi * 256 * DM; const bf16* ash2 = (const bf16*)(wsq(C) + WS_ASH) + (size_t)ashi2 * 256 * DM;
    if (do1) {
        OneUnit S{(r >= 0 && r < 15) ? r : -1};
        pg8::Gemm g{ash, (const bf16*)(wsq(C) + WS_WIN), 256, LDU, DM};
        EpiModCvec E{(float*)(wsq(C) + WS_CV1), LDU, nullptr, NSEQ, 0, nullptr};
        pg8::gemm_phase<EpiModCvec, OneUnit, false, true>(ldsq(C), g, S, E);
    }
    if (dogu) {
        const int r2 = do1 ? r - 15 : r;
        { OneUnit S{(r2 >= 0 && r2 < 11) ? r2 : -1};
          pg8::Gemm g{ash2, (const bf16*)(wsq(C) + WS_WG), 256, DFF, DM};
          EpiModCvec E{(float*)(wsq(C) + WS_CVG), DFF, nullptr, NSEQ, 0, nullptr};
          pg8::gemm_phase<EpiModCvec, OneUnit, false, true>(ldsq(C), g, S, E); }
        { OneUnit S{(r2 >= 11 && r2 < 22) ? r2 - 11 : -1};
          pg8::Gemm g{ash2, (const bf16*)(wsq(C) + WS_WU), 256, DFF, DM};
          EpiModCvec E{(float*)(wsq(C) + WS_CVU), DFF, nullptr, NSEQ, 0, nullptr};
          pg8::gemm_phase<EpiModCvec, OneUnit, false, true>(ldsq(C), g, S, E); }
    }
}
constexpr int CW_QHEAD = 12288 + 256;
constexpr int Q_PREP = 1024, Q_LRU1 = Q_PREP + 256, Q_DEC = Q_LRU1 + 640, Q_CONV = Q_DEC + 64, Q_LRU3 = Q_CONV + 256;
__device__ __forceinline__ void phase_m12(Ctx& C, int l) {
    int v_ = (int)blockIdx.x; asm volatile("" : "+s"(v_)); const int v = v_;
    unsigned* gcnt = (unsigned*)((gu32*)(wsq(C) + WS_CTL) + CW_GCNT + l * 32 * 64);
    unsigned* lcnt = (unsigned*)((gu32*)(wsq(C) + WS_CTL) + CW_LCNT + l * 64);
    unsigned* qhead = (unsigned*)((gu32*)(wsq(C) + WS_CTL) + CW_QHEAD + l * 64);
    if (v < 32) gdn_chain(C, l, v >> 2, v & 3);
    else if (v < 64) { const int r = v - 32; hgrn_chain(C, l, r >> 2, r & 3); }
    LAS unsigned* qslot = (LAS unsigned*)(ldsq(C) + MISC_OFF + 96);
    bool lru_ok = false;
    for (;;) {
        __syncthreads();
        if (threadIdx.x == 0) *qslot = __hip_atomic_fetch_add(qhead, 1u, __ATOMIC_RELAXED, __HIP_MEMORY_SCOPE_AGENT);
        __syncthreads();
        const int j = (int)*qslot;
        if (j >= Q_LRU3) break;
        if (j < Q_PREP) { const int n = j >> 5, bh = j & 31; gdn_prep_item(C, l, bh >> 2, bh & 3, n, gcnt + 64 * n); }
        else if (j < Q_LRU1) { const int it = j - Q_PREP; lru_pass1_item(C, l, it >> 5, it & 31, lcnt); }
        else if (j < Q_DEC) { const int it = j - Q_LRU1; if (it < 512) gdn_dec_item(C, l, it >> 2, it & 3); else hl_dec_item(C, l, it - 512); }
        else if (j < Q_CONV) {
            const int gw = (j - Q_DEC) * NWAVES + C.wave, ngw = 64 * NWAVES; int base = 0;
            tr_job(C, inptr(I_WOUT) + (size_t)l * DM * DM, (bf16*)(wsq(C) + WS_WOUT), DM, DM, 0, DM, gw, ngw, base);
            tr_job(C, inptr(I_WD) + (size_t)l * DFF * DM, (bf16*)(wsq(C) + WS_WD), DM, DFF, 0, DM, gw, ngw, base);
            if (l == 0) tr_job(C, inptr(I_WIN) + (size_t)DM * 3592, (bf16*)(wsq(C) + WS_WIN), 3592, DM, 1, LDU, gw, ngw, base);
        } else {
            if (!lru_ok) { if (threadIdx.x == 0) poll_acquire(lcnt, 256u); __syncthreads(); lru_ok = true; }
            const int it = j - Q_CONV; lru_pass3_item(C, l, it >> 5, it & 31);
        }
    }
}

#ifndef MK_PER_PHASE
#define MK_PER_PHASE 0
#endif
constexpr int NPHASE = 18;
struct Args { const float* in[N_IN]; float* out; unsigned char* ws; int ph_lo, ph_hi; };
static_assert(sizeof(Args) == N_IN * 8 + 24, "Args has no padding");
__global__ void __launch_bounds__(NTHR, 2) mega_fwd(Args args) {
    extern __shared__ __attribute__((aligned(16))) unsigned char lds_raw[];
    Ctx C;
    C.lds_ = (LAS unsigned char*)lds_raw;
    C.wave = __builtin_amdgcn_readfirstlane((int)threadIdx.x >> 6);
    C.G = gridDim.x; { const int bx = blockIdx.x; C.vcu = (bx & 7) * (C.G >> 3) + (bx >> 3); }
    C.out_ = args.out; C.ws_ = args.ws;
    for (int u = threadIdx.x; u < (LDS_BYTES - LDSCTL_OFF) / 4; u += NTHR) ((LAS unsigned*)(ldsq(C) + LDSCTL_OFF))[u] = 0u;
    __syncthreads();
#if MK_PER_PHASE
    const int lo = args.ph_lo, hi = args.ph_hi;
#else
    constexpr int lo = 0, hi = NPHASE;
#endif
    if (hi - lo > 1) (void)xcd_barrier_post((unsigned*)((gu32*)(wsq(C) + WS_CTL) + CW_BAR), (volatile LAS unsigned*)(size_t)(MISC_OFF + 32));
#ifndef PROBE_MASK
#define PROBE_MASK 0u
#endif
#define PRB ((volatile LAS unsigned long long*)(ldsq(C) + MISC_OFF + 64))
#ifndef PROBE_PRE
#define PROBE_PRE 0
#endif
#define prb_thr ((PROBE_MASK != 0u || PROBE_REGION != 0) && C.vcu == PROBE_VCU && threadIdx.x == 0)
#define PH_BEGIN(k) do { if (prb_thr && ((PROBE_MASK >> (k)) & 1u)) PRB[0] = __builtin_amdgcn_s_memrealtime(); } while (0)
#define PH_END_(k) do { if (prb_thr && ((PROBE_MASK >> (k)) & 1u)) PRB[1] = PRB[1] + (__builtin_amdgcn_s_memrealtime() - PRB[0]); } while (0)
#define PH_END(k) do { if (!PROBE_PRE) PH_END_(k); } while (0)
#define PH_PRE(k) do { if (PROBE_PRE) PH_END_(k); } while (0)
#define IN(k) (lo <= (k) && (k) < hi)
#define SEAM(k) do { if (IN(k) && IN((k) + 1)) { XcdBarrier b2_; b2_.bar = (unsigned*)((gu32*)(wsq(C) + WS_CTL) + CW_BAR); b2_.x = xb_xcc_id(); b2_.st = (volatile LAS unsigned*)(size_t)(MISC_OFF + 32); xcd_barrier(b2_); } } while (0)
#define MODP ((const float*)(wsq(C) + WS_MOD))
#define RSSP ((float*)(wsq(C) + WS_RSS))
#define XSb ((bf16*)(wsq(C) + WS_XS))
#define Ub ((bf16*)(wsq(C) + WS_U))
#define Ob ((bf16*)(wsq(C) + WS_O))
#define GPb ((bf16*)(wsq(C) + WS_GP))
#define ACTb ((bf16*)(wsq(C) + WS_ACT))

    PH_BEGIN(0);
    if (IN(0)) { phase_p0(C); }
    SEAM(0);
    PH_END(0); PH_BEGIN(1);
    if (IN(1)) {
        pg8::Gemm g{(const bf16*)(wsq(C) + WS_AC), (const bf16*)(wsq(C) + WS_WADA), 256, 12288, DM};
        pg8::StaticOrder S; S.init(256, 12288, C.G, bxq());
        EpiModCvec E{(float*)(wsq(C) + WS_MOD), 6144, inptr(I_BADA), NSEQ, 1, (bf16*)(wsq(C) + WS_ASH)};
        pg8::gemm_phase<EpiModCvec, pg8::StaticOrder, false, true>(ldsq(C), g, S, E);
        if ((int)blockIdx.x >= 48) {
            const int gw = ((int)blockIdx.x - 48) * NWAVES + C.wave, ngw = (C.G - 48) * NWAVES; int base = 0;
            tr_job(C, inptr(I_WIN), (bf16*)(wsq(C) + WS_WIN), 3592, DM, 1, LDU, gw, ngw, base);
            tr_job(C, inptr(I_WG), (bf16*)(wsq(C) + WS_WG), DFF, DM, 0, DFF, gw, ngw, base);
            tr_job(C, inptr(I_WU), (bf16*)(wsq(C) + WS_WU), DFF, DM, 0, DFF, gw, ngw, base);
        }
    }
    SEAM(1);
    PH_END(1); PH_BEGIN(2);
    if (IN(2)) {
        if (C.vcu < 37) cvec_units(C, C.vcu, 0, 1, true, true);
        else x_to_xs(C, (C.vcu - 37) * NWAVES + C.wave, (C.G - 37) * NWAVES);
    }
    SEAM(2);
    PH_END(2);
#pragma unroll 1
    for (int l = 0; l < 2; ++l) {
        const int p = 3 + 7 * l;
        PH_BEGIN(p);
        if (IN(p)) {
            pg8::Gemm g{XSb, (const bf16*)(wsq(C) + WS_WIN), MROWS, LDU, DM};
            pg8::StaticOrder S; S.init(MROWS, LDU, C.G, bxq());
            EpiU E{Ub, RSSP, (const float*)(wsq(C) + WS_CV1), LDU, LDU};
            pg8::gemm_phase<EpiU, pg8::StaticOrder, true, true>(ldsq(C), g, S, E);
            if (l == 1) cvec_units(C, bxq() - 222, 3, 3, false, true);
        }
        SEAM(p);
        PH_END(p); PH_BEGIN(p + 1);
        if (IN(p + 1)) phase_m12(C, l);
        PH_PRE(p + 1);
        SEAM(p + 1);
        PH_END(p + 1); PH_BEGIN(p + 2);
        PH_PRE(p + 2);
        PH_END(p + 2); PH_BEGIN(p + 3);
        if (IN(p + 3)) {
            pg8::Gemm g{Ob, (const bf16*)(wsq(C) + WS_WOUT), MP, DM, DM};
            pg8::StaticOrder S; S.init(MP, DM, C.G, bxq());
            const float* modl = MODP + (size_t)l * NSEQ * 6144;
            EpiRes E{l == 0 ? inptr(I_XP) : outq(C), outq(C), modl + 2048, modl + 4096, inptr(I_NFFN) + l * DM, XSb, RSSP};
            pg8::gemm_phase<EpiRes, pg8::StaticOrder, true, true>(ldsq(C), g, S, E);
            side_gemm_res(C, Ob + (size_t)MP * DM, (const bf16*)(wsq(C) + WS_WOUT), DM, l == 0 ? inptr(I_XS) : outq(C) + (size_t)MP * DM, outq(C), modl + 2048, modl + 4096, inptr(I_NFFN) + l * DM, XSb, RSSP);
        }
        SEAM(p + 3);
        PH_END(p + 3); PH_BEGIN(p + 4);
        if (IN(p + 4)) {
            pg8::Gemm g{XSb, (const bf16*)(wsq(C) + WS_WG), MROWS, DFF, DM};
            pg8::StaticOrder S; S.init(MROWS, DFF, C.G, bxq());
            EpiGate E{GPb, RSSP, (const float*)(wsq(C) + WS_CVG), outq(C) + O_FCP + (size_t)l * NBP * 2 * DFF, outq(C) + O_FCS + (size_t)l * NSQ * 2 * DFF};
            pg8::gemm_phase<EpiGate, pg8::StaticOrder, true, true>(ldsq(C), g, S, E);
            if (l == 0) cvec_units(C, bxq() - 214, 2, 2, true, false);
        }
        SEAM(p + 4);
        PH_END(p + 4); PH_BEGIN(p + 5);
        if (IN(p + 5)) {
            pg8::Gemm g{XSb, (const bf16*)(wsq(C) + WS_WU), MROWS, DFF, DM};
            pg8::StaticOrder S; S.init(MROWS, DFF, C.G, bxq());
            EpiUp E{ACTb, GPb, RSSP, (const float*)(wsq(C) + WS_CVU), inptr(I_FCW) + (size_t)l * 3 * DFF, inptr(I_FCB) + (size_t)l * DFF, inptr(I_SFC) + (size_t)l * NSQ * 2 * DFF};
            pg8::gemm_phase<EpiUp, pg8::StaticOrder, true, true>(ldsq(C), g, S, E);
        }
        SEAM(p + 5);
        PH_END(p + 5); PH_BEGIN(p + 6);
        if (IN(p + 6)) {
            pg8::Gemm g{ACTb, (const bf16*)(wsq(C) + WS_WD), MP, DM, DFF};
            pg8::StaticOrder S; S.init(MP, DM, C.G, bxq());
            const float* modl = MODP + (size_t)l * NSEQ * 6144; const float* mod1 = MODP + (size_t)NSEQ * 6144;
            EpiRes E{outq(C), outq(C), modl + 5120, l == 0 ? mod1 + 1024 : nullptr, inptr(I_NMIX) + DM, XSb, RSSP};
            pg8::gemm_phase<EpiRes, pg8::StaticOrder, true, true>(ldsq(C), g, S, E);
            side_gemm_res(C, ACTb + (size_t)MP * DFF, (const bf16*)(wsq(C) + WS_WD), DFF, outq(C) + (size_t)MP * DM, outq(C), modl + 5120, l == 0 ? mod1 + 1024 : nullptr, inptr(I_NMIX) + DM, XSb, RSSP);
            if (l == 0) {
                const int gw = C.vcu * NWAVES + C.wave, ngw = C.G * NWAVES; int base = 0;
                tr_job(C, inptr(I_WG) + (size_t)DM * DFF, (bf16*)(wsq(C) + WS_WG), DFF, DM, 0, DFF, gw, ngw, base);
                tr_job(C, inptr(I_WU) + (size_t)DM * DFF, (bf16*)(wsq(C) + WS_WU), DFF, DM, 0, DFF, gw, ngw, base);
            }
        }
        SEAM(p + 6);
        PH_END(p + 6);
    }
    PH_BEGIN(17);
    if (IN(17)) phase_final(C);
    PH_END(17);
    if (prb_thr) { const unsigned long long tgt = __builtin_amdgcn_s_memrealtime() + 4ull * PRB[1]; while (__builtin_amdgcn_s_memrealtime() < tgt) __builtin_amdgcn_s_sleep(8); }
#undef IN
#undef SEAM
}

#ifndef MK_PER_PHASE
#define MK_PER_PHASE 0
#endif
extern "C" void kernel_launch(void* const* d_in, const int* in_sizes, int n_in, void* d_out, int out_size, void* d_ws, size_t ws_size, hipStream_t stream) {
    static int grid = 0;
    if (grid == 0) {
        int dev = 0, cus = 0;
        if (n_in != N_IN || (size_t)out_size != O_END || ws_size < WS_END) { fprintf(stderr, "kernel_launch: unexpected problem (n_in %d, out %d, ws %zu)\n", n_in, out_size, ws_size); grid = -1; return; }
        if (hipGetDevice(&dev) != hipSuccess || hipDeviceGetAttribute(&cus, hipDeviceAttributeMultiprocessorCount, dev) != hipSuccess) { grid = -1; return; }
        if (hipFuncSetAttribute((const void*)mega_fwd, hipFuncAttributeMaxDynamicSharedMemorySize, LDS_BYTES) != hipSuccess) { fprintf(stderr, "kernel_launch: hipFuncSetAttribute failed\n"); grid = -1; return; }
        int per_cu = 0;
        if (hipOccupancyMaxActiveBlocksPerMultiprocessor(&per_cu, (const void*)mega_fwd, NTHR, LDS_BYTES) != hipSuccess || per_cu < 1) fprintf(stderr, "kernel_launch: occupancy query says %d blocks per CU\n", per_cu);
        (void)hipGetLastError();
        grid = cus & ~7;
    }
    if (grid < 0) return;
    (void)hipMemsetAsync((char*)d_ws + WS_CTL, 0, CTL_ZERO_BYTES, stream);
    Args a{};
    for (int i = 0; i < N_IN; ++i) a.in[i] = (const float*)d_in[i];
    a.out = (float*)d_out; a.ws = (unsigned char*)d_ws;
#if MK_PER_PHASE
    for (int p = 0; p < NPHASE; ++p) { a.ph_lo = p; a.ph_hi = p + 1; hipLaunchKernelGGL(mega_fwd, dim3(grid), dim3(NTHR), LDS_BYTES, stream, a); }
#else
    a.ph_lo = 0; a.ph_hi = NPHASE;
    hipLaunchKernelGGL(mega_fwd, dim3(grid), dim3(NTHR), LDS_BYTES, stream, a);
#endif
}
```

```cpp
#include <hip/hip_runtime.h>
#include <cstdio>
#include <cstdint>
namespace pg8 {
#define PG8_LAS __attribute__((address_space(3)))
typedef unsigned short bf16_t;
typedef short bf16x8 __attribute__((ext_vector_type(8)));
typedef float f32x4 __attribute__((ext_vector_type(4)));
typedef unsigned u32x4 __attribute__((ext_vector_type(4)));
constexpr int BM = 256, BK = 64, HALF = 128, HTB = HALF * BK * 2  , STAGE_BYTES = 8 * HTB, NXCD = 8, WGM = 8;

__host__ __device__ __forceinline__ int lds_byte(int r, int c) { const int st = (r >> 4) * 2 + (c >> 5), rr = r & 15, cc = c & 31, ob = rr * 64 + cc * 2; return st * 1024 + (ob ^ (((ob >> 9) & 1) << 5)); }
__host__ __device__ __forceinline__ void stage_rc(int b, int& R, int& C) { const int st = b / 1024, sb = b % 1024, swz = sb ^ (((sb >> 9) & 1) << 5); R = (st >> 1) * 16 + swz / 64; C = (st & 1) * 32 + (swz % 64) / 2; }
__host__ __device__ __forceinline__ int perm32(int rho) { const int n = rho >> 4, i = rho & 15; return 8 * (i >> 2) + 4 * n + (i & 3); }

struct Unit { int pm, pn; };
struct Gemm { const bf16_t* A; const bf16_t* Bt; int M, N, K; };

struct StaticOrder {
    int nM, nN, nwg, G, c;
    __host__ __device__ void init(int M, int N, int G_, int c_) { nM = M / BM; nN = N / BM; nwg = nM * nN; G = G_; c = c_; }
    __host__ __device__ bool next(int i, Unit& u) const {
        const long L = (long)i * G + c; if (L >= nwg) return false;
        int wgid = (int)L; { const int q = nwg / NXCD, r = nwg % NXCD, xcd = wgid % NXCD, off = wgid / NXCD; wgid = (xcd < r ? xcd * (q + 1) : r * (q + 1) + (xcd - r) * q) + off; }
        const int nig = WGM * nN, gid = wgid / nig, fm = gid * WGM, gsz = (nM - fm) < WGM ? (nM - fm) : WGM;
        u.pm = fm + ((wgid % nig) % gsz); u.pn = (wgid % nig) / gsz; return true;
    }
    __device__ __forceinline__ void a_ready(const Unit&) const {}
    __device__ __forceinline__ void done(const Unit&) const {}
};

__device__ __forceinline__ unsigned cvt_pk_bf16(float lo, float hi) { unsigned r; asm volatile("v_cvt_pk_bf16_f32 %0, %1, %2" : "=v"(r) : "v"(lo), "v"(hi)); return r; }
template <class Epi, class Sched, bool ALIGN_EPI = false, bool SP2 = false>
__device__ __forceinline__ void gemm_phase(PG8_LAS unsigned char* lds, const Gemm g, const Sched& S, const Epi& E) {
    int tid_ = threadIdx.x; asm volatile("" : "+v"(tid_)); const int tid = tid_, wid = __builtin_amdgcn_readfirstlane(tid >> 6), lane = tid & 63, wr = wid >> 2, wc = wid & 3, fr = lane & 15, fq = lane >> 4;
    const int K = g.K, nt = K / BK;
    unsigned voffA[2], voffB[2];
#pragma unroll
    for (int i = 0; i < 2; ++i) { int R, C; stage_rc(tid * 16 + i * 8192, R, C); const int Rb = Epi::PERM ? ((R & ~31) + perm32(R & 31)) : R;
        voffA[i] = (unsigned)(R * K + C) * 2u; voffB[i] = (unsigned)(Rb * K + C) * 2u; }
    const size_t kstep = (size_t)(BK * 2);
    const size_t hstep = (size_t)HALF * K * 2;
    const size_t tstep = 2 * hstep;
    const unsigned ldsw = (unsigned)wid * 1024u;
    const int aoff = lds_byte(wr * 64 + fr, fq * 8), boff = lds_byte(wc * 32 + fr, fq * 8);
#define PG8_SA(b, h) (((b) * 2 + (h)) * HTB)
#define PG8_SB(b, h) ((4 + (b) * 2 + (h)) * HTB)
#define PG8_STAGE(bufoff, gbase, voff) do { _Pragma("unroll") for (int _i = 0; _i < 2; ++_i) \
        __builtin_amdgcn_global_load_lds((const unsigned*)((const char*)(gbase) + (voff)[_i]), (PG8_LAS unsigned*)(lds + (bufoff) + ldsw + _i * 8192), 16, 0, 0); } while (0)
#define PG8_LDA(dst, b, h) do { _Pragma("unroll") for (int m = 0; m < 4; ++m) _Pragma("unroll") for (int k = 0; k < 2; ++k) dst[m][k] = *(const PG8_LAS bf16x8*)(lds + PG8_SA(b, h) + aoff + m * 2048 + k * 1024); } while (0)
#define PG8_LDB(dst, b, h) do { _Pragma("unroll") for (int n = 0; n < 2; ++n) _Pragma("unroll") for (int k = 0; k < 2; ++k) dst[n][k] = *(const PG8_LAS bf16x8*)(lds + PG8_SB(b, h) + boff + n * 2048 + k * 1024); } while (0)
#define PG8_MMA(ai, bj, At, Bt) do { __builtin_amdgcn_s_setprio(1); _Pragma("unroll") for (int m = 0; m < 4; ++m) _Pragma("unroll") for (int n = 0; n < 2; ++n) _Pragma("unroll") for (int k = 0; k < 2; ++k) \
        acc[ai][bj][m][n] = __builtin_amdgcn_mfma_f32_16x16x32_bf16(Bt[n][k], At[m][k], acc[ai][bj][m][n], 0, 0, 0); __builtin_amdgcn_s_setprio(0); } while (0)
#define PG8_WAIT_V(n) asm volatile("s_waitcnt vmcnt(" #n ")" ::: "memory")
#define PG8_WAIT_L(n) asm volatile("s_waitcnt lgkmcnt(" #n ")" ::: "memory")
#define PG8_BAR __builtin_amdgcn_s_barrier()
#define PG8_SCHED __builtin_amdgcn_sched_barrier(0)
    Unit cur, nxt; int ui = 0;
    if (!S.next(0, cur)) return;
    f32x4 acc[2][2][4][2];
#pragma unroll
    for (int a = 0; a < 2; ++a)
#pragma unroll
        for (int b = 0; b < 2; ++b)
#pragma unroll
            for (int m = 0; m < 4; ++m)
#pragma unroll
                for (int n = 0; n < 2; ++n) acc[a][b][m][n] = (f32x4){0.f, 0.f, 0.f, 0.f};
    bf16x8 At[4][2], B0[2][2], B1[2][2];
    const char* cA = (const char*)g.A + (size_t)cur.pm * tstep; const char* cB = (const char*)g.Bt + (size_t)cur.pn * tstep;
    S.a_ready(cur);
    if constexpr (SP2) {
        PG8_STAGE(PG8_SB(0, 0), cB, voffB); PG8_STAGE(PG8_SB(0, 1), cB + hstep, voffB); PG8_STAGE(PG8_SA(0, 0), cA, voffA); PG8_STAGE(PG8_SA(0, 1), cA + hstep, voffA);
        if (wr == 1) PG8_BAR;
        PG8_WAIT_V(2); PG8_BAR;
        PG8_STAGE(PG8_SB(1, 0), cB + kstep, voffB); PG8_STAGE(PG8_SA(1, 0), cA + kstep, voffA); PG8_STAGE(PG8_SB(1, 1), cB + hstep + kstep, voffB);
        PG8_WAIT_V(6); PG8_BAR;
    } else {
        PG8_STAGE(PG8_SB(0, 0), cB, voffB); PG8_STAGE(PG8_SA(0, 0), cA, voffA); PG8_STAGE(PG8_SB(0, 1), cB + hstep, voffB); PG8_STAGE(PG8_SA(0, 1), cA + hstep, voffA);
        if (wr == 1) PG8_BAR;
        PG8_WAIT_V(4); PG8_BAR;
        PG8_STAGE(PG8_SB(1, 0), cB + kstep, voffB); PG8_STAGE(PG8_SA(1, 0), cA + kstep, voffA); PG8_STAGE(PG8_SB(1, 1), cB + hstep + kstep, voffB);
        PG8_WAIT_V(6); PG8_BAR;
    }
    for (;;) {
        const bool has_next = S.next(ui + 1, nxt);
        const char* nA = has_next ? (const char*)g.A + (size_t)nxt.pm * tstep : cA; const char* nB = has_next ? (const char*)g.Bt + (size_t)nxt.pn * tstep : cB;
        for (int t = 0; t < nt; t += 2) {
            const bool last = (t == nt - 2);
            const char* a1 = cA + (size_t)(t + 1) * kstep;
            const char* a2 = last ? nA : cA + (size_t)(t + 2) * kstep; const char* b2 = last ? nB : cB + (size_t)(t + 2) * kstep;
            const char* a3 = a2 + kstep; const char* b3 = b2 + kstep;
            if (last && has_next) S.a_ready(nxt);
            if constexpr (SP2) {
            PG8_LDB(B0, 0, 0); PG8_LDB(B1, 0, 1); PG8_SCHED; PG8_LDA(At, 0, 0); PG8_STAGE(PG8_SA(1, 1), a1 + hstep, voffA);
            PG8_WAIT_V(8); PG8_WAIT_L(0); PG8_BAR; PG8_MMA(0, 0, At, B0); PG8_MMA(0, 1, At, B1); PG8_BAR; PG8_SCHED;
            PG8_LDA(At, 0, 1); PG8_STAGE(PG8_SB(0, 0), b2, voffB); PG8_STAGE(PG8_SB(0, 1), b2 + hstep, voffB); PG8_STAGE(PG8_SA(0, 0), a2, voffA);
            PG8_WAIT_V(8); PG8_WAIT_L(0); PG8_BAR; PG8_MMA(1, 0, At, B0); PG8_MMA(1, 1, At, B1); PG8_BAR; PG8_SCHED;
            PG8_LDB(B0, 1, 0); PG8_LDB(B1, 1, 1); PG8_SCHED; PG8_LDA(At, 1, 0); PG8_STAGE(PG8_SA(0, 1), a2 + hstep, voffA);
            PG8_WAIT_V(8); PG8_WAIT_L(0); PG8_BAR; PG8_MMA(0, 0, At, B0); PG8_MMA(0, 1, At, B1); PG8_BAR; PG8_SCHED;
            PG8_LDA(At, 1, 1); PG8_STAGE(PG8_SB(1, 0), b3, voffB); PG8_STAGE(PG8_SB(1, 1), b3 + hstep, voffB); PG8_STAGE(PG8_SA(1, 0), a3, voffA);
            PG8_WAIT_V(8); PG8_WAIT_L(0); PG8_BAR; PG8_MMA(1, 0, At, B0); PG8_MMA(1, 1, At, B1); PG8_BAR; PG8_SCHED;
            } else {
            PG8_LDB(B0, 0, 0); PG8_SCHED; PG8_LDA(At, 0, 0); PG8_STAGE(PG8_SA(1, 1), a1 + hstep, voffA);
            PG8_WAIT_L(8); PG8_BAR; PG8_WAIT_L(0); PG8_MMA(0, 0, At, B0); PG8_BAR; PG8_SCHED;
            PG8_LDB(B1, 0, 1); PG8_STAGE(PG8_SB(0, 0), b2, voffB);
            PG8_BAR; PG8_WAIT_L(0); PG8_MMA(0, 1, At, B1); PG8_BAR;
            PG8_LDA(At, 0, 1); PG8_STAGE(PG8_SA(0, 0), a2, voffA);
            PG8_BAR; PG8_WAIT_L(0); PG8_MMA(1, 0, At, B0); PG8_BAR; PG8_SCHED;
            PG8_STAGE(PG8_SB(0, 1), b2 + hstep, voffB);
            PG8_WAIT_V(6); PG8_BAR; PG8_MMA(1, 1, At, B1); PG8_BAR;
            PG8_LDB(B0, 1, 0); PG8_SCHED; PG8_LDA(At, 1, 0); PG8_STAGE(PG8_SA(0, 1), a2 + hstep, voffA);
            PG8_WAIT_L(8); PG8_BAR; PG8_WAIT_L(0); PG8_MMA(0, 0, At, B0); PG8_BAR; PG8_SCHED;
            PG8_LDB(B1, 1, 1); PG8_STAGE(PG8_SB(1, 0), b3, voffB);
            PG8_BAR; PG8_WAIT_L(0); PG8_MMA(0, 1, At, B1); PG8_BAR;
            PG8_LDA(At, 1, 1); PG8_STAGE(PG8_SA(1, 0), a3, voffA);
            PG8_BAR; PG8_WAIT_L(0); PG8_MMA(1, 0, At, B0); PG8_BAR; PG8_SCHED;
            PG8_STAGE(PG8_SB(1, 1), b3 + hstep, voffB);
            PG8_WAIT_V(6); PG8_BAR; PG8_MMA(1, 1, At, B1); PG8_BAR;
            }
        }
        if constexpr (ALIGN_EPI) { if (wr == 0) PG8_BAR; }
        if constexpr (!Epi::AFTER_DRAIN) { E(acc, cur, wr, wc, fr, fq); S.done(cur); }
        if (!has_next) break;
#pragma unroll
        for (int a = 0; a < 2; ++a)
#pragma unroll
            for (int b = 0; b < 2; ++b)
#pragma unroll
                for (int m = 0; m < 4; ++m)
#pragma unroll
                    for (int n = 0; n < 2; ++n) acc[a][b][m][n] = (f32x4){0.f, 0.f, 0.f, 0.f};
        cur = nxt; cA = nA; cB = nB; ++ui;
        if constexpr (ALIGN_EPI) { if (wr == 1) PG8_BAR; }
    }
    PG8_WAIT_V(0);
    if constexpr (!ALIGN_EPI) { if (wr == 0) PG8_BAR; }
    PG8_BAR;
    if constexpr (Epi::AFTER_DRAIN) { E.fused(acc, cur, wr, wc, fr, fq, lds, wid, lane); S.done(cur); }
#undef PG8_SA
#undef PG8_SB
#undef PG8_STAGE
#undef PG8_LDA
#undef PG8_LDB
#undef PG8_MMA
#undef PG8_WAIT_V
#undef PG8_WAIT_L
#undef PG8_BAR
#undef PG8_SCHED
}
}
#define GAS __attribute__((address_space(1)))
#define LAS __attribute__((address_space(3)))
typedef unsigned short bf16;
typedef unsigned v4u __attribute__((ext_vector_type(4)));
typedef float f32x4 __attribute__((ext_vector_type(4)));
typedef short bf16x8 __attribute__((ext_vector_type(8)));
typedef GAS unsigned gu32;
typedef GAS unsigned long long gu64;
#define RLX_AGENT __ATOMIC_RELAXED, __HIP_MEMORY_SCOPE_AGENT
#define LDS_WAIT() asm volatile("s_waitcnt lgkmcnt(0)" ::: "memory")
#define VM_WAIT() asm volatile("s_waitcnt vmcnt(0)" ::: "memory")
__device__ __forceinline__ unsigned long long rt() { return __builtin_amdgcn_s_memrealtime(); }
__device__ __forceinline__ unsigned f2bf(float f) { unsigned u = __builtin_bit_cast(unsigned, f); return (u + 0x7fffu + ((u >> 16) & 1u)) >> 16; }
__device__ __forceinline__ unsigned pk2(float lo, float hi) { unsigned r; asm("v_cvt_pk_bf16_f32 %0, %1, %2" : "=v"(r) : "v"(lo), "v"(hi)); return r; }

#define XB_TMO      128
#define XB_XCNT(j)  (256  + 64 * (j))
#define XB_XSUB(j)  (1280 + 64 * (j))
#define XB_XGEN(j)  (2304 + 64 * (j))
#define XB_TOP      3328
#define XB_TOPGEN   3392
#define XCD_BAR_WORDS 3456
#define XB_SPIN_CAP (1u << 18)

__device__ __forceinline__ unsigned xb_ld(unsigned* p)              { return __hip_atomic_load(p, __ATOMIC_RELAXED, __HIP_MEMORY_SCOPE_AGENT); }
__device__ __forceinline__ unsigned xb_add(unsigned* p, unsigned v) { return __hip_atomic_fetch_add(p, v, __ATOMIC_RELAXED, __HIP_MEMORY_SCOPE_AGENT); }
__device__ __forceinline__ unsigned xb_xcc_id() { return (unsigned)__builtin_amdgcn_s_getreg((3 << 11) | 20) & 0xFu; }
#define XB_SPIN(cond, bar) do { unsigned _sp = 0; while (cond) { __builtin_amdgcn_s_sleep(1); \
    if ((++_sp & 255u) == 0u) { if (xb_ld(&(bar)[XB_TMO])) break; if (_sp > XB_SPIN_CAP) { atomicAdd(&(bar)[XB_TMO], 1u); break; } } } } while (0)

struct XcdBarrier {
    unsigned* bar; unsigned x;
    volatile LAS unsigned* st;
};

__device__ __forceinline__ XcdBarrier xcd_barrier_post(unsigned* bar, volatile LAS unsigned* st) {
    XcdBarrier b; b.bar = bar; b.x = xb_xcc_id(); b.st = st;
    if (threadIdx.x == 0) (void)xb_add(&bar[XB_XCNT(b.x)], 1u);
    return b;
}
__device__ __forceinline__ void xcd_barrier_complete(unsigned* bar, unsigned x, unsigned& nloc, unsigned& nx) {
    const unsigned G = gridDim.x * gridDim.y * gridDim.z;
    unsigned sum, cnt, mine, sp = 0u;
    for (;;) {
        sum = 0u; cnt = 0u; mine = 0u;
#pragma unroll
        for (unsigned j = 0; j < 16; ++j) { const unsigned c = xb_ld(&bar[XB_XCNT(j)]); sum += c; cnt += (c > 0u) ? 1u : 0u; mine = (j == x) ? c : mine; }
        if (sum == G) break;
        __builtin_amdgcn_s_sleep(1);
        if ((++sp & 255u) == 0u) { if (xb_ld(&bar[XB_TMO])) break; if (sp > XB_SPIN_CAP) { atomicAdd(&bar[XB_TMO], 1u); break; } }
    }
    nloc = mine > 0u ? mine : 1u; nx = cnt > 0u ? cnt : 1u;
}

__device__ __forceinline__ void xcd_barrier(const XcdBarrier& b) {
    asm volatile("s_waitcnt vmcnt(0)" ::: "memory");
    __syncthreads();
    if (threadIdx.x == 0) {
        unsigned* bar = b.bar;
        __builtin_amdgcn_s_waitcnt(0);
        unsigned nloc = b.st[0], nx = b.st[1];
        if (nloc == 0u) { xcd_barrier_complete(bar, b.x, nloc, nx); b.st[0] = nloc; b.st[1] = nx; }
        const unsigned old = xb_add(&bar[XB_XSUB(b.x)], 1u);
        const unsigned gen = old / nloc;
        if (old + 1u == (gen + 1u) * nloc) {
            __builtin_amdgcn_fence(__ATOMIC_RELEASE, "agent");
            asm volatile("s_waitcnt vmcnt(0)" ::: "memory");
            const unsigned og = xb_add(&bar[XB_TOP], 1u);
            const unsigned tg = og / nx;
            if (og + 1u == (tg + 1u) * nx) xb_add(&bar[XB_TOPGEN], 1u);
            else XB_SPIN(xb_ld(&bar[XB_TOPGEN]) == tg, bar);
            __builtin_amdgcn_fence(__ATOMIC_ACQUIRE, "agent");
            xb_add(&bar[XB_XGEN(b.x)], 1u);
            asm volatile("s_waitcnt vmcnt(0)" ::: "memory");
        } else {
            XB_SPIN(xb_ld(&bar[XB_XGEN(b.x)]) == gen, bar);
            __builtin_amdgcn_fence(__ATOMIC_ACQUIRE, "agent");
            asm volatile("s_waitcnt vmcnt(0)" ::: "memory");
        }
    }
    __syncthreads();
}
constexpr int NWAVES = 8, NTHR = 512;
constexpr int DM = 1024, TSEQ = 2048, NBP = 8, NSQ = 128, TSMP = 4, NSEQ = 136;
constexpr int MP = 16384, MROWS = 16896;
constexpr int DFF = 2816, LDU = 3840;
constexpr float EPS = 1e-6f;
constexpr int C_HQ = 0, C_HF = 256, C_HI = 512, C_HZ = 768, C_Q = 1024, C_K = 1536, C_V = 2048, C_GZ = 2560, C_LX = 3072, C_LZ = 3328, C_GA = 3584, C_GB = 3588;
enum { I_XP = 0, I_XS, I_SHG, I_SGDN, I_SGC, I_SLRU, I_SLC, I_SFC, I_CP, I_CS, I_NMIX, I_NFFN, I_WADA, I_BADA, I_WIN, I_HGLB, I_HGN, I_GCW, I_GALOG, I_GDTB, I_GNORM,
       I_LCW, I_LCB, I_LWA, I_LBA, I_LWX, I_LBX, I_LLAM, I_WOUT, I_WG, I_WU, I_FCW, I_FCB, I_WD, I_FNORM, N_IN };
constexpr size_t O_YP = 0, O_YS = 16777216, O_HGP = 17301504, O_GDNP = 17563648, O_GCP = 18612224, O_LRUP = 18685952, O_LCP = 18690048, O_FCP = 18702336,
                 O_HGS = 18792448, O_GDNS = 22986752, O_GCS = 39763968, O_LRUS = 40943616, O_LCS = 41009152, O_FCS = 41205760, O_END = 42647552;
constexpr size_t MiB = 1u << 20;
constexpr size_t WS_CTL = 0, CTL_ZERO_BYTES = 65536;
constexpr size_t WS_WIN = 1 * MiB;
constexpr size_t WS_WOUT = 9 * MiB;
constexpr size_t WS_WG = 11 * MiB;
constexpr size_t WS_WU = 17 * MiB;
constexpr size_t WS_WD = 23 * MiB;
constexpr size_t WS_AC = 29 * MiB;
constexpr size_t WS_ASH = 30 * MiB;
constexpr size_t WS_MOD = 32 * MiB;
constexpr size_t WS_CV1 = 39 * MiB;
constexpr size_t WS_CVG = 41 * MiB;
constexpr size_t WS_CVU = 43 * MiB;
constexpr size_t WS_RSS = 45 * MiB;
constexpr size_t WS_XS = 47 * MiB;
constexpr size_t WS_PQ = 47 * MiB, WS_PK = 63 * MiB;
constexpr size_t WS_U = 80 * MiB;
constexpr size_t WS_O = 204 * MiB;
constexpr size_t WS_WADA = 204 * MiB;
constexpr size_t WS_PW = 237 * MiB, WS_PU = 253 * MiB, WS_PA = 269 * MiB, WS_EGL = 277 * MiB;
constexpr size_t WS_GP = 80 * MiB;
constexpr size_t WS_ACT = 171 * MiB;
constexpr size_t WS_LSUM = 277 * MiB + 65536;
constexpr size_t WS_ACUM = 278 * MiB, WS_HLOC = 286 * MiB;
constexpr size_t WS_XR = 262 * MiB;
constexpr size_t WS_END = 295 * MiB;
constexpr int CW_BAR = 4096;
constexpr int CW_GCNT = 8192;
constexpr int CW_LCNT = 12288;
constexpr int LDS_BYTES = 163840, LDSCTL_OFF = 162816, MISC_OFF = LDSCTL_OFF + 320;

typedef float f32x2 __attribute__((ext_vector_type(2)));
typedef unsigned u32x2 __attribute__((ext_vector_type(2)));
struct Ctx {
    LAS unsigned char* lds_;
    int wave, vcu, G;
    float* out_; unsigned char* ws_;
};
__device__ __forceinline__ LAS unsigned char* ldsq(const Ctx& C) { LAS unsigned char* p = C.lds_; asm volatile("" : "+s"(p)); return p; }
__device__ __forceinline__ int bxq() { int b = (int)blockIdx.x; asm volatile("" : "+s"(b)); return b; }
__device__ __forceinline__ unsigned char* wsq(const Ctx& C) { unsigned char* p = C.ws_; asm volatile("" : "+s"(p)); return p; }
__device__ __forceinline__ float* outq(const Ctx& C) { float* p = C.out_; asm volatile("" : "+s"(p)); return p; }
__device__ __forceinline__ const float* inptr(int i) {
    unsigned long long ka = (unsigned long long)__builtin_amdgcn_kernarg_segment_ptr();
    asm volatile("" : "+s"(ka));
    return *(const float* const __attribute__((address_space(4)))*)(ka + 8ull * (unsigned)i);
}
__device__ __forceinline__ float bf2f(unsigned short h) { return __builtin_bit_cast(float, (unsigned)h << 16); }
__device__ __forceinline__ float bflo(unsigned w) { return __builtin_bit_cast(float, w << 16); }
__device__ __forceinline__ float bfhi(unsigned w) { return __builtin_bit_cast(float, w & 0xffff0000u); }
__device__ __forceinline__ unsigned short f2bfs(float f) { return (unsigned short)(pk2(f, f) & 0xffffu); }
__device__ __forceinline__ float sigm(float x) { return __builtin_amdgcn_rcpf(1.f + __expf(-x)); }
__device__ __forceinline__ float siluf(float x) { return x * __builtin_amdgcn_rcpf(1.f + __expf(-x)); }
__device__ __forceinline__ float softplusf(float x) { return x > 20.f ? x : log1pf(__expf(x)); }
__device__ __forceinline__ float gelu_tanh(float x) { const float u = 0.7978845608028654f * (x + 0.044715f * x * x * x); return x * __builtin_amdgcn_rcpf(1.f + __expf(-2.f * u)); }
__device__ __forceinline__ float dpp_sum16(float v) {
    v += __builtin_bit_cast(float, __builtin_amdgcn_update_dpp(0, __builtin_bit_cast(int, v), 0xB1, 0xF, 0xF, true));
    v += __builtin_bit_cast(float, __builtin_amdgcn_update_dpp(0, __builtin_bit_cast(int, v), 0x4E, 0xF, 0xF, true));
    v += __builtin_bit_cast(float, __builtin_amdgcn_update_dpp(0, __builtin_bit_cast(int, v), 0x141, 0xF, 0xF, true));
    v += __builtin_bit_cast(float, __builtin_amdgcn_update_dpp(0, __builtin_bit_cast(int, v), 0x140, 0xF, 0xF, true));
    return v;
}
__device__ __forceinline__ int permpos(int d) { return 8 * ((d >> 2) & 3) + 4 * ((d >> 4) & 1) + (d & 3); }
__device__ __forceinline__ int seq_of_row(int row) { return row < MP ? (row >> 11) : NBP + ((row - MP) >> 2); }
__device__ __forceinline__ bf16x8 pack8(const f32x4 a, const f32x4 b) {
    v4u w; w.x = pk2(a.x, a.y); w.y = pk2(a.z, a.w); w.z = pk2(b.x, b.y); w.w = pk2(b.z, b.w); return __builtin_bit_cast(bf16x8, w);
}
__device__ __forceinline__ f32x4 mfma16(const bf16x8 a, const bf16x8 b, const f32x4 c) { return __builtin_amdgcn_mfma_f32_16x16x32_bf16(a, b, c, 0, 0, 0); }
__device__ __forceinline__ void glds16(const void* g, LAS unsigned char* l) { __builtin_amdgcn_global_load_lds((const unsigned*)g, (LAS unsigned*)l, 16, 0, 0); }
__device__ __forceinline__ float rstd_of(const float* rss, int row) {
    const f32x4* p = (const f32x4*)(rss + (size_t)row * 16); const f32x4 a = p[0], b = p[1], c = p[2], d = p[3];
    const float s = ((a.x + a.y) + (a.z + a.w)) + ((b.x + b.y) + (b.z + b.w)) + ((c.x + c.y) + (c.z + c.w)) + ((d.x + d.y) + (d.z + d.w));
    return rsqrtf(s * (1.f / DM) + EPS);
}

struct EpiModCvec {
    static constexpr bool PERM = false, AFTER_DRAIN = false;
    float* C; int ldc; const float* bias; int rowmax; int adaln; bf16* ash;
    __device__ __forceinline__ void operator()(const f32x4 (&acc)[2][2][4][2], const pg8::Unit& u, int wr, int wc, int fr, int fq) const {
        const int colb = u.pn * 256 + wc * 32 + 4 * fq;
#pragma unroll
        for (int ai = 0; ai < 2; ++ai)
#pragma unroll
            for (int m = 0; m < 4; ++m) {
                const int row = ai * 128 + wr * 64 + m * 16 + fr;
                if (row < rowmax) {
#pragma unroll
                    for (int bj = 0; bj < 2; ++bj)
#pragma unroll
                        for (int n = 0; n < 2; ++n) {
                            const int col = colb + bj * 128 + n * 16; f32x4 v = acc[ai][bj][m][n];
                            if (adaln) {
                                const int l = col / 6144, cl = col - l * 6144, chunk = cl >> 10;
                                v = v + *(const f32x4*)(bias + col);
                                *(f32x4*)(C + ((size_t)l * NSEQ + row) * 6144 + cl) = v;
                                if (chunk == 0 || chunk == 3) { u32x2 w; w.x = pk2(v.x, v.y); w.y = pk2(v.z, v.w); *(u32x2*)(ash + ((size_t)(2 * l + (chunk == 3)) * 256 + row) * DM + (cl & 1023)) = w; }
                            } else {
                                *(f32x4*)(C + (size_t)row * ldc + col) = v;
                            }
                        }
                }
            }
    }
};
constexpr int EPL_OFF = 131072;
#define EPLP ((LAS float*)(size_t)EPL_OFF)
template <int NV>
__device__ __forceinline__ void epi_stage(LAS float* epl, const float* rss, int pm, int pn, const float* v0, const float* v1, const float* v2, const float* v3, const float* v4) {
    const int tid = threadIdx.x;
    if (tid < 256) { if (rss) epl[tid] = rstd_of(rss, pm * 256 + tid); }
    else {
        const int cl = tid - 256, col = pn * 256 + cl;
        if (NV > 0 && v0) epl[256 + cl] = v0[col];
        if (NV > 1 && v1) epl[512 + cl] = v1[col];
        if (NV > 2 && v2) epl[768 + cl] = v2[col];
        if (NV > 3 && v3) epl[1024 + cl] = v3[col];
        if (NV > 4 && v4) epl[1280 + cl] = v4[col];
    }
    asm volatile("s_waitcnt vmcnt(0) lgkmcnt(0)" ::: "memory");
    __builtin_amdgcn_s_barrier();
    asm volatile("" ::: "memory");
}
struct EpiU {
    static constexpr bool PERM = true, AFTER_DRAIN = false;
    bf16* U; const float* rss; const float* cvec; int ldo; int ldcv;
    __device__ __forceinline__ void operator()(const f32x4 (&acc)[2][2][4][2], const pg8::Unit& u, int wr, int wc, int fr, int fq) const {
        const bool prm = u.pm < 64;
        epi_stage<1>(EPLP, rss, u.pm, u.pn, prm ? cvec + (size_t)(u.pm >> 3) * ldcv : nullptr, nullptr, nullptr, nullptr, nullptr);
        const int cl = wc * 32 + 8 * fq, colb = u.pn * 256 + cl;
#pragma unroll
        for (int ai = 0; ai < 2; ++ai)
#pragma unroll
            for (int m = 0; m < 4; ++m) {
                const int rl = ai * 128 + wr * 64 + m * 16 + fr, row = u.pm * 256 + rl;
                const float rs = EPLP[rl];
                bf16* op = U + (size_t)row * ldo + colb;
#pragma unroll
                for (int bj = 0; bj < 2; ++bj) {
                    f32x4 c0, c1;
                    if (prm) { c0 = *(const LAS f32x4*)(EPLP + 256 + cl + bj * 128); c1 = *(const LAS f32x4*)(EPLP + 256 + cl + bj * 128 + 4); }
                    else { const float* cv = cvec + (size_t)seq_of_row(row) * ldcv + colb + bj * 128; c0 = *(const f32x4*)cv; c1 = *(const f32x4*)(cv + 4); }
                    const f32x4 v0 = acc[ai][bj][m][0] * rs + c0, v1 = acc[ai][bj][m][1] * rs + c1;
                    v4u w; w.x = pk2(v0.x, v0.y); w.y = pk2(v0.z, v0.w); w.z = pk2(v1.x, v1.y); w.w = pk2(v1.z, v1.w);
                    *(v4u*)(op + bj * 128) = w;
                }
            }
    }
};
struct EpiGate {
    static constexpr bool PERM = true, AFTER_DRAIN = false;
    bf16* GP; const float* rss; const float* cvec; float* fcp; float* fcs;
    __device__ __forceinline__ void operator()(const f32x4 (&acc)[2][2][4][2], const pg8::Unit& u, int wr, int wc, int fr, int fq) const {
        const bool prm = u.pm < 64;
        epi_stage<1>(EPLP, rss, u.pm, u.pn, prm ? cvec + (size_t)(u.pm >> 3) * DFF : nullptr, nullptr, nullptr, nullptr, nullptr);
        const int cl = wc * 32 + 8 * fq, colb = u.pn * 256 + cl;
#pragma unroll
        for (int ai = 0; ai < 2; ++ai)
#pragma unroll
            for (int m = 0; m < 4; ++m) {
                const int rl = ai * 128 + wr * 64 + m * 16 + fr, row = u.pm * 256 + rl;
                const float rs = EPLP[rl]; const int s = seq_of_row(row);
                bf16* op = GP + (size_t)row * DFF + colb;
                float* st = nullptr;
                if (row < MP) { const int tt = row & (TSEQ - 1); if (tt >= TSEQ - 2) st = fcp + ((size_t)s * 2 + (tt - (TSEQ - 2))) * DFF + colb; }
                else { const int tt = row & 3; if (tt >= 2) st = fcs + ((size_t)(s - NBP) * 2 + (tt - 2)) * DFF + colb; }
#pragma unroll
                for (int bj = 0; bj < 2; ++bj) {
                    f32x4 c0, c1;
                    if (prm) { c0 = *(const LAS f32x4*)(EPLP + 256 + cl + bj * 128); c1 = *(const LAS f32x4*)(EPLP + 256 + cl + bj * 128 + 4); }
                    else { const float* cv = cvec + (size_t)s * DFF + colb + bj * 128; c0 = *(const f32x4*)cv; c1 = *(const f32x4*)(cv + 4); }
                    const f32x4 v0 = acc[ai][bj][m][0] * rs + c0, v1 = acc[ai][bj][m][1] * rs + c1;
                    v4u w; w.x = pk2(v0.x, v0.y); w.y = pk2(v0.z, v0.w); w.z = pk2(v1.x, v1.y); w.w = pk2(v1.z, v1.w);
                    *(v4u*)(op + bj * 128) = w;
                    if (st) { *(f32x4*)(st + bj * 128) = v0; *(f32x4*)(st + bj * 128 + 4) = v1; }
                }
            }
    }
};
struct EpiUp {
    static constexpr bool PERM = true, AFTER_DRAIN = false;
    bf16* ACT; const bf16* GP; const float* rss; const float* cvec; const float* cw; const float* cb; const float* sfc;
    template <int BY> static __device__ __forceinline__ unsigned nb(unsigned cur, unsigned prev, int fr) {
        const unsigned s = (unsigned)__builtin_amdgcn_update_dpp(0, (int)cur, BY == 1 ? 0x111 : 0x112, 0xF, 0xF, true);
        const unsigned p = (unsigned)__builtin_amdgcn_update_dpp(0, (int)prev, BY == 1 ? 0x121 : 0x122, 0xF, 0xF, true);
        return fr < BY ? p : s;
    }
    __device__ __forceinline__ void operator()(const f32x4 (&acc)[2][2][4][2], const pg8::Unit& u, int wr, int wc, int fr, int fq) const {
        const bool prm = u.pm < 64;
        epi_stage<5>(EPLP, rss, u.pm, u.pn, prm ? cvec + (size_t)(u.pm >> 3) * DFF : nullptr, cw, cw + DFF, cw + 2 * DFF, cb);
        const int cl = wc * 32 + 8 * fq, colb = u.pn * 256 + cl;
#pragma unroll
        for (int ai = 0; ai < 2; ++ai)
#pragma unroll
            for (int bj = 0; bj < 2; ++bj) {
                const int cc = colb + bj * 128, lc = cl + bj * 128;
                const int rbase = u.pm * 256 + ai * 128 + wr * 64;
                v4u rb[5];
#pragma unroll
                for (int k = 0; k < 5; ++k) { const int row = rbase + 16 * (k - 1) + fr; rb[k] = *(const v4u*)(GP + (size_t)(row < 0 ? 0 : row) * DFF + cc); }
#pragma unroll
                for (int m = 0; m < 4; ++m) {
                    const int rl = ai * 128 + wr * 64 + m * 16 + fr, row = u.pm * 256 + rl;
                    const float rs = EPLP[rl];
                    const int tt = row < MP ? (row & (TSEQ - 1)) : (row & 3);
                    const int s = seq_of_row(row);
                    const v4u cur = rb[m + 1], prv = rb[m];
                    unsigned wq[4];
#pragma unroll
                    for (int hf = 0; hf < 2; ++hf) {
                        const unsigned q0 = hf ? cur.z : cur.x, q1 = hf ? cur.w : cur.y, v0 = hf ? prv.z : prv.x, v1 = hf ? prv.w : prv.y;
                        const unsigned p0 = nb<1>(q0, v0, fr), p1 = nb<1>(q1, v1, fr), o0 = nb<2>(q0, v0, fr), o1 = nb<2>(q1, v1, fr);
                        const f32x4 g0 = (f32x4){bflo(q0), bfhi(q0), bflo(q1), bfhi(q1)};
                        f32x4 g1 = (f32x4){bflo(p0), bfhi(p0), bflo(p1), bfhi(p1)}, g2 = (f32x4){bflo(o0), bfhi(o0), bflo(o1), bfhi(o1)}, c0;
                        if (prm) {
                            const f32x4 z4 = (f32x4){0.f, 0.f, 0.f, 0.f};
                            if (tt < 1) g1 = z4;
                            if (tt < 2) g2 = z4;
                            c0 = *(const LAS f32x4*)(EPLP + 256 + lc + 4 * hf);
                        } else {
                            if (tt < 1) g1 = *(const f32x4*)(sfc + ((size_t)(s - NBP) * 2 + 1) * DFF + cc + 4 * hf);
                            if (tt < 2) g2 = *(const f32x4*)(sfc + ((size_t)(s - NBP) * 2 + tt) * DFF + cc + 4 * hf);
                            c0 = *(const f32x4*)(cvec + (size_t)s * DFF + cc + 4 * hf);
                        }
                        const f32x4 uu = acc[ai][bj][m][hf] * rs + c0;
                        const f32x4 ga = *(const LAS f32x4*)(EPLP + 512 + lc + 4 * hf) * g2 + *(const LAS f32x4*)(EPLP + 768 + lc + 4 * hf) * g1 + *(const LAS f32x4*)(EPLP + 1024 + lc + 4 * hf) * g0 + *(const LAS f32x4*)(EPLP + 1280 + lc + 4 * hf);
                        wq[2 * hf] = pk2(siluf(ga.x) * uu.x, siluf(ga.y) * uu.y); wq[2 * hf + 1] = pk2(siluf(ga.z) * uu.z, siluf(ga.w) * uu.w);
                    }
                    v4u w; w.x = wq[0]; w.y = wq[1]; w.z = wq[2]; w.w = wq[3];
                    *(v4u*)(ACT + (size_t)row * DFF + cc) = w;
                }
            }
    }
};
template <int XM>
struct EpiRes {
    static constexpr bool PERM = false, AFTER_DRAIN = false;
    const float* xinP; const bf16* XRin; bf16* XRout; const float* gvec; const float* scn; const float* gamma; bf16* XS; float* rss;
    __device__ __forceinline__ void operator()(const f32x4 (&acc)[2][2][4][2], const pg8::Unit& u, int wr, int wc, int fr, int fq) const {
        const int s0 = u.pm >> 3;
        epi_stage<3>(EPLP, nullptr, u.pm, u.pn, gvec + (size_t)s0 * 6144, scn ? scn + (size_t)s0 * 6144 : nullptr, scn ? gamma : nullptr, nullptr, nullptr);
        const int cl = wc * 32 + 4 * fq, colb = u.pn * 256 + cl;
#pragma unroll
        for (int ai = 0; ai < 2; ++ai)
#pragma unroll
            for (int mp = 0; mp < 2; ++mp) {
                f32x4 xr[2][2][2];
#pragma unroll
                for (int m2 = 0; m2 < 2; ++m2) {
                    const size_t ro = (size_t)(u.pm * 256 + ai * 128 + wr * 64 + (2 * mp + m2) * 16 + fr) * DM + colb;
#pragma unroll
                    for (int bj = 0; bj < 2; ++bj)
#pragma unroll
                        for (int n = 0; n < 2; ++n) {
                            if (XM == 0) xr[m2][bj][n] = *(const f32x4*)(xinP + ro + bj * 128 + n * 16);
                            else { const u32x2 r = *(const u32x2*)(XRin + ro + bj * 128 + n * 16); xr[m2][bj][n] = (f32x4){bflo(r.x), bfhi(r.x), bflo(r.y), bfhi(r.y)}; }
                        }
                }
#pragma unroll
                for (int m2 = 0; m2 < 2; ++m2) {
                    const int m = 2 * mp + m2, row = u.pm * 256 + ai * 128 + wr * 64 + m * 16 + fr;
                    float ss = 0.f;
#pragma unroll
                    for (int bj = 0; bj < 2; ++bj)
#pragma unroll
                        for (int n = 0; n < 2; ++n) {
                            const int lc = cl + bj * 128 + n * 16, col = u.pn * 256 + lc;
                            const f32x4 xn = xr[m2][bj][n] + *(const LAS f32x4*)(EPLP + 256 + lc) * acc[ai][bj][m][n];
                            { u32x2 w; w.x = pk2(xn.x, xn.y); w.y = pk2(xn.z, xn.w); *(u32x2*)(XRout + (size_t)row * DM + col) = w; }
                            ss += (xn.x * xn.x + xn.y * xn.y) + (xn.z * xn.z + xn.w * xn.w);
                            if (scn) { const f32x4 v = xn * *(const LAS f32x4*)(EPLP + 768 + lc) * (*(const LAS f32x4*)(EPLP + 512 + lc) + 1.f);
                                u32x2 w; w.x = pk2(v.x, v.y); w.y = pk2(v.z, v.w); *(u32x2*)(XS + (size_t)row * DM + col) = w; }
                        }
                    ss += __shfl_xor(ss, 16); ss += __shfl_xor(ss, 32);
                    if (fq == 0) rss[(size_t)row * 16 + u.pn * 4 + wc] = ss;
                }
            }
    }
};
struct OneUnit {
    int pn;
    __device__ __forceinline__ bool next(int i, pg8::Unit& u) const { if (i > 0 || pn < 0) return false; u.pm = 0; u.pn = pn; return true; }
    __device__ __forceinline__ void a_ready(const pg8::Unit&) const {}
    __device__ __forceinline__ void done(const pg8::Unit&) const {}
};

#ifndef DBL_LOADS
#define DBL_LOADS 0
#endif
#ifndef PROBE_REGION
#define PROBE_REGION 0
#endif
#ifndef PROBE_VCU
#define PROBE_VCU 0
#endif
#define RB(id) do { if (PROBE_REGION == (id) && C.vcu == PROBE_VCU && threadIdx.x == 0) ((volatile LAS unsigned long long*)(ldsq(C) + MISC_OFF + 64))[0] = __builtin_amdgcn_s_memrealtime(); } while (0)
#define RE(id) do { if (PROBE_REGION == (id) && C.vcu == PROBE_VCU && threadIdx.x == 0) { volatile LAS unsigned long long* q_ = (volatile LAS unsigned long long*)(ldsq(C) + MISC_OFF + 64); q_[1] = q_[1] + (__builtin_amdgcn_s_memrealtime() - q_[0]); } } while (0)
__device__ __forceinline__ void st16_wt(unsigned char* ws, size_t off, const v4u v) {
    const __amdgpu_buffer_rsrc_t r = __builtin_amdgcn_make_buffer_rsrc(ws, (short)0, (int)WS_END, 0x00020000);
    __builtin_amdgcn_raw_buffer_store_b128(v, r, (unsigned)off, 0, 16);
}
__device__ __forceinline__ void st8_wt(void* p, const u32x2 v) { __hip_atomic_store((unsigned long long*)p, (unsigned long long)v.x | ((unsigned long long)v.y << 32), __ATOMIC_RELAXED, __HIP_MEMORY_SCOPE_AGENT); }
__device__ __forceinline__ void st4_wt(float* p, float v) { __hip_atomic_store((unsigned*)p, __builtin_bit_cast(unsigned, v), __ATOMIC_RELAXED, __HIP_MEMORY_SCOPE_AGENT); }
__device__ __forceinline__ void publish_add(unsigned* cnt) {
    if (!cnt) { __syncthreads(); return; }
    asm volatile("s_waitcnt vmcnt(0)" ::: "memory");
    __syncthreads();
    if (threadIdx.x == 0) (void)__hip_atomic_fetch_add(cnt, 1u, __ATOMIC_RELAXED, __HIP_MEMORY_SCOPE_AGENT);
}
__device__ __forceinline__ void poll_acquire(unsigned* cnt, unsigned need) {
    unsigned sp = 0;
    while (__hip_atomic_load(cnt, __ATOMIC_RELAXED, __HIP_MEMORY_SCOPE_AGENT) < need) { __builtin_amdgcn_s_sleep(2); if (++sp > (1u << 22)) break; }
    __builtin_amdgcn_fence(__ATOMIC_ACQUIRE, "agent");
    asm volatile("s_waitcnt vmcnt(0)" ::: "memory");
}
__device__ __forceinline__ float wave_sum(float v) {
#pragma unroll
    for (int o = 1; o < 64; o <<= 1) v += __shfl_xor(v, o);
    return v;
}
template <int MODE>
__device__ __forceinline__ void tr_item(const float* W, int N, int K, bf16* WT, int nblk, LAS float* scr, int item, int lane) {
    const int kb = item / nblk, nb = item - kb * nblk, k0 = 64 * kb, n0 = 64 * nb;
    const int c4 = (lane & 15) * 4, r0 = lane >> 4;
    int sc = n0 + c4;
    if (MODE == 1) { const int np = sc; sc = np < 3072 ? np : (np < 3584 ? np + 8 : (np < 3592 ? np - 512 : -1)); }
#pragma unroll 4
    for (int i = 0; i < 16; ++i) {
        const int kk = 4 * i + r0;
        const f32x4 v = sc >= 0 ? *(const f32x4*)(W + (size_t)(k0 + kk) * N + sc) : (f32x4){0.f, 0.f, 0.f, 0.f};
        LAS float* d = scr + kk * 65 + c4; d[0] = v.x; d[1] = v.y; d[2] = v.z; d[3] = v.w;
    }
    LDS_WAIT(); asm volatile("" ::: "memory");
    const int c = lane & 7;
#pragma unroll
    for (int j = 0; j < 8; ++j) { const int n = (lane >> 3) + 8 * j; const LAS float* s = scr + (8 * c) * 65 + n;
        v4u o; o.x = pk2(s[0 * 65], s[1 * 65]); o.y = pk2(s[2 * 65], s[3 * 65]); o.z = pk2(s[4 * 65], s[5 * 65]); o.w = pk2(s[6 * 65], s[7 * 65]);
        *(GAS v4u*)(WT + (size_t)(n0 + n) * K + k0 + 8 * c) = o; }
    LDS_WAIT(); asm volatile("" ::: "memory");
}
__device__ __forceinline__ void tr_job(Ctx& C, const float* W, bf16* WT, int N, int K, int mode, int ndest, int gw, int ngw, int& base) {
    int tid_ = threadIdx.x; asm volatile("" : "+v"(tid_)); const int lane = tid_ & 63; (void)lane;
    LAS float* scr = (LAS float*)(ldsq(C) + C.wave * 16640);
    const int nblk = ndest / 64, nit = nblk * (K / 64);
    int it = gw - (base % ngw); if (it < 0) it += ngw;
    for (; it < nit; it += ngw) { if (mode == 1) tr_item<1>(W, N, K, WT, nblk, scr, it, lane); else tr_item<0>(W, N, K, WT, nblk, scr, it, lane); }
    base += nit;
}
__device__ __forceinline__ void phase_p0(Ctx& C) {
    const int gw = C.vcu * NWAVES + C.wave, ngw = C.G * NWAVES;
    bf16* wada = (bf16*)(wsq(C) + WS_WADA);
    int base = 0;
    tr_job(C, inptr(I_WADA), wada, 6144, DM, 0, 6144, gw, ngw, base);
    tr_job(C, inptr(I_WADA) + (size_t)DM * 6144, wada + (size_t)6144 * DM, 6144, DM, 0, 6144, gw, ngw, base);
    bf16* ac = (bf16*)(wsq(C) + WS_AC);
    int tid_ = threadIdx.x; asm volatile("" : "+v"(tid_)); const int lane = tid_ & 63; (void)lane;
    for (int r = gw; r < NSEQ; r += ngw) {
        const float* src = r < NBP ? inptr(I_CP) + (size_t)r * DM : inptr(I_CS) + (size_t)(r - NBP) * DM;
#pragma unroll
        for (int j = 0; j < 4; ++j) { const f32x4 v = *(const f32x4*)(src + 256 * j + 4 * lane);
            u32x2 w; w.x = pk2(siluf(v.x), siluf(v.y)); w.y = pk2(siluf(v.z), siluf(v.w)); *(u32x2*)(ac + (size_t)r * DM + 256 * j + 4 * lane) = w; }
    }
}
__device__ __forceinline__ void x_to_xs(Ctx& C, int gw, int ngw) {
    const float* mod = (const float*)(wsq(C) + WS_MOD); bf16* xs = (bf16*)(wsq(C) + WS_XS); float* rss = (float*)(wsq(C) + WS_RSS);
    const float* gam = inptr(I_NMIX); const float* xp_ = inptr(I_XP); const float* xs_ = inptr(I_XS);
    int tid_ = threadIdx.x; asm volatile("" : "+v"(tid_)); const int lane = tid_ & 63; (void)lane;
    for (int row = gw; row < MROWS; row += ngw) {
        const float* src = row < MP ? xp_ + (size_t)row * DM : xs_ + (size_t)(row - MP) * DM;
        const int s = seq_of_row(row); const float* sc = mod + (size_t)s * 6144 + 1024;
        float ss = 0.f;
#pragma unroll
        for (int j = 0; j < 4; ++j) { const int col = 256 * j + 4 * lane; const f32x4 v = *(const f32x4*)(src + col);
            ss += (v.x * v.x + v.y * v.y) + (v.z * v.z + v.w * v.w);
            const f32x4 o = v * *(const f32x4*)(gam + col) * (*(const f32x4*)(sc + col) + 1.f);
            u32x2 w; w.x = pk2(o.x, o.y); w.y = pk2(o.z, o.w); *(u32x2*)(xs + (size_t)row * DM + col) = w; }
        ss = wave_sum(ss);
        if (lane < 16) rss[(size_t)row * 16 + lane] = lane == 0 ? ss : 0.f;
    }
}
__device__ __forceinline__ void phase_final(Ctx& C) {
    const int gw = C.vcu * NWAVES + C.wave, ngw = C.G * NWAVES;
    const float* rss = (const float*)(wsq(C) + WS_RSS); const float* gam = inptr(I_FNORM);
    int tid_ = threadIdx.x; asm volatile("" : "+v"(tid_)); const int lane = tid_ & 63; (void)lane;
    for (int row = gw; row < MROWS; row += ngw) {
        const float rs = rstd_of(rss, row); float* p = outq(C) + (size_t)row * DM; const bf16* xr = (const bf16*)(wsq(C) + WS_XR) + (size_t)row * DM;
#pragma unroll
        for (int j = 0; j < 4; ++j) { const int col = 256 * j + 4 * lane; const u32x2 r = *(const u32x2*)(xr + col);
            *(f32x4*)(p + col) = (f32x4){bflo(r.x), bfhi(r.x), bflo(r.y), bfhi(r.y)} * rs * *(const f32x4*)(gam + col); }
    }
}

__device__ __forceinline__ void gdn_prep_item(Ctx& C, int l, int b, int h, int n, unsigned* cnt) {
    int tid_ = threadIdx.x; asm volatile("" : "+v"(tid_)); const int tid = tid_, lane = tid & 63, wave = __builtin_amdgcn_readfirstlane(tid >> 6);
    LAS float* F32 = (LAS float*)(ldsq(C));
    LAS unsigned short* KH = (LAS unsigned short*)(ldsq(C) + 99328);
    LAS unsigned short* QH = (LAS unsigned short*)(ldsq(C) + 116736);
    LAS float* AM = (LAS float*)(ldsq(C) + 134144);
    LAS float* SC = (LAS float*)(ldsq(C) + 151552);
    const bf16* U = (const bf16*)(wsq(C) + WS_U);
    const int row0 = b * TSEQ + n * 64;
    const int idx = (b * 4 + h) * 32 + n;
#ifndef REP_STEPA
#define REP_STEPA 1
#endif
    for (int rpa_ = 0; rpa_ < REP_STEPA; ++rpa_)
    if (tid < 384) {
        const int cg = tid % 48, rs = tid / 48, which = cg >> 4, cc = (cg & 15) * 8;
        const int ucol = C_Q + which * 512 + h * 128 + cc, wcol = which * 512 + h * 128 + cc;
        const float* cw = inptr(I_GCW) + (size_t)l * 4 * 1536 + wcol;
        float w[4][8];
#pragma unroll
        for (int k = 0; k < 4; ++k) { const f32x4 a = *(const f32x4*)(cw + k * 1536), bq = *(const f32x4*)(cw + k * 1536 + 4);
            w[k][0] = a.x; w[k][1] = a.y; w[k][2] = a.z; w[k][3] = a.w; w[k][4] = bq.x; w[k][5] = bq.y; w[k][6] = bq.z; w[k][7] = bq.w; }
        const int t0 = 8 * rs;
        v4u rr[11];
#pragma unroll
        for (int k = 0; k < 11; ++k) { const int tg = n * 64 + t0 - 3 + k; rr[k] = *(const v4u*)(U + (size_t)(b * TSEQ + (tg < 0 ? 0 : tg)) * LDU + ucol); if (tg < 0) rr[k] = (v4u){0u, 0u, 0u, 0u}; }
        if (n == 31 && rs == 7) {
#pragma unroll
            for (int k = 0; k < 3; ++k) { float* gp = outq(C) + O_GCP + ((size_t)(l * NBP + b) * 3 + k) * 1536 + wcol; const v4u r = rr[8 + k];
                *(f32x4*)gp = (f32x4){bflo(r.x), bfhi(r.x), bflo(r.y), bfhi(r.y)}; *(f32x4*)(gp + 4) = (f32x4){bflo(r.z), bfhi(r.z), bflo(r.w), bfhi(r.w)}; }
        }
#pragma unroll
        for (int j = 0; j < 8; ++j) {
            LAS float* dst = F32 + (t0 + j) * 388 + cg * 8;
            float y[8];
#pragma unroll
            for (int i = 0; i < 8; ++i) y[i] = 0.f;
#pragma unroll
            for (int k = 0; k < 4; ++k) { const v4u r = rr[j + k];
                y[0] += w[k][0] * bflo(r.x); y[1] += w[k][1] * bfhi(r.x); y[2] += w[k][2] * bflo(r.y); y[3] += w[k][3] * bfhi(r.y);
                y[4] += w[k][4] * bflo(r.z); y[5] += w[k][5] * bfhi(r.z); y[6] += w[k][6] * bflo(r.w); y[7] += w[k][7] * bfhi(r.w); }
#pragma unroll
            for (int i = 0; i < 8; ++i) dst[i] = siluf(y[i]);
        }
    }
    __syncthreads();
    {
        const int p = tid >> 2, sub = tid & 3, t = p & 63, which = p >> 6;
        const LAS f32x4* src = (const LAS f32x4*)(F32 + t * 388 + which * 128 + sub * 32);
        float s = 0.f;
#pragma unroll
        for (int i = 0; i < 8; ++i) { const f32x4 v = src[i]; s += (v.x * v.x + v.y * v.y) + (v.z * v.z + v.w * v.w); }
        s += __builtin_bit_cast(float, __builtin_amdgcn_update_dpp(0, __builtin_bit_cast(int, s), 0xB1, 0xF, 0xF, true));
        s += __builtin_bit_cast(float, __builtin_amdgcn_update_dpp(0, __builtin_bit_cast(int, s), 0x4E, 0xF, 0xF, true));
        if (sub == 0) SC[which * 64 + t] = rsqrtf(s + EPS) * (which == 0 ? 0.08838834764831845f : 1.f);
    }
    if (wave == 0) {
        const int t = lane; const bf16* ur = U + (size_t)(row0 + t) * LDU;
        const float ga = bf2f(ur[C_GA + h]), gb = bf2f(ur[C_GB + h]);
        const float g = -__expf(inptr(I_GALOG)[l * 4 + h]) * softplusf(ga + inptr(I_GDTB)[l * 4 + h]);
        float cs = g;
#pragma unroll
        for (int o = 1; o < 64; o <<= 1) { const float v = __shfl_up(cs, o); if (lane >= o) cs += v; }
        SC[128 + t] = sigm(gb); SC[192 + t] = cs; SC[256 + t] = __expf(cs);
    }
    __syncthreads();
    {
        const int t = tid >> 3, cs = (tid & 7) * 16; const float rq = SC[t], rk = SC[64 + t];
        LAS f32x4* qrow = (LAS f32x4*)(F32 + t * 388 + cs); LAS f32x4* krow = (LAS f32x4*)(F32 + t * 388 + 128 + cs);
        f32x4 q4[4], k4[4];
#pragma unroll
        for (int i = 0; i < 4; ++i) { q4[i] = qrow[i] * rq; k4[i] = krow[i] * rk; qrow[i] = q4[i]; krow[i] = k4[i]; }
        *(LAS bf16x8*)(QH + t * 136 + cs) = pack8(q4[0], q4[1]); *(LAS bf16x8*)(QH + t * 136 + cs + 8) = pack8(q4[2], q4[3]);
        *(LAS bf16x8*)(KH + t * 136 + cs) = pack8(k4[0], k4[1]); *(LAS bf16x8*)(KH + t * 136 + cs + 8) = pack8(k4[2], k4[3]);
    }
    __syncthreads();
    {
        const int g = lane >> 4, c = lane & 15;
        LAS unsigned short* ATL = (LAS unsigned short*)(ldsq(C) + 152832);
        for (int job = wave; job < 26; job += 8) {
            int which, mt, nt;
            if (job < 16) { which = 1; mt = job >> 2; nt = job & 3; }
            else { const int k = job - 16; which = 0; mt = (k >= 6) ? 3 : (k >= 3) ? 2 : (k >= 1) ? 1 : 0; nt = k - (mt * (mt + 1)) / 2; }
            f32x4 acc = (f32x4){0.f, 0.f, 0.f, 0.f};
            if (mt >= nt) {
                const LAS unsigned short* ap = (which ? QH : KH) + (16 * mt + c) * 136 + 8 * g;
                const LAS unsigned short* bp = KH + (16 * nt + c) * 136 + 8 * g;
#pragma unroll
                for (int s = 0; s < 4; ++s) acc = mfma16(*(const LAS bf16x8*)(ap + 32 * s), *(const LAS bf16x8*)(bp + 32 * s), acc);
            }
            const int sidx = 16 * nt + c; const float gcs = SC[192 + sidx];
#pragma unroll
            for (int r = 0; r < 4; ++r) {
                const int t = 16 * mt + 4 * g + r; const float dec = __expf(SC[192 + t] - gcs);
                if (which == 0) AM[t * 68 + (sidx & 1) * 32 + (sidx >> 1)] = (sidx < t) ? SC[128 + t] * acc[r] * dec : 0.f;
                else ATL[t * 72 + (sidx & 32) + permpos(sidx & 31)] = f2bfs((sidx <= t) ? acc[r] * dec : 0.f);
            }
        }
    }
    __syncthreads();
#ifndef REP_SOLVE
#define REP_SOLVE 1
#endif
    for (int rps_ = 0; rps_ < REP_SOLVE; ++rps_)
    {
        const int c = tid >> 1, half = tid & 1; const bool isv = c < 128; const int fcol = isv ? 256 + c : c;
        float mine[32];
#pragma unroll
        for (int i = 0; i < 32; ++i) mine[i] = 0.f;
        f32x4 ar[2][8]; float rh[2], rb[2], re[2];
        ar[0][0] = *(const LAS f32x4*)(AM + half * 32); rh[0] = F32[fcol]; rb[0] = SC[128]; re[0] = SC[256];
#pragma unroll
        for (int i = 0; i < 64; ++i) {
            const int cur = i & 1, nxt = cur ^ 1;
            if (i + 1 < 64) {
                const int njn = (i + 2) >> 1;
#pragma unroll
                for (int q = 0; q * 4 < njn; ++q) ar[nxt][q] = *(const LAS f32x4*)(AM + (i + 1) * 68 + half * 32 + 4 * q);
                rh[nxt] = F32[(i + 1) * 388 + fcol]; rb[nxt] = SC[128 + i + 1]; re[nxt] = SC[256 + i + 1];
            }
            float rhs = rh[cur] * rb[cur]; if (!isv) rhs *= re[cur];
            float p0 = 0.f, p1 = 0.f, p2 = 0.f, p3 = 0.f;
            const int nj = (i + 1) >> 1;
#pragma unroll
            for (int q = 0; q * 4 < nj; ++q) {
                const f32x4 a = ar[cur][q];
                p0 += a.x * mine[4 * q]; if (4 * q + 1 < nj) p1 += a.y * mine[4 * q + 1]; if (4 * q + 2 < nj) p2 += a.z * mine[4 * q + 2]; if (4 * q + 3 < nj) p3 += a.w * mine[4 * q + 3];
            }
            const float part = (p0 + p1) + (p2 + p3);
            const float tot = part + __builtin_bit_cast(float, __builtin_amdgcn_update_dpp(0, __builtin_bit_cast(int, part), 0xB1, 0xF, 0xF, true));
            const float sol = rhs - tot;
            mine[i >> 1] = ((i & 1) == half) ? sol : mine[i >> 1];
        }
        const int d = c - 128; const int dpos = (d & ~31) + permpos(d & 31);
#pragma unroll
        for (int jj = 0; jj < 32; ++jj) { const int t = 2 * jj + half; if (isv) QH[t * 136 + c] = f2bfs(mine[jj]); else KH[t * 136 + dpos] = f2bfs(-mine[jj]); }
    }
    {
        const int t = tid >> 3, ds = (tid & 7) * 16; const float e = SC[256 + t];
        bf16* QT = (bf16*)(wsq(C) + WS_PQ) + (size_t)idx * 8192 + t * 128;
#pragma unroll
        for (int gq = 0; gq < 4; ++gq) { const f32x4 v = *(const LAS f32x4*)(F32 + t * 388 + ds + 4 * gq) * e;
            u32x2 w; w.x = pk2(v.x, v.y); w.y = pk2(v.z, v.w); st8_wt(QT + (ds & ~31) + 8 * gq + 4 * ((ds >> 4) & 1), w); }
    }
    {
        const int d = tid & 127, tq = tid >> 7; const float gl = SC[192 + 63];
        float kv[4][4];
#pragma unroll
        for (int gq = 0; gq < 4; ++gq)
#pragma unroll
            for (int i = 0; i < 4; ++i) { const int t = 16 * tq + 4 * gq + i; kv[gq][i] = F32[t * 388 + 128 + d] * __expf(gl - SC[192 + t]); }
        if (tid == 0) st4_wt((float*)(wsq(C) + WS_EGL) + idx, __expf(gl));
        __syncthreads();
        LAS unsigned short* KTL = (LAS unsigned short*)(ldsq(C) + 134144) + d * 64;
#pragma unroll
        for (int gq = 0; gq < 4; ++gq) { u32x2 w; w.x = pk2(kv[gq][0], kv[gq][1]); w.y = pk2(kv[gq][2], kv[gq][3]); *(LAS u32x2*)(KTL + ((16 * tq) & ~31) + 8 * gq + 4 * (tq & 1)) = w; }
    }
    __syncthreads();
    {
        unsigned char* wsb = wsq(C);
        const size_t pu = WS_PU + (size_t)idx * 16384, pw = WS_PW + (size_t)idx * 16384, pk = WS_PK + (size_t)idx * 16384, pa = WS_PA + (size_t)idx * 8192;
        LAS unsigned char* L = ldsq(C);
#pragma unroll
        for (int k = 0; k < 2; ++k) { const int e = tid + 512 * k, r = e >> 4, q = e & 15;
            st16_wt(wsb, pu + e * 16, *(const LAS v4u*)(L + 116736 + r * 272 + q * 16));
            st16_wt(wsb, pw + e * 16, *(const LAS v4u*)(L + 99328 + r * 272 + q * 16));
            st16_wt(wsb, pk + e * 16, *(const LAS v4u*)(L + 134144 + e * 16)); }
        { const int r = tid >> 3, q = tid & 7; st16_wt(wsb, pa + tid * 16, *(const LAS v4u*)(L + 152832 + r * 144 + q * 16)); }
    }
    publish_add(cnt);
}

constexpr int GC_NW = 0, GC_QT = 16384, GC_KT = 32768, GC_AT = 49152, GC_UT = 57344, GC_BUF = 73728, GC_PART = 147456;
__device__ __forceinline__ void gdn_chain_issue(LAS unsigned char* lds, const unsigned char* ws, int idx, int buf, int tid, int wave) {
    LAS unsigned char* base = lds + buf * GC_BUF;
    const unsigned char* nw = ws + WS_PW + (size_t)idx * 16384; const unsigned char* qt = ws + WS_PQ + (size_t)idx * 16384;
    const unsigned char* kt = ws + WS_PK + (size_t)idx * 16384; const unsigned char* at = ws + WS_PA + (size_t)idx * 8192; const unsigned char* ut = ws + WS_PU + (size_t)idx * 16384;
#pragma unroll
    for (int i = 0; i < 2; ++i) {
        const int L = tid + 512 * i; const int wb = (i * 512 + wave * 64) * 16;
        { const int r = L >> 4, ps = L & 15, q = ps ^ (r & 15); glds16(nw + r * 256 + q * 16, base + GC_NW + wb); glds16(qt + r * 256 + q * 16, base + GC_QT + wb); }
        glds16(ut + L * 16, base + GC_UT + wb);
        { const int r = L >> 3, ps = L & 7, q = ps ^ ((r >> 1) & 7); glds16(kt + r * 128 + q * 16, base + GC_KT + wb); }
    }
    { const int L = tid; const int r = L >> 3, ps = L & 7, q = ps ^ ((r >> 1) & 7); glds16(at + r * 128 + q * 16, base + GC_AT + wave * 1024); }
}
template <int PART>
__device__ __forceinline__ void gdn_chain_issue_part(LAS unsigned char* lds, const unsigned char* ws, int idx, int buf, int tid, int wave) {
    LAS unsigned char* base = lds + buf * GC_BUF;
#pragma unroll
    for (int i = 0; i < 2; ++i) {
        const int L = tid + 512 * i; const int wb = (i * 512 + wave * 64) * 16;
        if (PART == 0) { const int r = L >> 4, ps = L & 15, q = ps ^ (r & 15); glds16(ws + WS_PW + (size_t)idx * 16384 + r * 256 + q * 16, base + GC_NW + wb); }
        if (PART == 1) { const int r = L >> 4, ps = L & 15, q = ps ^ (r & 15); glds16(ws + WS_PQ + (size_t)idx * 16384 + r * 256 + q * 16, base + GC_QT + wb); }
        if (PART == 2) glds16(ws + WS_PU + (size_t)idx * 16384 + L * 16, base + GC_UT + wb);
        if (PART == 3) { const int r = L >> 3, ps = L & 7, q = ps ^ ((r >> 1) & 7); glds16(ws + WS_PK + (size_t)idx * 16384 + r * 128 + q * 16, base + GC_KT + wb); }
    }
    if (PART == 2) { const int L = tid; const int r = L >> 3, ps = L & 7, q = ps ^ ((r >> 1) & 7); glds16(ws + WS_PA + (size_t)idx * 8192 + r * 128 + q * 16, base + GC_AT + wave * 1024); }
}
__device__ __forceinline__ void gdn_chain(Ctx& C, int l, int b, int h) {
    int tid_ = threadIdx.x; asm volatile("" : "+v"(tid_)); const int tid = tid_, lane = tid & 63, w = __builtin_amdgcn_readfirstlane(tid >> 6), g = lane >> 4, c = lane & 15, e0 = 16 * w;
    LAS unsigned char* lds = ldsq(C);
    const bf16* U = (const bf16*)(wsq(C) + WS_U); bf16* O = (bf16*)(wsq(C) + WS_O);
    const float* egl_p = (const float*)(wsq(C) + WS_EGL);
    const int idx0 = (b * 4 + h) * 32;
    const float gnorm = inptr(I_GNORM)[l * 128 + e0 + c];
    f32x4 S[8];
#pragma unroll
    for (int i = 0; i < 8; ++i) S[i] = (f32x4){0.f, 0.f, 0.f, 0.f};
    const bf16* gzp = U + (size_t)(b * TSEQ + lane) * LDU + C_GZ + h * 128 + e0;
    bf16* orow = O + (size_t)(b * TSEQ + lane) * DM + 256 + h * 128 + e0;
    v4u gz0 = (v4u){0u, 0u, 0u, 0u}, gz1 = gz0;
    f32x4 op[4];
#pragma unroll
    for (int i = 0; i < 4; ++i) op[i] = (f32x4){0.f, 0.f, 0.f, 0.f};
    const int xa = c * 256 + (((c & 12) + (g ^ (c & 3))) << 4);
    const int m3 = (c >> 1) & 7;
    const int xk = c * 128 + (((m3 & 4) + (g ^ (m3 & 3))) << 4);
    unsigned* gcnt = (unsigned*)((gu32*)(wsq(C) + WS_CTL) + CW_GCNT + l * 32 * 64);
    if (tid == 0) { poll_acquire(gcnt, 32u); poll_acquire(gcnt + 64, 32u); }
    __syncthreads();
    gdn_chain_issue(lds, wsq(C), idx0, 0, tid, w);
    float egl = egl_p[idx0];
    asm volatile("s_waitcnt vmcnt(0)" ::: "memory");
    __syncthreads();
    for (int n = 0; n <= 32; ++n) {
        asm volatile("; GDNCHAIN_STEP_BEGIN");
        const int buf = n & 1;
        LAS unsigned char* B = lds + buf * GC_BUF;
        LAS unsigned short* SL = (LAS unsigned short*)(B + GC_UT) + e0;
        bf16x8 fa[16];
        f32x4 vn[4], o[4];
        v4u gn0 = gz0, gn1 = gz1; float egln = 0.f;
        RB(5);
        if (n < 32) {
#pragma unroll
            for (int mt = 0; mt < 4; ++mt) {
                const LAS unsigned short* up = SL + (16 * mt + 4 * g) * 128 + c;
                vn[mt] = (f32x4){bf2f(up[0]), bf2f(up[128]), bf2f(up[256]), bf2f(up[384])}; o[mt] = (f32x4){0.f, 0.f, 0.f, 0.f};
            }
            { const bf16* gp = gzp + (size_t)n * 64 * LDU; gn0 = *(const v4u*)gp; gn1 = *(const v4u*)(gp + 8); }
            if (n + 1 < 32) egln = egl_p[idx0 + n + 1];
            if (n + 1 < 32) gdn_chain_issue_part<0>(lds, wsq(C), idx0 + n + 1, buf ^ 1, tid, w);
            if (n + 1 < 32) gdn_chain_issue_part<1>(lds, wsq(C), idx0 + n + 1, buf ^ 1, tid, w);
        }
        if (n > 0) {
            asm volatile("s_waitcnt lgkmcnt(0)" ::: "memory");
            const LAS float* PART = (const LAS float*)(lds + GC_PART + (buf ^ 1) * 2048);
            *(LAS v4u*)(SL + lane * 128) = gz0; *(LAS v4u*)(SL + lane * 128 + 8) = gz1;
            unsigned short gzv[4][4];
#pragma unroll
            for (int mt = 0; mt < 4; ++mt)
#pragma unroll
                for (int r = 0; r < 4; ++r) gzv[mt][r] = SL[(16 * mt + 4 * g + r) * 128 + c];
#pragma unroll
            for (int mt = 0; mt < 4; ++mt) {
                f32x4 pr[4][2];
#pragma unroll
                for (int r = 0; r < 4; ++r) { const int t = 16 * mt + 4 * g + r; pr[r][0] = *(const LAS f32x4*)(PART + t * 8); pr[r][1] = *(const LAS f32x4*)(PART + t * 8 + 4); }
                __builtin_amdgcn_sched_barrier(0);
#pragma unroll
                for (int r = 0; r < 4; ++r) {
                    const f32x4 p0 = pr[r][0], p1 = pr[r][1];
                    const float tot = ((p0.x + p0.y) + (p0.z + p0.w)) + ((p1.x + p1.y) + (p1.z + p1.w));
                    const float rs = __builtin_amdgcn_rsqf(tot * (1.f / 128.f) + EPS);
                    SL[(16 * mt + 4 * g + r) * 128 + c] = f2bfs(op[mt][r] * rs * gnorm * siluf(bf2f(gzv[mt][r])));
                }
            }
            const v4u ov0 = *(const LAS v4u*)(SL + lane * 128), ov1 = *(const LAS v4u*)(SL + lane * 128 + 8);
            bf16* od = orow + (size_t)(n - 1) * 64 * DM; *(v4u*)od = ov0; *(v4u*)(od + 8) = ov1;
        }
        RE(5);
        if (n < 32) {
            RB(6);
            __builtin_amdgcn_sched_barrier(0);
#pragma unroll
            for (int mt = 0; mt < 4; ++mt)
#pragma unroll
                for (int s = 0; s < 4; ++s) fa[mt * 4 + s] = *(const LAS bf16x8*)(B + GC_NW + mt * 4096 + (xa ^ (s << 6)));
            bf16x8 Sb[4];
#pragma unroll
            for (int s = 0; s < 4; ++s) Sb[s] = pack8(S[2 * s], S[2 * s + 1]);
            __builtin_amdgcn_sched_barrier(0);
#pragma unroll
            for (int s = 0; s < 4; ++s)
#pragma unroll
                for (int mt = 0; mt < 4; ++mt) vn[mt] = mfma16(fa[mt * 4 + s], Sb[s], vn[mt]);
            if (n + 1 < 32) gdn_chain_issue_part<2>(lds, wsq(C), idx0 + n + 1, buf ^ 1, tid, w);
            __builtin_amdgcn_sched_barrier(0);
            RE(6); RB(7);
#pragma unroll
            for (int mt = 0; mt < 4; ++mt)
#pragma unroll
                for (int s = 0; s < 4; ++s) fa[mt * 4 + s] = *(const LAS bf16x8*)(B + GC_QT + mt * 4096 + (xa ^ (s << 6)));
            __builtin_amdgcn_sched_barrier(0);
#pragma unroll
            for (int s = 0; s < 4; ++s)
#pragma unroll
                for (int mt = 0; mt < 4; ++mt) o[mt] = mfma16(fa[mt * 4 + s], Sb[s], o[mt]);
            if (n + 1 < 32) gdn_chain_issue_part<3>(lds, wsq(C), idx0 + n + 1, buf ^ 1, tid, w);
            bf16x8 vb[2];
            vb[0] = pack8(vn[0], vn[1]); vb[1] = pack8(vn[2], vn[3]);
            __builtin_amdgcn_sched_barrier(0);
            RE(7); RB(8);
#pragma unroll
            for (int mt = 0; mt < 4; ++mt)
#pragma unroll
                for (int s = 0; s < 2; ++s) { fa[mt * 2 + s] = *(const LAS bf16x8*)(B + GC_AT + mt * 2048 + (xk ^ (s << 6))); fa[8 + mt * 2 + s] = *(const LAS bf16x8*)(B + GC_KT + mt * 2048 + (xk ^ (s << 6))); }
#pragma unroll
            for (int i = 0; i < 8; ++i) S[i] = S[i] * egl;
            __builtin_amdgcn_sched_barrier(0);
#pragma unroll
            for (int s = 0; s < 2; ++s)
#pragma unroll
                for (int mt = 0; mt < 4; ++mt) { o[mt] = mfma16(fa[mt * 2 + s], vb[s], o[mt]); S[mt] = mfma16(fa[8 + mt * 2 + s], vb[s], S[mt]); }
            __builtin_amdgcn_sched_barrier(0);
            RE(8); RB(9);
#pragma unroll
            for (int md = 0; md < 4; ++md)
#pragma unroll
                for (int s = 0; s < 2; ++s) fa[md * 2 + s] = *(const LAS bf16x8*)(B + GC_KT + (4 + md) * 2048 + (xk ^ (s << 6)));
            __builtin_amdgcn_sched_barrier(0);
#pragma unroll
            for (int s = 0; s < 2; ++s)
#pragma unroll
                for (int md = 0; md < 4; ++md) S[4 + md] = mfma16(fa[md * 2 + s], vb[s], S[4 + md]);
            LAS float* PARTW = (LAS float*)(lds + GC_PART + buf * 2048);
#pragma unroll
            for (int mt = 0; mt < 4; ++mt)
#pragma unroll
                for (int r = 0; r < 4; ++r) {
                    const float ss = dpp_sum16(o[mt][r] * o[mt][r]);
                    if (c == 4 * mt + r) PARTW[(16 * mt + 4 * g + r) * 8 + w] = ss;
                }
#pragma unroll
            for (int mt = 0; mt < 4; ++mt) op[mt] = o[mt];
            gz0 = gn0; gz1 = gn1; egl = egln;
            RE(9); RB(10);
            asm volatile("; GDNCHAIN_STEP_END");
            if (tid == 0 && n + 2 < 32) poll_acquire(gcnt + 64 * (n + 2), 32u);
            asm volatile("s_waitcnt vmcnt(0)" ::: "memory");
            __syncthreads();
            RE(10);
        }
    }
    float* sp = outq(C) + O_GDNP + (size_t)((l * NBP + b) * 4 + h) * 128 * 128;
#pragma unroll
    for (int i = 0; i < 8; ++i)
#pragma unroll
        for (int r = 0; r < 4; ++r) sp[(size_t)(16 * i + 4 * g + r) * 128 + e0 + c] = S[i][r];
    __syncthreads();
}

constexpr int HC_QM = 0, HC_KM = 9216, HC_QE = 18432, HC_VT = 27648, HC_KLT = 36864, HC_BUF = 46080, HC_SEG = 92160, HC_GLS = 94208, HC_PART = 94720;
__device__ __forceinline__ void hgrn_chain(Ctx& C, int l, int b, int h) {
    int tid_ = threadIdx.x; asm volatile("" : "+v"(tid_)); const int tid = tid_, lane = tid & 63, w = __builtin_amdgcn_readfirstlane(tid >> 6), g = lane >> 4, c = lane & 15, d = lane, ts = w;
    LAS unsigned char* lds = ldsq(C);
    const bf16* U = (const bf16*)(wsq(C) + WS_U); bf16* O = (bf16*)(wsq(C) + WS_O);
    float lb = 0.f;
    if (l == 1) { const float b0 = inptr(I_HGLB)[h * 64 + d], b1 = inptr(I_HGLB)[256 + h * 64 + d]; lb = __builtin_amdgcn_rcpf(1.f + __expf(b0 - b1)); }
    const float oml = 1.f - lb;
    const int nt = w >> 1, ep = w & 1;
    f32x4 S[4][2];
#pragma unroll
    for (int i = 0; i < 4; ++i) { S[i][0] = (f32x4){0.f, 0.f, 0.f, 0.f}; S[i][1] = (f32x4){0.f, 0.f, 0.f, 0.f}; }
    float hgn[2][4];
#pragma unroll
    for (int mi = 0; mi < 2; ++mi)
#pragma unroll
        for (int r = 0; r < 4; ++r) hgn[mi][r] = inptr(I_HGN)[l * 64 + 16 * (2 * ep + mi) + 4 * g + r];
    LAS float* SEG = (LAS float*)(lds + HC_SEG);
    unsigned short rq[8], rf[8], ri[8];
    {
        const bf16* up = U + (size_t)(b * TSEQ + 8 * ts) * LDU + h * 64 + d;
#pragma unroll
        for (int j = 0; j < 8; ++j) { rq[j] = up[(size_t)j * LDU + C_HQ]; rf[j] = up[(size_t)j * LDU + C_HF]; ri[j] = up[(size_t)j * LDU + C_HI]; }
    }
    for (int n = 0; n < 32; ++n) {
        const int buf = n & 1; const int row0 = b * TSEQ + n * 64;
        float q[8], kk[8], cs[8], v[8];
        float run = 0.f;
#pragma unroll
        for (int j = 0; j < 8; ++j) {
            const float z = bf2f(rf[j]); const float ez = __expf(-z); const float sg = __builtin_amdgcn_rcpf(1.f + ez);
            const float f = lb + oml * sg; run += __logf(f); cs[j] = run;
            kk[j] = oml * (1.f - sg);
            q[j] = siluf(bf2f(rq[j])); v[j] = bf2f(ri[j]);
        }
        SEG[ts * 64 + d] = run;
        u32x2 hz[2];
#pragma unroll
        for (int mi = 0; mi < 2; ++mi) hz[mi] = *(const u32x2*)(U + (size_t)(row0 + 16 * nt + c) * LDU + C_HZ + h * 64 + 16 * (2 * ep + mi) + 4 * g);
        if (n + 1 < 32) {
            const bf16* up = U + (size_t)(row0 + 64 + 8 * ts) * LDU + h * 64 + d;
#pragma unroll
            for (int j = 0; j < 8; ++j) { rq[j] = up[(size_t)j * LDU + C_HQ]; rf[j] = up[(size_t)j * LDU + C_HF]; ri[j] = up[(size_t)j * LDU + C_HI]; }
        }
        __syncthreads();
        float base = 0.f, gmid = 0.f, gl = 0.f;
#pragma unroll
        for (int k = 0; k < 8; ++k) { const float sv = SEG[k * 64 + d]; if (k < ts) base += sv; if (k < 4) gmid += sv; gl += sv; }
        LAS unsigned short* T = (LAS unsigned short*)(lds + buf * HC_BUF);
        {
            const int dpos = (d & ~31) + permpos(d & 31);
            float klv[8];
#pragma unroll
            for (int j = 0; j < 8; ++j) {
                const int t = 8 * ts + j; const float G = base + cs[j];
                const float e1 = fminf(fmaxf(G - gmid, -80.f), 80.f);
                T[HC_QM / 2 + t * 72 + d] = f2bfs(q[j] * __expf(e1));
                T[HC_KM / 2 + t * 72 + d] = f2bfs(kk[j] * __expf(-e1));
                T[HC_QE / 2 + t * 72 + dpos] = f2bfs(q[j] * __expf(G));
                klv[j] = kk[j] * __expf(gl - G);
            }
            const int p0 = 32 * (ts >> 2) + 16 * (ts & 1) + 4 * ((ts >> 1) & 1);
            u32x2 wv0, wv1, wk0, wk1;
            wv0.x = pk2(v[0], v[1]); wv0.y = pk2(v[2], v[3]); wv1.x = pk2(v[4], v[5]); wv1.y = pk2(v[6], v[7]);
            wk0.x = pk2(klv[0], klv[1]); wk0.y = pk2(klv[2], klv[3]); wk1.x = pk2(klv[4], klv[5]); wk1.y = pk2(klv[6], klv[7]);
            *(LAS u32x2*)(T + HC_VT / 2 + d * 72 + p0) = wv0; *(LAS u32x2*)(T + HC_VT / 2 + d * 72 + p0 + 8) = wv1;
            *(LAS u32x2*)(T + HC_KLT / 2 + d * 72 + p0) = wk0; *(LAS u32x2*)(T + HC_KLT / 2 + d * 72 + p0 + 8) = wk1;
            if (ts == 0) ((LAS float*)(lds + HC_GLS))[buf * 64 + d] = gl;
        }
        __syncthreads();
        f32x4 at[4];
#pragma unroll
        for (int ms = 0; ms < 4; ++ms) {
            at[ms] = (f32x4){0.f, 0.f, 0.f, 0.f};
            if (ms <= nt) {
#pragma unroll
                for (int s = 0; s < 2; ++s)
                    at[ms] = mfma16(*(const LAS bf16x8*)(T + HC_KM / 2 + (16 * ms + c) * 72 + 32 * s + 8 * g), *(const LAS bf16x8*)(T + HC_QM / 2 + (16 * nt + c) * 72 + 32 * s + 8 * g), at[ms]);
                if (ms == nt) {
#pragma unroll
                    for (int r = 0; r < 4; ++r) at[ms][r] = (4 * g + r <= c) ? at[ms][r] : 0.f;
                }
            }
        }
        bf16x8 atb[2]; atb[0] = pack8(at[0], at[1]); atb[1] = pack8(at[2], at[3]);
        f32x4 oT[2];
#pragma unroll
        for (int mi = 0; mi < 2; ++mi) {
            const int me = 2 * ep + mi; f32x4 acc = (f32x4){0.f, 0.f, 0.f, 0.f};
#pragma unroll
            for (int s = 0; s < 2; ++s)
                acc = mfma16(pack8(S[2 * s][mi], S[2 * s + 1][mi]), *(const LAS bf16x8*)(T + HC_QE / 2 + (16 * nt + c) * 72 + 32 * s + 8 * g), acc);
#pragma unroll
            for (int s = 0; s < 2; ++s)
                acc = mfma16(*(const LAS bf16x8*)(T + HC_VT / 2 + (16 * me + c) * 72 + 32 * s + 8 * g), atb[s], acc);
            oT[mi] = acc;
        }
        {
            const LAS float* GLS = (const LAS float*)(lds + HC_GLS) + buf * 64;
#pragma unroll
            for (int md = 0; md < 4; ++md) {
                const f32x4 lg = *(const LAS f32x4*)(GLS + 16 * md + 4 * g);
                const f32x4 lam = (f32x4){__expf(lg.x), __expf(lg.y), __expf(lg.z), __expf(lg.w)};
#pragma unroll
                for (int mi = 0; mi < 2; ++mi) {
                    const int me = 2 * ep + mi; f32x4 acc = S[md][mi] * lam;
#pragma unroll
                    for (int s = 0; s < 2; ++s)
                        acc = mfma16(*(const LAS bf16x8*)(T + HC_KLT / 2 + (16 * md + c) * 72 + 32 * s + 8 * g), *(const LAS bf16x8*)(T + HC_VT / 2 + (16 * me + c) * 72 + 32 * s + 8 * g), acc);
                    S[md][mi] = acc;
                }
            }
        }
        LAS float* PART = (LAS float*)(lds + HC_PART) + buf * 128;
        float ss = 0.f;
#pragma unroll
        for (int mi = 0; mi < 2; ++mi)
#pragma unroll
            for (int r = 0; r < 4; ++r) ss += oT[mi][r] * oT[mi][r];
        ss += __shfl_xor(ss, 16); ss += __shfl_xor(ss, 32);
        if (g == 0) PART[(16 * nt + c) * 2 + ep] = ss;
        __syncthreads();
        const float tot = PART[(16 * nt + c) * 2] + PART[(16 * nt + c) * 2 + 1];
        const float rs = rsqrtf(tot * (1.f / 64.f) + EPS);
#pragma unroll
        for (int mi = 0; mi < 2; ++mi) {
            const float z0 = bflo(hz[mi].x), z1 = bfhi(hz[mi].x), z2 = bflo(hz[mi].y), z3 = bfhi(hz[mi].y);
            u32x2 wv; wv.x = pk2(oT[mi][0] * rs * hgn[mi][0] * siluf(z0), oT[mi][1] * rs * hgn[mi][1] * siluf(z1));
            wv.y = pk2(oT[mi][2] * rs * hgn[mi][2] * siluf(z2), oT[mi][3] * rs * hgn[mi][3] * siluf(z3));
            *(u32x2*)(O + (size_t)(row0 + 16 * nt + c) * DM + h * 64 + 16 * (2 * ep + mi) + 4 * g) = wv;
        }
    }
    if (nt == 0) {
        float* sp = outq(C) + O_HGP + (size_t)((l * NBP + b) * 4 + h) * 64 * 64;
#pragma unroll
        for (int md = 0; md < 4; ++md)
#pragma unroll
            for (int mi = 0; mi < 2; ++mi)
#pragma unroll
                for (int r = 0; r < 4; ++r) sp[(size_t)(16 * md + 4 * g + r) * 64 + 16 * (2 * ep + mi) + c] = S[md][mi][r];
    }
    __syncthreads();
}

constexpr int L1_WT = 0, L1_XCB = 73728, L1_STA = 0, L1_STH = 32768;
__device__ __forceinline__ void lru_pass1_item(Ctx& C, int l, int b, int n, unsigned* cnt) {
    int tid_ = threadIdx.x; asm volatile("" : "+v"(tid_)); const int tid = tid_, lane = tid & 63, w = __builtin_amdgcn_readfirstlane(tid >> 6), g = lane >> 4, c = lane & 15;
    LAS unsigned char* lds = ldsq(C);
    const bf16* U = (const bf16*)(wsq(C) + WS_U); bf16* O = (bf16*)(wsq(C) + WS_O);
    LAS unsigned short* WT = (LAS unsigned short*)(lds + L1_WT);
    LAS unsigned short* XCB = (LAS unsigned short*)(lds + L1_XCB);
    const int row0 = b * TSEQ + n * 64;
    {
        const float* wa = inptr(I_LWA) + (size_t)l * 16384; const float* wx = inptr(I_LWX) + (size_t)l * 16384;
        for (int idx = tid; idx < 8192; idx += NTHR) {
            const int gate = idx >> 12, rem = idx & 4095, blk = rem >> 10, i = (rem >> 4) & 63, j4 = (rem & 15) * 4;
            const f32x4 v = *(const f32x4*)((gate ? wx : wa) + ((size_t)blk * 64 + i) * 64 + j4);
            LAS unsigned short* dst = WT + ((gate * 4 + blk) * 64 + j4) * 72 + i;
            dst[0] = f2bfs(v.x); dst[72] = f2bfs(v.y); dst[144] = f2bfs(v.z); dst[216] = f2bfs(v.w);
        }
    }
    {
        const int cg = tid & 31, rs = tid >> 5, ch0 = cg * 8, t0 = rs * 4;
        float cw[4][8], cb[8];
        const float* cwp = inptr(I_LCW) + (size_t)l * 4 * 256 + ch0; const float* cbp = inptr(I_LCB) + (size_t)l * 256 + ch0;
#pragma unroll
        for (int k = 0; k < 4; ++k) { const f32x4 a = *(const f32x4*)(cwp + k * 256), bq = *(const f32x4*)(cwp + k * 256 + 4);
            cw[k][0] = a.x; cw[k][1] = a.y; cw[k][2] = a.z; cw[k][3] = a.w; cw[k][4] = bq.x; cw[k][5] = bq.y; cw[k][6] = bq.z; cw[k][7] = bq.w; }
        { const f32x4 a = *(const f32x4*)cbp, bq = *(const f32x4*)(cbp + 4); cb[0] = a.x; cb[1] = a.y; cb[2] = a.z; cb[3] = a.w; cb[4] = bq.x; cb[5] = bq.y; cb[6] = bq.z; cb[7] = bq.w; }
        float x[7][8];
#pragma unroll
        for (int k = 0; k < 7; ++k) {
            const int tg = n * 64 + t0 - 3 + k;
            if (tg >= 0) { const v4u r = *(const v4u*)(U + (size_t)(b * TSEQ + tg) * LDU + C_LX + ch0);
                x[k][0] = bflo(r.x); x[k][1] = bfhi(r.x); x[k][2] = bflo(r.y); x[k][3] = bfhi(r.y); x[k][4] = bflo(r.z); x[k][5] = bfhi(r.z); x[k][6] = bflo(r.w); x[k][7] = bfhi(r.w);
                if (n == 31 && tg >= TSEQ - 3) { float* cp = outq(C) + O_LCP + ((size_t)(l * NBP + b) * 3 + (tg - (TSEQ - 3))) * 256 + ch0;
                    *(f32x4*)cp = (f32x4){x[k][0], x[k][1], x[k][2], x[k][3]}; *(f32x4*)(cp + 4) = (f32x4){x[k][4], x[k][5], x[k][6], x[k][7]}; }
            } else {
#pragma unroll
                for (int i = 0; i < 8; ++i) x[k][i] = 0.f; }
        }
#pragma unroll
        for (int j = 0; j < 4; ++j) {
            float y[8];
#pragma unroll
            for (int i = 0; i < 8; ++i) y[i] = cw[0][i] * x[j][i] + cw[1][i] * x[j + 1][i] + cw[2][i] * x[j + 2][i] + cw[3][i] * x[j + 3][i] + cb[i];
            v4u wv; wv.x = pk2(y[0], y[1]); wv.y = pk2(y[2], y[3]); wv.z = pk2(y[4], y[5]); wv.w = pk2(y[6], y[7]);
            *(LAS v4u*)(XCB + (t0 + j) * 264 + ch0) = wv;
            const v4u r = *(const v4u*)(U + (size_t)(row0 + t0 + j) * LDU + C_LZ + ch0);
            v4u gv; gv.x = pk2(gelu_tanh(bflo(r.x)), gelu_tanh(bfhi(r.x))); gv.y = pk2(gelu_tanh(bflo(r.y)), gelu_tanh(bfhi(r.y)));
            gv.z = pk2(gelu_tanh(bflo(r.z)), gelu_tanh(bfhi(r.z))); gv.w = pk2(gelu_tanh(bflo(r.w)), gelu_tanh(bfhi(r.w)));
            st16_wt(wsq(C), WS_O + ((size_t)(row0 + t0 + j) * DM + 768 + ch0) * 2, gv);
        }
    }
    __syncthreads();
    const int nb = w >> 1, njb = 2 * (w & 1);
    f32x4 pa[4][2], px[4][2];
    {
        bf16x8 fa[8], fb[8];
#pragma unroll
        for (int mt = 0; mt < 4; ++mt)
#pragma unroll
            for (int s = 0; s < 2; ++s) fa[mt * 2 + s] = *(const LAS bf16x8*)(XCB + (16 * mt + c) * 264 + 64 * nb + 32 * s + 8 * g);
#pragma unroll
        for (int gate = 0; gate < 2; ++gate)
#pragma unroll
            for (int q = 0; q < 2; ++q)
#pragma unroll
                for (int s = 0; s < 2; ++s) fb[(gate * 2 + q) * 2 + s] = *(const LAS bf16x8*)(WT + ((gate * 4 + nb) * 64 + 16 * (njb + q) + c) * 72 + 32 * s + 8 * g);
        __builtin_amdgcn_sched_barrier(0);
#pragma unroll
        for (int mt = 0; mt < 4; ++mt)
#pragma unroll
            for (int q = 0; q < 2; ++q) {
                f32x4 a = (f32x4){0.f, 0.f, 0.f, 0.f}, x = a;
#pragma unroll
                for (int s = 0; s < 2; ++s) { a = mfma16(fa[mt * 2 + s], fb[q * 2 + s], a); x = mfma16(fa[mt * 2 + s], fb[(2 + q) * 2 + s], x); }
                pa[mt][q] = a; px[mt][q] = x;
            }
    }
    unsigned short oa[2][4][4], oh[2][4][4];
    const float* bap = inptr(I_LBA) + l * 256; const float* bxp = inptr(I_LBX) + l * 256; const float* lamp = inptr(I_LLAM) + l * 256;
#pragma unroll
    for (int q = 0; q < 2; ++q) {
        const int ch = 64 * nb + 16 * (njb + q) + c;
        const float ba = bap[ch], bx = bxp[ch], sp = softplusf(-lamp[ch]);
        float pc = 1.f, hc = 0.f;
#pragma unroll
        for (int mt = 0; mt < 4; ++mt) {
            float a[4], bb[4];
#pragma unroll
            for (int r = 0; r < 4; ++r) {
                const float xcv = bf2f(XCB[(16 * mt + 4 * g + r) * 264 + ch]);
                const float rr = sigm(pa[mt][q][r] + ba), ii = sigm(px[mt][q][r] + bx);
                const float la = -8.f * rr * sp, x2 = 2.f * la;
                a[r] = __expf(la);
                const float om = -x2 * (1.f + x2 * (0.5f + x2 * (0.16666667f + x2 * (0.041666668f + x2 * 0.0083333338f))));
                bb[r] = sqrtf(fmaxf(om, 0.f)) * ii * xcv;
            }
            const float P = a[0] * a[1] * a[2] * a[3];
            const float H = ((bb[0] * a[1] + bb[1]) * a[2] + bb[2]) * a[3] + bb[3];
            float ps = pc, hs = hc, pstart = pc, hstart = hc;
#pragma unroll
            for (int k = 0; k < 4; ++k) {
                const float Pk = __shfl(P, c + 16 * k), Hk = __shfl(H, c + 16 * k);
                hs = Pk * hs + Hk; ps = Pk * ps;
                if (g == k + 1) { hstart = hs; pstart = ps; }
            }
            pc = ps; hc = hs;
            float pp = pstart, hh = hstart;
#pragma unroll
            for (int r = 0; r < 4; ++r) { pp = pp * a[r]; hh = a[r] * hh + bb[r]; oa[q][mt][r] = f2bfs(pp); oh[q][mt][r] = f2bfs(hh); }
        }
        if (g == 0) { float* sp_ = (float*)(wsq(C) + WS_LSUM) + ((size_t)(b * 32 + n) * 2) * 256 + ch; st4_wt(sp_, pc); st4_wt(sp_ + 256, hc); }
    }
    __syncthreads();
    {
        LAS unsigned short* STA = (LAS unsigned short*)(lds + L1_STA); LAS unsigned short* STH = (LAS unsigned short*)(lds + L1_STH);
#pragma unroll
        for (int q = 0; q < 2; ++q)
#pragma unroll
            for (int mt = 0; mt < 4; ++mt)
#pragma unroll
                for (int r = 0; r < 4; ++r) { const int off = (16 * mt + 4 * g + r) * 256 + 64 * nb + 16 * (njb + q) + c; STA[off] = oa[q][mt][r]; STH[off] = oh[q][mt][r]; }
    }
    __syncthreads();
    {
        unsigned char* wsb = wsq(C);
#pragma unroll
        for (int k = 0; k < 4; ++k) { const int e = (tid + 512 * k) * 8;
            st16_wt(wsb, WS_ACUM + ((size_t)row0 * 256 + e) * 2, *(const LAS v4u*)(lds + L1_STA + e * 2)); st16_wt(wsb, WS_HLOC + ((size_t)row0 * 256 + e) * 2, *(const LAS v4u*)(lds + L1_STH + e * 2)); }
    }
    publish_add(cnt);
}
__device__ __forceinline__ void lru_pass3_item(Ctx& C, int l, int b, int n) {
    int tid_ = threadIdx.x; asm volatile("" : "+v"(tid_)); const int tid = tid_;
    const int cg = tid & 31, rs = tid >> 5, ch0 = cg * 8, row0 = b * TSEQ + n * 64;
    const float* sum = (const float*)(wsq(C) + WS_LSUM) + (size_t)(b * 32) * 2 * 256 + ch0;
    float hin[8];
#pragma unroll
    for (int i = 0; i < 8; ++i) hin[i] = 0.f;
    for (int k = 0; k < n; ++k) {
        const f32x4 p0 = *(const f32x4*)(sum + (size_t)k * 512), p1 = *(const f32x4*)(sum + (size_t)k * 512 + 4), h0 = *(const f32x4*)(sum + (size_t)k * 512 + 256), h1 = *(const f32x4*)(sum + (size_t)k * 512 + 260);
        hin[0] = p0.x * hin[0] + h0.x; hin[1] = p0.y * hin[1] + h0.y; hin[2] = p0.z * hin[2] + h0.z; hin[3] = p0.w * hin[3] + h0.w;
        hin[4] = p1.x * hin[4] + h1.x; hin[5] = p1.y * hin[5] + h1.y; hin[6] = p1.z * hin[6] + h1.z; hin[7] = p1.w * hin[7] + h1.w;
    }
    const bf16* ga = (const bf16*)(wsq(C) + WS_ACUM); const bf16* gh = (const bf16*)(wsq(C) + WS_HLOC); bf16* O = (bf16*)(wsq(C) + WS_O);
#pragma unroll
    for (int j = 0; j < 4; ++j) {
        const int row = row0 + rs * 4 + j;
        const v4u a = *(const v4u*)(ga + (size_t)row * 256 + ch0), h = *(const v4u*)(gh + (size_t)row * 256 + ch0), gl = *(const v4u*)(O + (size_t)row * DM + 768 + ch0);
        v4u o;
        o.x = pk2((bflo(h.x) + bflo(a.x) * hin[0]) * bflo(gl.x), (bfhi(h.x) + bfhi(a.x) * hin[1]) * bfhi(gl.x));
        o.y = pk2((bflo(h.y) + bflo(a.y) * hin[2]) * bflo(gl.y), (bfhi(h.y) + bfhi(a.y) * hin[3]) * bfhi(gl.y));
        o.z = pk2((bflo(h.z) + bflo(a.z) * hin[4]) * bflo(gl.z), (bfhi(h.z) + bfhi(a.z) * hin[5]) * bfhi(gl.z));
        o.w = pk2((bflo(h.w) + bflo(a.w) * hin[6]) * bflo(gl.w), (bfhi(h.w) + bfhi(a.w) * hin[7]) * bfhi(gl.w));
        *(v4u*)(O + (size_t)row * DM + 768 + ch0) = o;
    }
    if (n == 31 && rs == 0) {
        const f32x4 p0 = *(const f32x4*)(sum + (size_t)31 * 512), p1 = *(const f32x4*)(sum + (size_t)31 * 512 + 4), h0 = *(const f32x4*)(sum + (size_t)31 * 512 + 256), h1 = *(const f32x4*)(sum + (size_t)31 * 512 + 260);
        float* lp = outq(C) + O_LRUP + (size_t)(l * NBP + b) * 256 + ch0;
        *(f32x4*)lp = (f32x4){p0.x * hin[0] + h0.x, p0.y * hin[1] + h0.y, p0.z * hin[2] + h0.z, p0.w * hin[3] + h0.w};
        *(f32x4*)(lp + 4) = (f32x4){p1.x * hin[4] + h1.x, p1.y * hin[5] + h1.y, p1.z * hin[6] + h1.z, p1.w * hin[7] + h1.w};
    }
}

__device__ __forceinline__ void gdn_dec_item(Ctx& C, int l, int seq, int h) {
    int tid_ = threadIdx.x; asm volatile("" : "+v"(tid_)); const int tid = tid_, lane = tid & 63, w = __builtin_amdgcn_readfirstlane(tid >> 6);
    LAS float* XQ = (LAS float*)(ldsq(C));
    LAS float* SCd = (LAS float*)(ldsq(C) + 6144);
    LAS float* RED = (LAS float*)(ldsq(C) + 6400);
    LAS float* SS = (LAS float*)(ldsq(C) + 6400 + 16384);
    const bf16* U = (const bf16*)(wsq(C) + WS_U); bf16* O = (bf16*)(wsq(C) + WS_O);
    const int row0 = MP + seq * 4;
    const int e = tid & 127, dq = tid >> 7;
    const size_t sbase = ((size_t)((l * NSQ + seq) * 4 + h) * 128 + dq * 32) * 128 + e;
    float S[32];
    { const float* sp_ = inptr(I_SGDN) + sbase;
#pragma unroll
      for (int i = 0; i < 32; ++i) S[i] = sp_[(size_t)i * 128]; }
    if (tid < 384) {
        const int which = tid >> 7, cc = tid & 127, ucol = C_Q + which * 512 + h * 128 + cc, wcol = which * 512 + h * 128 + cc;
        float xs[7], cw[4];
#pragma unroll
        for (int k = 0; k < 3; ++k) xs[k] = inptr(I_SGC)[((size_t)(l * NSQ + seq) * 3 + k) * 1536 + wcol];
#pragma unroll
        for (int t = 0; t < 4; ++t) xs[3 + t] = bf2f(U[(size_t)(row0 + t) * LDU + ucol]);
#pragma unroll
        for (int k = 0; k < 4; ++k) cw[k] = inptr(I_GCW)[(size_t)(l * 4 + k) * 1536 + wcol];
#pragma unroll
        for (int t = 0; t < 4; ++t) XQ[t * 384 + tid] = siluf(cw[0] * xs[t] + cw[1] * xs[t + 1] + cw[2] * xs[t + 2] + cw[3] * xs[t + 3]);
#pragma unroll
        for (int k = 0; k < 3; ++k) outq(C)[O_GCS + ((size_t)(l * NSQ + seq) * 3 + k) * 1536 + wcol] = xs[4 + k];
    }
    __syncthreads();
    {
        const int t = w & 3, which = w >> 2;
        const float a = XQ[t * 384 + which * 128 + lane], bq = XQ[t * 384 + which * 128 + 64 + lane];
        const float s = wave_sum(a * a + bq * bq);
        if (lane == 0) SCd[which * 4 + t] = rsqrtf(s + EPS) * (which == 0 ? 0.08838834764831845f : 1.f);
        if (tid < 4) {
            const bf16* ur = U + (size_t)(row0 + tid) * LDU;
            const float g = -__expf(inptr(I_GALOG)[l * 4 + h]) * softplusf(bf2f(ur[C_GA + h]) + inptr(I_GDTB)[l * 4 + h]);
            SCd[8 + tid] = __expf(g); SCd[12 + tid] = sigm(bf2f(ur[C_GB + h]));
        }
    }
    __syncthreads();
#pragma unroll
    for (int t = 0; t < 4; ++t) {
        const float a = SCd[8 + t], beta = SCd[12 + t], rk = SCd[4 + t], rq = SCd[t];
        const LAS float* kp = XQ + t * 384 + 128 + dq * 32; const LAS float* qp = XQ + t * 384 + dq * 32;
        float part = 0.f;
#pragma unroll
        for (int i = 0; i < 32; ++i) { S[i] *= a; part += kp[i] * S[i]; }
        RED[((t * 2 + 0) * 4 + dq) * 128 + e] = part * rk;
        __syncthreads();
        const float kS = (RED[((t * 2) * 4 + 0) * 128 + e] + RED[((t * 2) * 4 + 1) * 128 + e]) + (RED[((t * 2) * 4 + 2) * 128 + e] + RED[((t * 2) * 4 + 3) * 128 + e]);
        const float dv = beta * (XQ[t * 384 + 256 + e] - kS) * rk;
        float part2 = 0.f;
#pragma unroll
        for (int i = 0; i < 32; ++i) { S[i] += kp[i] * dv; part2 += qp[i] * S[i]; }
        RED[((t * 2 + 1) * 4 + dq) * 128 + e] = part2 * rq;
    }
    __syncthreads();
    {
        const int t = tid >> 7;
        const float o = (RED[((t * 2 + 1) * 4 + 0) * 128 + e] + RED[((t * 2 + 1) * 4 + 1) * 128 + e]) + (RED[((t * 2 + 1) * 4 + 2) * 128 + e] + RED[((t * 2 + 1) * 4 + 3) * 128 + e]);
        const float ss = wave_sum(o * o);
        if (lane == 0) SS[w] = ss;
        __syncthreads();
        const float rs = rsqrtf((SS[2 * t] + SS[2 * t + 1]) * (1.f / 128.f) + EPS);
        const float gz = bf2f(U[(size_t)(row0 + t) * LDU + C_GZ + h * 128 + e]);
        O[(size_t)(row0 + t) * DM + 256 + h * 128 + e] = f2bfs(o * rs * inptr(I_GNORM)[l * 128 + e] * siluf(gz));
    }
    { float* op_ = outq(C) + O_GDNS + sbase;
#pragma unroll
      for (int i = 0; i < 32; ++i) op_[(size_t)i * 128] = S[i]; }
    __syncthreads();
}
__device__ __forceinline__ void hl_dec_item(Ctx& C, int l, int seq) {
    int tid_ = threadIdx.x; asm volatile("" : "+v"(tid_)); const int tid = tid_, lane = tid & 63, wv_ = 0; (void)wv_;
    LAS float* QK = (LAS float*)(ldsq(C));
    LAS float* REDh = (LAS float*)(ldsq(C) + 16384);
    LAS float* XCs = (LAS float*)(ldsq(C) + 24576);
    const bf16* U = (const bf16*)(wsq(C) + WS_U); bf16* O = (bf16*)(wsq(C) + WS_O);
    const int row0 = MP + seq * 4;
    if (tid < 256) {
        const int ch = tid; float lb = 0.f;
        if (l == 1) { const float b0 = inptr(I_HGLB)[ch], b1 = inptr(I_HGLB)[256 + ch]; lb = __builtin_amdgcn_rcpf(1.f + __expf(b0 - b1)); }
        const float oml = 1.f - lb;
#pragma unroll
        for (int t = 0; t < 4; ++t) {
            const bf16* ur = U + (size_t)(row0 + t) * LDU;
            const float z = bf2f(ur[C_HF + ch]); const float sg = sigm(z);
            QK[t * 256 + ch] = siluf(bf2f(ur[C_HQ + ch])); QK[1024 + t * 256 + ch] = oml * (1.f - sg); QK[2048 + t * 256 + ch] = lb + oml * sg; QK[3072 + t * 256 + ch] = bf2f(ur[C_HI + ch]);
        }
    } else {
        const int ch = tid - 256; float xs[7], cw[4];
#pragma unroll
        for (int k = 0; k < 3; ++k) xs[k] = inptr(I_SLC)[((size_t)(l * NSQ + seq) * 3 + k) * 256 + ch];
#pragma unroll
        for (int t = 0; t < 4; ++t) xs[3 + t] = bf2f(U[(size_t)(row0 + t) * LDU + C_LX + ch]);
#pragma unroll
        for (int k = 0; k < 4; ++k) cw[k] = inptr(I_LCW)[(l * 4 + k) * 256 + ch];
        const float cb = inptr(I_LCB)[l * 256 + ch];
#pragma unroll
        for (int t = 0; t < 4; ++t) XCs[t * 256 + ch] = cw[0] * xs[t] + cw[1] * xs[t + 1] + cw[2] * xs[t + 2] + cw[3] * xs[t + 3] + cb;
#pragma unroll
        for (int k = 0; k < 3; ++k) outq(C)[O_LCS + ((size_t)(l * NSQ + seq) * 3 + k) * 256 + ch] = xs[4 + k];
    }
    __syncthreads();
    {
        const int hh = tid >> 7, dh = (tid >> 6) & 1, e = tid & 63;
        const size_t sbase = ((size_t)((l * NSQ + seq) * 4 + hh) * 64 + dh * 32) * 64 + e;
        float S[32];
#pragma unroll
        for (int i = 0; i < 32; ++i) S[i] = inptr(I_SHG)[sbase + (size_t)i * 64];
#pragma unroll
        for (int t = 0; t < 4; ++t) {
            const float v = QK[3072 + t * 256 + hh * 64 + e]; const int dd = hh * 64 + dh * 32;
            float part = 0.f;
#pragma unroll
            for (int i = 0; i < 32; ++i) { S[i] = QK[2048 + t * 256 + dd + i] * S[i] + QK[1024 + t * 256 + dd + i] * v; part += QK[t * 256 + dd + i] * S[i]; }
            REDh[((t * 4 + hh) * 2 + dh) * 64 + e] = part;
        }
#pragma unroll
        for (int i = 0; i < 32; ++i) outq(C)[O_HGS + sbase + (size_t)i * 64] = S[i];
    }
    __syncthreads();
#pragma unroll
    for (int rep = 0; rep < 2; ++rep) {
        const int id = tid + 512 * rep, t = id >> 8, hh = (id >> 6) & 3, e = id & 63;
        const float o = REDh[((t * 4 + hh) * 2) * 64 + e] + REDh[((t * 4 + hh) * 2 + 1) * 64 + e];
        const float rs = rsqrtf(wave_sum(o * o) * (1.f / 64.f) + EPS);
        const float hz = bf2f(U[(size_t)(row0 + t) * LDU + C_HZ + hh * 64 + e]);
        O[(size_t)(row0 + t) * DM + hh * 64 + e] = f2bfs(o * rs * inptr(I_HGN)[l * 64 + e] * siluf(hz));
    }
    if (tid < 256) {
        const int ch = tid, blk = ch >> 6, jl = ch & 63;
        float pa[4] = {0.f, 0.f, 0.f, 0.f}, px[4] = {0.f, 0.f, 0.f, 0.f};
        const float* wa = inptr(I_LWA) + (size_t)(l * 4 + blk) * 4096 + jl; const float* wx = inptr(I_LWX) + (size_t)(l * 4 + blk) * 4096 + jl;
#pragma unroll 8
        for (int i = 0; i < 64; ++i) {
            const float a = wa[i * 64], x = wx[i * 64];
#pragma unroll
            for (int t = 0; t < 4; ++t) { const float xc = XCs[t * 256 + blk * 64 + i]; pa[t] += xc * a; px[t] += xc * x; }
        }
        const float ba = inptr(I_LBA)[l * 256 + ch], bx = inptr(I_LBX)[l * 256 + ch], sp = softplusf(-inptr(I_LLAM)[l * 256 + ch]);
        float hcur = inptr(I_SLRU)[(size_t)(l * NSQ + seq) * 256 + ch];
#pragma unroll
        for (int t = 0; t < 4; ++t) {
            const float rr = sigm(pa[t] + ba), ii = sigm(px[t] + bx), la = -8.f * rr * sp;
            hcur = __expf(la) * hcur + sqrtf(fmaxf(0.f, -expm1f(2.f * la))) * ii * XCs[t * 256 + ch];
            const float lz = bf2f(U[(size_t)(row0 + t) * LDU + C_LZ + ch]);
            O[(size_t)(row0 + t) * DM + 768 + ch] = f2bfs(hcur * gelu_tanh(lz));
        }
        outq(C)[O_LRUS + (size_t)(l * NSQ + seq) * 256 + ch] = hcur;
    }
    __syncthreads();
}

template <int XM>
__device__ __forceinline__ void side_gemm_res(Ctx& C, const bf16* A, const bf16* Bt, int K, const float* xin, const bf16* XRin, bf16* XRout, const float* gvec, const float* scn, const float* gamma, bf16* XS, float* rss) {
    int tid_ = threadIdx.x; asm volatile("" : "+v"(tid_)); const int tid = tid_, lane = tid & 63, w = __builtin_amdgcn_readfirstlane(tid >> 6), g = lane >> 4, c = lane & 15;
    int bx_ = (int)blockIdx.x; asm volatile("" : "+s"(bx_));
    const int rb = bx_ >> 4, cb = bx_ & 15, rt = w >> 2, ct = w & 3;
    if (bx_ >= 256) return;
    const int row = rb * 32 + rt * 16 + c;
    const int ncol = cb * 64 + ct * 16 + c;
    const bf16* ap = A + (size_t)row * K + 8 * g; const bf16* bp = Bt + (size_t)ncol * K + 8 * g;
    f32x4 acc0 = (f32x4){0.f, 0.f, 0.f, 0.f}, acc1 = acc0;
    bf16x8 fa[8], fb[8], ga[8], gb[8];
#pragma unroll
    for (int j = 0; j < 8; ++j) { fa[j] = *(const bf16x8*)(ap + 32 * j); fb[j] = *(const bf16x8*)(bp + 32 * j); }
    for (int k0 = 0; k0 < K; k0 += 512) {
        const bool h2 = k0 + 256 < K, h3 = k0 + 512 < K;
        if (h2) {
#pragma unroll
            for (int j = 0; j < 8; ++j) { ga[j] = *(const bf16x8*)(ap + k0 + 256 + 32 * j); gb[j] = *(const bf16x8*)(bp + k0 + 256 + 32 * j); }
        }
        __builtin_amdgcn_sched_barrier(0);
#pragma unroll
        for (int j = 0; j < 8; j += 2) { acc0 = mfma16(fb[j], fa[j], acc0); acc1 = mfma16(fb[j + 1], fa[j + 1], acc1); }
        __builtin_amdgcn_sched_barrier(0);
        if (h3) {
#pragma unroll
            for (int j = 0; j < 8; ++j) { fa[j] = *(const bf16x8*)(ap + k0 + 512 + 32 * j); fb[j] = *(const bf16x8*)(bp + k0 + 512 + 32 * j); }
        }
        __builtin_amdgcn_sched_barrier(0);
        if (h2) {
#pragma unroll
            for (int j = 0; j < 8; j += 2) { acc0 = mfma16(gb[j], ga[j], acc0); acc1 = mfma16(gb[j + 1], ga[j + 1], acc1); }
        }
        __builtin_amdgcn_sched_barrier(0);
    }
    const f32x4 acc = acc0 + acc1;
    const int col = cb * 64 + ct * 16 + 4 * g, grow = MP + row, s = NBP + (row >> 2);
    f32x4 x0;
    if (XM == 0) x0 = *(const f32x4*)(xin + (size_t)row * DM + col);
    else { const u32x2 r = *(const u32x2*)(XRin + (size_t)grow * DM + col); x0 = (f32x4){bflo(r.x), bfhi(r.x), bflo(r.y), bfhi(r.y)}; }
    const f32x4 xn = x0 + *(const f32x4*)(gvec + (size_t)s * 6144 + col) * acc;
    { u32x2 wq; wq.x = pk2(xn.x, xn.y); wq.y = pk2(xn.z, xn.w); *(u32x2*)(XRout + (size_t)grow * DM + col) = wq; }
    if (scn) { const f32x4 v = xn * *(const f32x4*)(gamma + col) * (*(const f32x4*)(scn + (size_t)s * 6144 + col) + 1.f);
        u32x2 wv; wv.x = pk2(v.x, v.y); wv.y = pk2(v.z, v.w); *(u32x2*)(XS + (size_t)grow * DM + col) = wv; }
    float ss = (xn.x * xn.x + xn.y * xn.y) + (xn.z * xn.z + xn.w * xn.w);
    ss += __shfl_xor(ss, 16); ss += __shfl_xor(ss, 32);
    LAS float* red = (LAS float*)(ldsq(C));
    if (g == 0) red[(rt * 16 + c) * 4 + ct] = ss;
    __syncthreads();
    if (tid < 32) { const f32x4 p = *(const LAS f32x4*)(red + tid * 4); rss[(size_t)(MP + rb * 32 + tid) * 16 + cb] = (p.x + p.y) + (p.z + p.w); }
    __syncthreads();
}

__device__ __forceinline__ void cvec_units(Ctx& C, int r, int ashi, int ashi2, bool do1, bool dogu) {
    const bf16* ash = (const bf16*)(wsq(C) + WS_ASH) + (size_t)ashi * 256 * DM; const bf16* ash2 = (const bf16*)(wsq(C) + WS_ASH) + (size_t)ashi2 * 256 * DM;
    if (do1) {
        OneUnit S{(r >= 0 && r < 15) ? r : -1};
        pg8::Gemm g{ash, (const bf16*)(wsq(C) + WS_WIN), 256, LDU, DM};
        EpiModCvec E{(float*)(wsq(C) + WS_CV1), LDU, nullptr, NSEQ, 0, nullptr};
        pg8::gemm_phase<EpiModCvec, OneUnit, false, true>(ldsq(C), g, S, E);
    }
    if (dogu) {
        const int r2 = do1 ? r - 15 : r;
        { OneUnit S{(r2 >= 0 && r2 < 11) ? r2 : -1};
          pg8::Gemm g{ash2, (const bf16*)(wsq(C) + WS_WG), 256, DFF, DM};
          EpiModCvec E{(float*)(wsq(C) + WS_CVG), DFF, nullptr, NSEQ, 0, nullptr};
          pg8::gemm_phase<EpiModCvec, OneUnit, false, true>(ldsq(C), g, S, E); }
        { OneUnit S{(r2 >= 11 && r2 < 22) ? r2 - 11 : -1};
          pg8::Gemm g{ash2, (const bf16*)(wsq(C) + WS_WU), 256, DFF, DM};
          EpiModCvec E{(float*)(wsq(C) + WS_CVU), DFF, nullptr, NSEQ, 0, nullptr};
          pg8::gemm_phase<EpiModCvec, OneUnit, false, true>(ldsq(C), g, S, E); }
    }
}
constexpr int CW_QHEAD = 12288 + 256;
constexpr int Q_PREP = 1024, Q_LRU1 = Q_PREP + 256, Q_DEC = Q_LRU1 + 640, Q_CONV = Q_DEC + 64, Q_LRU3 = Q_CONV + 256;
__device__ __forceinline__ void phase_m12(Ctx& C, int l) {
    int v_ = (int)blockIdx.x; asm volatile("" : "+s"(v_)); const int v = v_;
    unsigned* gcnt = (unsigned*)((gu32*)(wsq(C) + WS_CTL) + CW_GCNT + l * 32 * 64);
    unsigned* lcnt = (unsigned*)((gu32*)(wsq(C) + WS_CTL) + CW_LCNT + l * 64);
    unsigned* qhead = (unsigned*)((gu32*)(wsq(C) + WS_CTL) + CW_QHEAD + l * 64);
    if (v < 32) gdn_chain(C, l, v >> 2, v & 3);
    else if (v < 64) { const int r = v - 32; hgrn_chain(C, l, r >> 2, r & 3); }
    LAS unsigned* qslot = (LAS unsigned*)(ldsq(C) + MISC_OFF + 96);
    bool lru_ok = false;
    for (;;) {
        __syncthreads();
        if (threadIdx.x == 0) *qslot = __hip_atomic_fetch_add(qhead, 1u, __ATOMIC_RELAXED, __HIP_MEMORY_SCOPE_AGENT);
        __syncthreads();
        const int j = (int)*qslot;
        if (j >= Q_LRU3) break;
        if (j < Q_PREP) { const int n = j >> 5, bh = j & 31; gdn_prep_item(C, l, bh >> 2, bh & 3, n, gcnt + 64 * n); }
        else if (j < Q_LRU1) { const int it = j - Q_PREP; lru_pass1_item(C, l, it >> 5, it & 31, lcnt); }
        else if (j < Q_DEC) { const int it = j - Q_LRU1; if (it < 512) gdn_dec_item(C, l, it >> 2, it & 3); else hl_dec_item(C, l, it - 512); }
        else if (j < Q_CONV) {
            const int gw = (j - Q_DEC) * NWAVES + C.wave, ngw = 64 * NWAVES; int base = 0;
            tr_job(C, inptr(I_WOUT) + (size_t)l * DM * DM, (bf16*)(wsq(C) + WS_WOUT), DM, DM, 0, DM, gw, ngw, base);
            tr_job(C, inptr(I_WD) + (size_t)l * DFF * DM, (bf16*)(wsq(C) + WS_WD), DM, DFF, 0, DM, gw, ngw, base);
            if (l == 0) tr_job(C, inptr(I_WIN) + (size_t)DM * 3592, (bf16*)(wsq(C) + WS_WIN), 3592, DM, 1, LDU, gw, ngw, base);
        } else {
            if (!lru_ok) { if (threadIdx.x == 0) poll_acquire(lcnt, 256u); __syncthreads(); lru_ok = true; }
            const int it = j - Q_CONV; lru_pass3_item(C, l, it >> 5, it & 31);
        }
    }
}

#ifndef MK_PER_PHASE
#define MK_PER_PHASE 0
#endif
constexpr int NPHASE = 18;
struct Args { const float* in[N_IN]; float* out; unsigned char* ws; int ph_lo, ph_hi; };
static_assert(sizeof(Args) == N_IN * 8 + 24, "Args has no padding");
__global__ void __launch_bounds__(NTHR, 2) mega_fwd(Args args) {
    extern __shared__ __attribute__((aligned(16))) unsigned char lds_raw[];
    Ctx C;
    C.lds_ = (LAS unsigned char*)lds_raw;
    C.wave = __builtin_amdgcn_readfirstlane((int)threadIdx.x >> 6);
    C.G = gridDim.x; { const int bx = blockIdx.x; C.vcu = (bx & 7) * (C.G >> 3) + (bx >> 3); }
    C.out_ = args.out; C.ws_ = args.ws;
    for (int u = threadIdx.x; u < (LDS_BYTES - LDSCTL_OFF) / 4; u += NTHR) ((LAS unsigned*)(ldsq(C) + LDSCTL_OFF))[u] = 0u;
    __syncthreads();
#if MK_PER_PHASE
    const int lo = args.ph_lo, hi = args.ph_hi;
#else
    constexpr int lo = 0, hi = NPHASE;
#endif
    if (hi - lo > 1) (void)xcd_barrier_post((unsigned*)((gu32*)(wsq(C) + WS_CTL) + CW_BAR), (volatile LAS unsigned*)(size_t)(MISC_OFF + 32));
#ifndef PROBE_MASK
#define PROBE_MASK 0u
#endif
#define PRB ((volatile LAS unsigned long long*)(ldsq(C) + MISC_OFF + 64))
#ifndef PROBE_PRE
#define PROBE_PRE 0
#endif
#define prb_thr ((PROBE_MASK != 0u || PROBE_REGION != 0) && C.vcu == PROBE_VCU && threadIdx.x == 0)
#define PH_BEGIN(k) do { if (prb_thr && ((PROBE_MASK >> (k)) & 1u)) PRB[0] = __builtin_amdgcn_s_memrealtime(); } while (0)
#define PH_END_(k) do { if (prb_thr && ((PROBE_MASK >> (k)) & 1u)) PRB[1] = PRB[1] + (__builtin_amdgcn_s_memrealtime() - PRB[0]); } while (0)
#define PH_END(k) do { if (!PROBE_PRE) PH_END_(k); } while (0)
#define PH_PRE(k) do { if (PROBE_PRE) PH_END_(k); } while (0)
#define IN(k) (lo <= (k) && (k) < hi)
#define SEAM(k) do { if (IN(k) && IN((k) + 1)) { XcdBarrier b2_; b2_.bar = (unsigned*)((gu32*)(wsq(C) + WS_CTL) + CW_BAR); b2_.x = xb_xcc_id(); b2_.st = (volatile LAS unsigned*)(size_t)(MISC_OFF + 32); xcd_barrier(b2_); } } while (0)
#define MODP ((const float*)(wsq(C) + WS_MOD))
#define RSSP ((float*)(wsq(C) + WS_RSS))
#define XSb ((bf16*)(wsq(C) + WS_XS))
#define Ub ((bf16*)(wsq(C) + WS_U))
#define Ob ((bf16*)(wsq(C) + WS_O))
#define GPb ((bf16*)(wsq(C) + WS_GP))
#define ACTb ((bf16*)(wsq(C) + WS_ACT))

    PH_BEGIN(0);
    if (IN(0)) { phase_p0(C); }
    SEAM(0);
    PH_END(0); PH_BEGIN(1);
    if (IN(1)) {
        pg8::Gemm g{(const bf16*)(wsq(C) + WS_AC), (const bf16*)(wsq(C) + WS_WADA), 256, 12288, DM};
        pg8::StaticOrder S; S.init(256, 12288, C.G, bxq());
        EpiModCvec E{(float*)(wsq(C) + WS_MOD), 6144, inptr(I_BADA), NSEQ, 1, (bf16*)(wsq(C) + WS_ASH)};
        pg8::gemm_phase<EpiModCvec, pg8::StaticOrder, false, true>(ldsq(C), g, S, E);
        if ((int)blockIdx.x >= 48) {
            const int gw = ((int)blockIdx.x - 48) * NWAVES + C.wave, ngw = (C.G - 48) * NWAVES; int base = 0;
            tr_job(C, inptr(I_WIN), (bf16*)(wsq(C) + WS_WIN), 3592, DM, 1, LDU, gw, ngw, base);
            tr_job(C, inptr(I_WG), (bf16*)(wsq(C) + WS_WG), DFF, DM, 0, DFF, gw, ngw, base);
            tr_job(C, inptr(I_WU), (bf16*)(wsq(C) + WS_WU), DFF, DM, 0, DFF, gw, ngw, base);
        }
    }
    SEAM(1);
    PH_END(1); PH_BEGIN(2);
    if (IN(2)) {
        if (C.vcu < 37) cvec_units(C, C.vcu, 0, 1, true, true);
        else x_to_xs(C, (C.vcu - 37) * NWAVES + C.wave, (C.G - 37) * NWAVES);
    }
    SEAM(2);
    PH_END(2);
#pragma unroll 1
    for (int l = 0; l < 2; ++l) {
        const int p = 3 + 7 * l;
        PH_BEGIN(p);
        if (IN(p)) {
            pg8::Gemm g{XSb, (const bf16*)(wsq(C) + WS_WIN), MROWS, LDU, DM};
            pg8::StaticOrder S; S.init(MROWS, LDU, C.G, bxq());
            EpiU E{Ub, RSSP, (const float*)(wsq(C) + WS_CV1), LDU, LDU};
            pg8::gemm_phase<EpiU, pg8::StaticOrder, true, true>(ldsq(C), g, S, E);
            if (l == 1) cvec_units(C, bxq() - 222, 3, 3, false, true);
        }
        SEAM(p);
        PH_END(p); PH_BEGIN(p + 1);
        if (IN(p + 1)) phase_m12(C, l);
        PH_PRE(p + 1);
        SEAM(p + 1);
        PH_END(p + 1); PH_BEGIN(p + 2);
        PH_PRE(p + 2);
        PH_END(p + 2); PH_BEGIN(p + 3);
        if (IN(p + 3)) {
            pg8::Gemm g{Ob, (const bf16*)(wsq(C) + WS_WOUT), MP, DM, DM};
            pg8::StaticOrder S; S.init(MP, DM, C.G, bxq());
            const float* modl = MODP + (size_t)l * NSEQ * 6144;
            bf16* xrb = (bf16*)(wsq(C) + WS_XR); const bf16* ybb = (const bf16*)outq(C);
            if (l == 0) {
                EpiRes<0> E{inptr(I_XP), nullptr, xrb, modl + 2048, modl + 4096, inptr(I_NFFN), XSb, RSSP};
                pg8::gemm_phase<EpiRes<0>, pg8::StaticOrder, true, true>(ldsq(C), g, S, E);
                side_gemm_res<0>(C, Ob + (size_t)MP * DM, (const bf16*)(wsq(C) + WS_WOUT), DM, inptr(I_XS), nullptr, xrb, modl + 2048, modl + 4096, inptr(I_NFFN), XSb, RSSP);
            } else {
                EpiRes<1> E{nullptr, ybb, xrb, modl + 2048, modl + 4096, inptr(I_NFFN) + DM, XSb, RSSP};
                pg8::gemm_phase<EpiRes<1>, pg8::StaticOrder, true, true>(ldsq(C), g, S, E);
                side_gemm_res<1>(C, Ob + (size_t)MP * DM, (const bf16*)(wsq(C) + WS_WOUT), DM, nullptr, ybb, xrb, modl + 2048, modl + 4096, inptr(I_NFFN) + DM, XSb, RSSP);
            }
        }
        SEAM(p + 3);
        PH_END(p + 3); PH_BEGIN(p + 4);
        if (IN(p + 4)) {
            pg8::Gemm g{XSb, (const bf16*)(wsq(C) + WS_WG), MROWS, DFF, DM};
            pg8::StaticOrder S; S.init(MROWS, DFF, C.G, bxq());
            EpiGate E{GPb, RSSP, (const float*)(wsq(C) + WS_CVG), outq(C) + O_FCP + (size_t)l * NBP * 2 * DFF, outq(C) + O_FCS + (size_t)l * NSQ * 2 * DFF};
            pg8::gemm_phase<EpiGate, pg8::StaticOrder, true, true>(ldsq(C), g, S, E);
            if (l == 0) cvec_units(C, bxq() - 214, 2, 2, true, false);
        }
        SEAM(p + 4);
        PH_END(p + 4); PH_BEGIN(p + 5);
        if (IN(p + 5)) {
            pg8::Gemm g{XSb, (const bf16*)(wsq(C) + WS_WU), MROWS, DFF, DM};
            pg8::StaticOrder S; S.init(MROWS, DFF, C.G, bxq());
            EpiUp E{ACTb, GPb, RSSP, (const float*)(wsq(C) + WS_CVU), inptr(I_FCW) + (size_t)l * 3 * DFF, inptr(I_FCB) + (size_t)l * DFF, inptr(I_SFC) + (size_t)l * NSQ * 2 * DFF};
            pg8::gemm_phase<EpiUp, pg8::StaticOrder, true, true>(ldsq(C), g, S, E);
        }
        SEAM(p + 5);
        PH_END(p + 5); PH_BEGIN(p + 6);
        if (IN(p + 6)) {
            pg8::Gemm g{ACTb, (const bf16*)(wsq(C) + WS_WD), MP, DM, DFF};
            pg8::StaticOrder S; S.init(MP, DM, C.G, bxq());
            const float* modl = MODP + (size_t)l * NSEQ * 6144; const float* mod1 = MODP + (size_t)NSEQ * 6144;
            bf16* xrb = (bf16*)(wsq(C) + WS_XR); bf16* ybb = (bf16*)outq(C);
            {
                EpiRes<1> E{nullptr, xrb, l == 0 ? ybb : xrb, modl + 5120, l == 0 ? mod1 + 1024 : nullptr, inptr(I_NMIX) + DM, XSb, RSSP};
                pg8::gemm_phase<EpiRes<1>, pg8::StaticOrder, true, true>(ldsq(C), g, S, E);
                side_gemm_res<1>(C, ACTb + (size_t)MP * DFF, (const bf16*)(wsq(C) + WS_WD), DFF, nullptr, xrb, l == 0 ? ybb : xrb, modl + 5120, l == 0 ? mod1 + 1024 : nullptr, inptr(I_NMIX) + DM, XSb, RSSP);
            }
            if (l == 0) {
                const int gw = C.vcu * NWAVES + C.wave, ngw = C.G * NWAVES; int base = 0;
                tr_job(C, inptr(I_WG) + (size_t)DM * DFF, (bf16*)(wsq(C) + WS_WG), DFF, DM, 0, DFF, gw, ngw, base);
                tr_job(C, inptr(I_WU) + (size_t)DM * DFF, (bf16*)(wsq(C) + WS_WU), DFF, DM, 0, DFF, gw, ngw, base);
            }
        }
        SEAM(p + 6);
        PH_END(p + 6);
    }
    PH_BEGIN(17);
    if (IN(17)) phase_final(C);
    PH_END(17);
    if (prb_thr) { const unsigned long long tgt = __builtin_amdgcn_s_memrealtime() + 4ull * PRB[1]; while (__builtin_amdgcn_s_memrealtime() < tgt) __builtin_amdgcn_s_sleep(8); }
#undef IN
#undef SEAM
}

#ifndef MK_PER_PHASE
#define MK_PER_PHASE 0
#endif
extern "C" void kernel_launch(void* const* d_in, const int* in_sizes, int n_in, void* d_out, int out_size, void* d_ws, size_t ws_size, hipStream_t stream) {
    static int grid = 0;
    if (grid == 0) {
        int dev = 0, cus = 0;
        if (n_in != N_IN || (size_t)out_size != O_END || ws_size < WS_END) { fprintf(stderr, "kernel_launch: unexpected problem (n_in %d, out %d, ws %zu)\n", n_in, out_size, ws_size); grid = -1; return; }
        if (hipGetDevice(&dev) != hipSuccess || hipDeviceGetAttribute(&cus, hipDeviceAttributeMultiprocessorCount, dev) != hipSuccess) { grid = -1; return; }
        if (hipFuncSetAttribute((const void*)mega_fwd, hipFuncAttributeMaxDynamicSharedMemorySize, LDS_BYTES) != hipSuccess) { fprintf(stderr, "kernel_launch: hipFuncSetAttribute failed\n"); grid = -1; return; }
        int per_cu = 0;
        if (hipOccupancyMaxActiveBlocksPerMultiprocessor(&per_cu, (const void*)mega_fwd, NTHR, LDS_BYTES) != hipSuccess || per_cu < 1) fprintf(stderr, "kernel_launch: occupancy query says %d blocks per CU\n", per_cu);
        (void)hipGetLastError();
        grid = cus & ~7;
    }
    if (grid < 0) return;
    (void)hipMemsetAsync((char*)d_ws + WS_CTL, 0, CTL_ZERO_BYTES, stream);
    Args a{};
    for (int i = 0; i < N_IN; ++i) a.in[i] = (const float*)d_in[i];
    a.out = (float*)d_out; a.ws = (unsigned char*)d_ws;
#if MK_PER_PHASE
    for (int p = 0; p < NPHASE; ++p) { a.ph_lo = p; a.ph_hi = p + 1; hipLaunchKernelGGL(mega_fwd, dim3(grid), dim3(NTHR), LDS_BYTES, stream, a); }
#else
    a.ph_lo = 0; a.ph_hi = NPHASE;
    hipLaunchKernelGGL(mega_fwd, dim3(grid), dim3(NTHR), LDS_BYTES, stream, a);
#endif
}
```

```cpp
#include <hip/hip_runtime.h>
#include <cstdio>
#include <cstdint>
namespace pg8 {
#define PG8_LAS __attribute__((address_space(3)))
typedef unsigned short bf16_t;
typedef short bf16x8 __attribute__((ext_vector_type(8)));
typedef float f32x4 __attribute__((ext_vector_type(4)));
typedef unsigned u32x4 __attribute__((ext_vector_type(4)));
constexpr int BM = 256, BK = 64, HALF = 128, HTB = HALF * BK * 2  , STAGE_BYTES = 8 * HTB, NXCD = 8, WGM = 8;

__host__ __device__ __forceinline__ int lds_byte(int r, int c) { const int st = (r >> 4) * 2 + (c >> 5), rr = r & 15, cc = c & 31, ob = rr * 64 + cc * 2; return st * 1024 + (ob ^ (((ob >> 9) & 1) << 5)); }
__host__ __device__ __forceinline__ void stage_rc(int b, int& R, int& C) { const int st = b / 1024, sb = b % 1024, swz = sb ^ (((sb >> 9) & 1) << 5); R = (st >> 1) * 16 + swz / 64; C = (st & 1) * 32 + (swz % 64) / 2; }
__host__ __device__ __forceinline__ int perm32(int rho) { const int n = rho >> 4, i = rho & 15; return 8 * (i >> 2) + 4 * n + (i & 3); }

struct Unit { int pm, pn; };
struct Gemm { const bf16_t* A; const bf16_t* Bt; int M, N, K; };

struct StaticOrder {
    int nM, nN, nwg, G, c;
    __host__ __device__ void init(int M, int N, int G_, int c_) { nM = M / BM; nN = N / BM; nwg = nM * nN; G = G_; c = c_; }
    __host__ __device__ bool next(int i, Unit& u) const {
        const long L = (long)i * G + c; if (L >= nwg) return false;
        int wgid = (int)L; { const int q = nwg / NXCD, r = nwg % NXCD, xcd = wgid % NXCD, off = wgid / NXCD; wgid = (xcd < r ? xcd * (q + 1) : r * (q + 1) + (xcd - r) * q) + off; }
        const int nig = WGM * nN, gid = wgid / nig, fm = gid * WGM, gsz = (nM - fm) < WGM ? (nM - fm) : WGM;
        u.pm = fm + ((wgid % nig) % gsz); u.pn = (wgid % nig) / gsz; return true;
    }
    __device__ __forceinline__ void a_ready(const Unit&) const {}
    __device__ __forceinline__ void done(const Unit&) const {}
};

__device__ __forceinline__ unsigned cvt_pk_bf16(float lo, float hi) { unsigned r; asm volatile("v_cvt_pk_bf16_f32 %0, %1, %2" : "=v"(r) : "v"(lo), "v"(hi)); return r; }
template <class Epi, class Sched, bool ALIGN_EPI = false, bool SP2 = false>
__device__ __forceinline__ void gemm_phase(PG8_LAS unsigned char* lds, const Gemm g, const Sched& S, const Epi& E) {
    int tid_ = threadIdx.x; asm volatile("" : "+v"(tid_)); const int tid = tid_, wid = __builtin_amdgcn_readfirstlane(tid >> 6), lane = tid & 63, wr = wid >> 2, wc = wid & 3, fr = lane & 15, fq = lane >> 4;
    const int K = g.K, nt = K / BK;
    unsigned voffA[2], voffB[2];
#pragma unroll
    for (int i = 0; i < 2; ++i) { int R, C; stage_rc(tid * 16 + i * 8192, R, C); const int Rb = Epi::PERM ? ((R & ~31) + perm32(R & 31)) : R;
        voffA[i] = (unsigned)(R * K + C) * 2u; voffB[i] = (unsigned)(Rb * K + C) * 2u; }
    const size_t kstep = (size_t)(BK * 2);
    const size_t hstep = (size_t)HALF * K * 2;
    const size_t tstep = 2 * hstep;
    const unsigned ldsw = (unsigned)wid * 1024u;
    const int aoff = lds_byte(wr * 64 + fr, fq * 8), boff = lds_byte(wc * 32 + fr, fq * 8);
#define PG8_SA(b, h) (((b) * 2 + (h)) * HTB)
#define PG8_SB(b, h) ((4 + (b) * 2 + (h)) * HTB)
#define PG8_STAGE(bufoff, gbase, voff) do { _Pragma("unroll") for (int _i = 0; _i < 2; ++_i) \
        __builtin_amdgcn_global_load_lds((const unsigned*)((const char*)(gbase) + (voff)[_i]), (PG8_LAS unsigned*)(lds + (bufoff) + ldsw + _i * 8192), 16, 0, 0); } while (0)
#define PG8_LDA(dst, b, h) do { _Pragma("unroll") for (int m = 0; m < 4; ++m) _Pragma("unroll") for (int k = 0; k < 2; ++k) dst[m][k] = *(const PG8_LAS bf16x8*)(lds + PG8_SA(b, h) + aoff + m * 2048 + k * 1024); } while (0)
#define PG8_LDB(dst, b, h) do { _Pragma("unroll") for (int n = 0; n < 2; ++n) _Pragma("unroll") for (int k = 0; k < 2; ++k) dst[n][k] = *(const PG8_LAS bf16x8*)(lds + PG8_SB(b, h) + boff + n * 2048 + k * 1024); } while (0)
#define PG8_MMA(ai, bj, At, Bt) do { __builtin_amdgcn_s_setprio(1); _Pragma("unroll") for (int m = 0; m < 4; ++m) _Pragma("unroll") for (int n = 0; n < 2; ++n) _Pragma("unroll") for (int k = 0; k < 2; ++k) \
        acc[ai][bj][m][n] = __builtin_amdgcn_mfma_f32_16x16x32_bf16(Bt[n][k], At[m][k], acc[ai][bj][m][n], 0, 0, 0); __builtin_amdgcn_s_setprio(0); } while (0)
#define PG8_WAIT_V(n) asm volatile("s_waitcnt vmcnt(" #n ")" ::: "memory")
#define PG8_WAIT_L(n) asm volatile("s_waitcnt lgkmcnt(" #n ")" ::: "memory")
#define PG8_BAR __builtin_amdgcn_s_barrier()
#define PG8_SCHED __builtin_amdgcn_sched_barrier(0)
    Unit cur, nxt; int ui = 0;
    if (!S.next(0, cur)) return;
    f32x4 acc[2][2][4][2];
#pragma unroll
    for (int a = 0; a < 2; ++a)
#pragma unroll
        for (int b = 0; b < 2; ++b)
#pragma unroll
            for (int m = 0; m < 4; ++m)
#pragma unroll
                for (int n = 0; n < 2; ++n) acc[a][b][m][n] = (f32x4){0.f, 0.f, 0.f, 0.f};
    bf16x8 At[4][2], B0[2][2], B1[2][2];
    const char* cA = (const char*)g.A + (size_t)cur.pm * tstep; const char* cB = (const char*)g.Bt + (size_t)cur.pn * tstep;
    S.a_ready(cur);
    if constexpr (SP2) {
        PG8_STAGE(PG8_SB(0, 0), cB, voffB); PG8_STAGE(PG8_SB(0, 1), cB + hstep, voffB); PG8_STAGE(PG8_SA(0, 0), cA, voffA); PG8_STAGE(PG8_SA(0, 1), cA + hstep, voffA);
        if (wr == 1) PG8_BAR;
        PG8_WAIT_V(2); PG8_BAR;
        PG8_STAGE(PG8_SB(1, 0), cB + kstep, voffB); PG8_STAGE(PG8_SA(1, 0), cA + kstep, voffA); PG8_STAGE(PG8_SB(1, 1), cB + hstep + kstep, voffB);
        PG8_WAIT_V(6); PG8_BAR;
    } else {
        PG8_STAGE(PG8_SB(0, 0), cB, voffB); PG8_STAGE(PG8_SA(0, 0), cA, voffA); PG8_STAGE(PG8_SB(0, 1), cB + hstep, voffB); PG8_STAGE(PG8_SA(0, 1), cA + hstep, voffA);
        if (wr == 1) PG8_BAR;
        PG8_WAIT_V(4); PG8_BAR;
        PG8_STAGE(PG8_SB(1, 0), cB + kstep, voffB); PG8_STAGE(PG8_SA(1, 0), cA + kstep, voffA); PG8_STAGE(PG8_SB(1, 1), cB + hstep + kstep, voffB);
        PG8_WAIT_V(6); PG8_BAR;
    }
    for (;;) {
        const bool has_next = S.next(ui + 1, nxt);
        const char* nA = has_next ? (const char*)g.A + (size_t)nxt.pm * tstep : cA; const char* nB = has_next ? (const char*)g.Bt + (size_t)nxt.pn * tstep : cB;
        for (int t = 0; t < nt; t += 2) {
            const bool last = (t == nt - 2);
            const char* a1 = cA + (size_t)(t + 1) * kstep;
            const char* a2 = last ? nA : cA + (size_t)(t + 2) * kstep; const char* b2 = last ? nB : cB + (size_t)(t + 2) * kstep;
            const char* a3 = a2 + kstep; const char* b3 = b2 + kstep;
            if (last && has_next) S.a_ready(nxt);
            if constexpr (SP2) {
            PG8_LDB(B0, 0, 0); PG8_LDB(B1, 0, 1); PG8_SCHED; PG8_LDA(At, 0, 0); PG8_STAGE(PG8_SA(1, 1), a1 + hstep, voffA);
            PG8_WAIT_V(8); PG8_WAIT_L(0); PG8_BAR; PG8_MMA(0, 0, At, B0); PG8_MMA(0, 1, At, B1); PG8_BAR; PG8_SCHED;
            PG8_LDA(At, 0, 1); PG8_STAGE(PG8_SB(0, 0), b2, voffB); PG8_STAGE(PG8_SB(0, 1), b2 + hstep, voffB); PG8_STAGE(PG8_SA(0, 0), a2, voffA);
            PG8_WAIT_V(8); PG8_WAIT_L(0); PG8_BAR; PG8_MMA(1, 0, At, B0); PG8_MMA(1, 1, At, B1); PG8_BAR; PG8_SCHED;
            PG8_LDB(B0, 1, 0); PG8_LDB(B1, 1, 1); PG8_SCHED; PG8_LDA(At, 1, 0); PG8_STAGE(PG8_SA(0, 1), a2 + hstep, voffA);
            PG8_WAIT_V(8); PG8_WAIT_L(0); PG8_BAR; PG8_MMA(0, 0, At, B0); PG8_MMA(0, 1, At, B1); PG8_BAR; PG8_SCHED;
            PG8_LDA(At, 1, 1); PG8_STAGE(PG8_SB(1, 0), b3, voffB); PG8_STAGE(PG8_SB(1, 1), b3 + hstep, voffB); PG8_STAGE(PG8_SA(1, 0), a3, voffA);
            PG8_WAIT_V(8); PG8_WAIT_L(0); PG8_BAR; PG8_MMA(1, 0, At, B0); PG8_MMA(1, 1, At, B1); PG8_BAR; PG8_SCHED;
            } else {
            PG8_LDB(B0, 0, 0); PG8_SCHED; PG8_LDA(At, 0, 0); PG8_STAGE(PG8_SA(1, 1), a1 + hstep, voffA);
            PG8_WAIT_L(8); PG8_BAR; PG8_WAIT_L(0); PG8_MMA(0, 0, At, B0); PG8_BAR; PG8_SCHED;
            PG8_LDB(B1, 0, 1); PG8_STAGE(PG8_SB(0, 0), b2, voffB);
            PG8_BAR; PG8_WAIT_L(0); PG8_MMA(0, 1, At, B1); PG8_BAR;
            PG8_LDA(At, 0, 1); PG8_STAGE(PG8_SA(0, 0), a2, voffA);
            PG8_BAR; PG8_WAIT_L(0); PG8_MMA(1, 0, At, B0); PG8_BAR; PG8_SCHED;
            PG8_STAGE(PG8_SB(0, 1), b2 + hstep, voffB);
            PG8_WAIT_V(6); PG8_BAR; PG8_MMA(1, 1, At, B1); PG8_BAR;
            PG8_LDB(B0, 1, 0); PG8_SCHED; PG8_LDA(At, 1, 0); PG8_STAGE(PG8_SA(0, 1), a2 + hstep, voffA);
            PG8_WAIT_L(8); PG8_BAR; PG8_WAIT_L(0); PG8_MMA(0, 0, At, B0); PG8_BAR; PG8_SCHED;
            PG8_LDB(B1, 1, 1); PG8_STAGE(PG8_SB(1, 0), b3, voffB);
            PG8_BAR; PG8_WAIT_L(0); PG8_MMA(0, 1, At, B1); PG8_BAR;
            PG8_LDA(At, 1, 1); PG8_STAGE(PG8_SA(1, 0), a3, voffA);
            PG8_BAR; PG8_WAIT_L(0); PG8_MMA(1, 0, At, B0); PG8_BAR; PG8_SCHED;
            PG8_STAGE(PG8_SB(1, 1), b3 + hstep, voffB);
            PG8_WAIT_V(6); PG8_BAR; PG8_MMA(1, 1, At, B1); PG8_BAR;
            }
        }
        if constexpr (ALIGN_EPI) { if (wr == 0) PG8_BAR; }
        if constexpr (!Epi::AFTER_DRAIN) { E(acc, cur, wr, wc, fr, fq); S.done(cur); }
        if (!has_next) break;
#pragma unroll
        for (int a = 0; a < 2; ++a)
#pragma unroll
            for (int b = 0; b < 2; ++b)
#pragma unroll
                for (int m = 0; m < 4; ++m)
#pragma unroll
                    for (int n = 0; n < 2; ++n) acc[a][b][m][n] = (f32x4){0.f, 0.f, 0.f, 0.f};
        cur = nxt; cA = nA; cB = nB; ++ui;
        if constexpr (ALIGN_EPI) { if (wr == 1) PG8_BAR; }
    }
    PG8_WAIT_V(0);
    if constexpr (!ALIGN_EPI) { if (wr == 0) PG8_BAR; }
    PG8_BAR;
    if constexpr (Epi::AFTER_DRAIN) { E.fused(acc, cur, wr, wc, fr, fq, lds, wid, lane); S.done(cur); }
#undef PG8_SA
#undef PG8_SB
#undef PG8_STAGE
#undef PG8_LDA
#undef PG8_LDB
#undef PG8_MMA
#undef PG8_WAIT_V
#undef PG8_WAIT_L
#undef PG8_BAR
#undef PG8_SCHED
}
}
#define GAS __attribute__((address_space(1)))
#define LAS __attribute__((address_space(3)))
typedef unsigned short bf16;
typedef unsigned v4u __attribute__((ext_vector_type(4)));
typedef float f32x4 __attribute__((ext_vector_type(4)));
typedef short bf16x8 __attribute__((ext_vector_type(8)));
typedef GAS unsigned gu32;
typedef GAS unsigned long long gu64;
#define RLX_AGENT __ATOMIC_RELAXED, __HIP_MEMORY_SCOPE_AGENT
#define LDS_WAIT() asm volatile("s_waitcnt lgkmcnt(0)" ::: "memory")
#define VM_WAIT() asm volatile("s_waitcnt vmcnt(0)" ::: "memory")
__device__ __forceinline__ unsigned long long rt() { return __builtin_amdgcn_s_memrealtime(); }
__device__ __forceinline__ unsigned f2bf(float f) { unsigned u = __builtin_bit_cast(unsigned, f); return (u + 0x7fffu + ((u >> 16) & 1u)) >> 16; }
__device__ __forceinline__ unsigned pk2(float lo, float hi) { unsigned r; asm("v_cvt_pk_bf16_f32 %0, %1, %2" : "=v"(r) : "v"(lo), "v"(hi)); return r; }

#define XB_TMO      128
#define XB_XCNT(j)  (256  + 64 * (j))
#define XB_XSUB(j)  (1280 + 64 * (j))
#define XB_XGEN(j)  (2304 + 64 * (j))
#define XB_TOP      3328
#define XB_TOPGEN   3392
#define XCD_BAR_WORDS 3456
#define XB_SPIN_CAP (1u << 18)

__device__ __forceinline__ unsigned xb_ld(unsigned* p)              { return __hip_atomic_load(p, __ATOMIC_RELAXED, __HIP_MEMORY_SCOPE_AGENT); }
__device__ __forceinline__ unsigned xb_add(unsigned* p, unsigned v) { return __hip_atomic_fetch_add(p, v, __ATOMIC_RELAXED, __HIP_MEMORY_SCOPE_AGENT); }
__device__ __forceinline__ unsigned xb_xcc_id() { return (unsigned)__builtin_amdgcn_s_getreg((3 << 11) | 20) & 0xFu; }
#define XB_SPIN(cond, bar) do { unsigned _sp = 0; while (cond) { __builtin_amdgcn_s_sleep(1); \
    if ((++_sp & 255u) == 0u) { if (xb_ld(&(bar)[XB_TMO])) break; if (_sp > XB_SPIN_CAP) { atomicAdd(&(bar)[XB_TMO], 1u); break; } } } } while (0)

struct XcdBarrier {
    unsigned* bar; unsigned x;
    volatile LAS unsigned* st;
};

__device__ __forceinline__ XcdBarrier xcd_barrier_post(unsigned* bar, volatile LAS unsigned* st) {
    XcdBarrier b; b.bar = bar; b.x = xb_xcc_id(); b.st = st;
    if (threadIdx.x == 0) (void)xb_add(&bar[XB_XCNT(b.x)], 1u);
    return b;
}
__device__ __forceinline__ void xcd_barrier_complete(unsigned* bar, unsigned x, unsigned& nloc, unsigned& nx) {
    const unsigned G = gridDim.x * gridDim.y * gridDim.z;
    unsigned sum, cnt, mine, sp = 0u;
    for (;;) {
        sum = 0u; cnt = 0u; mine = 0u;
#pragma unroll
        for (unsigned j = 0; j < 16; ++j) { const unsigned c = xb_ld(&bar[XB_XCNT(j)]); sum += c; cnt += (c > 0u) ? 1u : 0u; mine = (j == x) ? c : mine; }
        if (sum == G) break;
        __builtin_amdgcn_s_sleep(1);
        if ((++sp & 255u) == 0u) { if (xb_ld(&bar[XB_TMO])) break; if (sp > XB_SPIN_CAP) { atomicAdd(&bar[XB_TMO], 1u); break; } }
    }
    nloc = mine > 0u ? mine : 1u; nx = cnt > 0u ? cnt : 1u;
}

__device__ __forceinline__ void xcd_barrier(const XcdBarrier& b) {
    asm volatile("s_waitcnt vmcnt(0)" ::: "memory");
    __syncthreads();
    if (threadIdx.x == 0) {
        unsigned* bar = b.bar;
        __builtin_amdgcn_s_waitcnt(0);
        unsigned nloc = b.st[0], nx = b.st[1];
        if (nloc == 0u) { xcd_barrier_complete(bar, b.x, nloc, nx); b.st[0] = nloc; b.st[1] = nx; }
        const unsigned old = xb_add(&bar[XB_XSUB(b.x)], 1u);
        const unsigned gen = old / nloc;
        if (old + 1u == (gen + 1u) * nloc) {
            __builtin_amdgcn_fence(__ATOMIC_RELEASE, "agent");
            asm volatile("s_waitcnt vmcnt(0)" ::: "memory");
            const unsigned og = xb_add(&bar[XB_TOP], 1u);
            const unsigned tg = og / nx;
            if (og + 1u == (tg + 1u) * nx) xb_add(&bar[XB_TOPGEN], 1u);
            else XB_SPIN(xb_ld(&bar[XB_TOPGEN]) == tg, bar);
            __builtin_amdgcn_fence(__ATOMIC_ACQUIRE, "agent");
            xb_add(&bar[XB_XGEN(b.x)], 1u);
            asm volatile("s_waitcnt vmcnt(0)" ::: "memory");
        } else {
            XB_SPIN(xb_ld(&bar[XB_XGEN(b.x)]) == gen, bar);
            __builtin_amdgcn_fence(__ATOMIC_ACQUIRE, "agent");
            asm volatile("s_waitcnt vmcnt(0)" ::: "memory");
        }
    }
    __syncthreads();
}
constexpr int NWAVES = 8, NTHR = 512;
constexpr int DM = 1024, TSEQ = 2048, NBP = 8, NSQ = 128, TSMP = 4, NSEQ = 136;
constexpr int MP = 16384, MROWS = 16896;
constexpr int DFF = 2816, LDU = 3840;
constexpr float EPS = 1e-6f;
constexpr int C_HQ = 0, C_HF = 256, C_HI = 512, C_HZ = 768, C_Q = 1024, C_K = 1536, C_V = 2048, C_GZ = 2560, C_LX = 3072, C_LZ = 3328, C_GA = 3584, C_GB = 3588;
enum { I_XP = 0, I_XS, I_SHG, I_SGDN, I_SGC, I_SLRU, I_SLC, I_SFC, I_CP, I_CS, I_NMIX, I_NFFN, I_WADA, I_BADA, I_WIN, I_HGLB, I_HGN, I_GCW, I_GALOG, I_GDTB, I_GNORM,
       I_LCW, I_LCB, I_LWA, I_LBA, I_LWX, I_LBX, I_LLAM, I_WOUT, I_WG, I_WU, I_FCW, I_FCB, I_WD, I_FNORM, N_IN };
constexpr size_t O_YP = 0, O_YS = 16777216, O_HGP = 17301504, O_GDNP = 17563648, O_GCP = 18612224, O_LRUP = 18685952, O_LCP = 18690048, O_FCP = 18702336,
                 O_HGS = 18792448, O_GDNS = 22986752, O_GCS = 39763968, O_LRUS = 40943616, O_LCS = 41009152, O_FCS = 41205760, O_END = 42647552;
constexpr size_t MiB = 1u << 20;
constexpr size_t WS_CTL = 0, CTL_ZERO_BYTES = 65536;
constexpr size_t WS_WIN = 1 * MiB;
constexpr size_t WS_WOUT = 9 * MiB;
constexpr size_t WS_WG = 11 * MiB;
constexpr size_t WS_WU = 17 * MiB;
constexpr size_t WS_WD = 23 * MiB;
constexpr size_t WS_AC = 29 * MiB;
constexpr size_t WS_ASH = 30 * MiB;
constexpr size_t WS_MOD = 32 * MiB;
constexpr size_t WS_CV1 = 39 * MiB;
constexpr size_t WS_CVG = 41 * MiB;
constexpr size_t WS_CVU = 43 * MiB;
constexpr size_t WS_RSS = 45 * MiB;
constexpr size_t WS_XS = 47 * MiB;
constexpr size_t WS_PQ = 47 * MiB, WS_PK = 63 * MiB;
constexpr size_t WS_U = 80 * MiB;
constexpr size_t WS_O = 204 * MiB;
constexpr size_t WS_WADA = 204 * MiB;
constexpr size_t WS_PW = 237 * MiB, WS_PU = 253 * MiB, WS_PA = 269 * MiB, WS_EGL = 277 * MiB;
constexpr size_t WS_GP = 80 * MiB;
constexpr size_t WS_ACT = 171 * MiB;
constexpr size_t WS_LSUM = 277 * MiB + 65536;
constexpr size_t WS_ACUM = 278 * MiB, WS_HLOC = 286 * MiB;
constexpr size_t WS_XR = 262 * MiB;
constexpr size_t WS_END = 295 * MiB;
constexpr int CW_BAR = 4096;
constexpr int CW_GCNT = 8192;
constexpr int CW_LCNT = 12288;
constexpr int LDS_BYTES = 163840, LDSCTL_OFF = 162816, MISC_OFF = LDSCTL_OFF + 320;

typedef float f32x2 __attribute__((ext_vector_type(2)));
typedef unsigned u32x2 __attribute__((ext_vector_type(2)));
struct Ctx {
    LAS unsigned char* lds_;
    int wave, vcu, G;
    float* out_; unsigned char* ws_;
};
__device__ __forceinline__ LAS unsigned char* ldsq(const Ctx& C) { LAS unsigned char* p = C.lds_; asm volatile("" : "+s"(p)); return p; }
__device__ __forceinline__ int bxq() { int b = (int)blockIdx.x; asm volatile("" : "+s"(b)); return b; }
__device__ __forceinline__ unsigned char* wsq(const Ctx& C) { unsigned char* p = C.ws_; asm volatile("" : "+s"(p)); return p; }
__device__ __forceinline__ float* outq(const Ctx& C) { float* p = C.out_; asm volatile("" : "+s"(p)); return p; }
__device__ __forceinline__ const float* inptr(int i) {
    unsigned long long ka = (unsigned long long)__builtin_amdgcn_kernarg_segment_ptr();
    asm volatile("" : "+s"(ka));
    return *(const float* const __attribute__((address_space(4)))*)(ka + 8ull * (unsigned)i);
}
__device__ __forceinline__ float bf2f(unsigned short h) { return __builtin_bit_cast(float, (unsigned)h << 16); }
__device__ __forceinline__ float bflo(unsigned w) { return __builtin_bit_cast(float, w << 16); }
__device__ __forceinline__ float bfhi(unsigned w) { return __builtin_bit_cast(float, w & 0xffff0000u); }
__device__ __forceinline__ unsigned short f2bfs(float f) { return (unsigned short)(pk2(f, f) & 0xffffu); }
__device__ __forceinline__ float sigm(float x) { return __builtin_amdgcn_rcpf(1.f + __expf(-x)); }
__device__ __forceinline__ float siluf(float x) { return x * __builtin_amdgcn_rcpf(1.f + __expf(-x)); }
__device__ __forceinline__ float softplusf(float x) { return x > 20.f ? x : log1pf(__expf(x)); }
__device__ __forceinline__ float gelu_tanh(float x) { const float u = 0.7978845608028654f * (x + 0.044715f * x * x * x); return x * __builtin_amdgcn_rcpf(1.f + __expf(-2.f * u)); }
__device__ __forceinline__ float dpp_sum16(float v) {
    v += __builtin_bit_cast(float, __builtin_amdgcn_update_dpp(0, __builtin_bit_cast(int, v), 0xB1, 0xF, 0xF, true));
    v += __builtin_bit_cast(float, __builtin_amdgcn_update_dpp(0, __builtin_bit_cast(int, v), 0x4E, 0xF, 0xF, true));
    v += __builtin_bit_cast(float, __builtin_amdgcn_update_dpp(0, __builtin_bit_cast(int, v), 0x141, 0xF, 0xF, true));
    v += __builtin_bit_cast(float, __builtin_amdgcn_update_dpp(0, __builtin_bit_cast(int, v), 0x140, 0xF, 0xF, true));
    return v;
}
__device__ __forceinline__ int permpos(int d) { return 8 * ((d >> 2) & 3) + 4 * ((d >> 4) & 1) + (d & 3); }
__device__ __forceinline__ int seq_of_row(int row) { return row < MP ? (row >> 11) : NBP + ((row - MP) >> 2); }
__device__ __forceinline__ bf16x8 pack8(const f32x4 a, const f32x4 b) {
    v4u w; w.x = pk2(a.x, a.y); w.y = pk2(a.z, a.w); w.z = pk2(b.x, b.y); w.w = pk2(b.z, b.w); return __builtin_bit_cast(bf16x8, w);
}
__device__ __forceinline__ f32x4 mfma16(const bf16x8 a, const bf16x8 b, const f32x4 c) { return __builtin_amdgcn_mfma_f32_16x16x32_bf16(a, b, c, 0, 0, 0); }
__device__ __forceinline__ void glds16(const void* g, LAS unsigned char* l) { __builtin_amdgcn_global_load_lds((const unsigned*)g, (LAS unsigned*)l, 16, 0, 0); }
__device__ __forceinline__ float rstd_of(const float* rss, int row) {
    const f32x4* p = (const f32x4*)(rss + (size_t)row * 16); const f32x4 a = p[0], b = p[1], c = p[2], d = p[3];
    const float s = ((a.x + a.y) + (a.z + a.w)) + ((b.x + b.y) + (b.z + b.w)) + ((c.x + c.y) + (c.z + c.w)) + ((d.x + d.y) + (d.z + d.w));
    return rsqrtf(s * (1.f / DM) + EPS);
}

struct EpiModCvec {
    static constexpr bool PERM = false, AFTER_DRAIN = false;
    float* C; int ldc; const float* bias; int rowmax; int adaln; bf16* ash;
    __device__ __forceinline__ void operator()(const f32x4 (&acc)[2][2][4][2], const pg8::Unit& u, int wr, int wc, int fr, int fq) const {
        const int colb = u.pn * 256 + wc * 32 + 4 * fq;
#pragma unroll
        for (int ai = 0; ai < 2; ++ai)
#pragma unroll
            for (int m = 0; m < 4; ++m) {
                const int row = ai * 128 + wr * 64 + m * 16 + fr;
                if (row < rowmax) {
#pragma unroll
                    for (int bj = 0; bj < 2; ++bj)
#pragma unroll
                        for (int n = 0; n < 2; ++n) {
                            const int col = colb + bj * 128 + n * 16; f32x4 v = acc[ai][bj][m][n];
                            if (adaln) {
                                const int l = col / 6144, cl = col - l * 6144, chunk = cl >> 10;
                                v = v + *(const f32x4*)(bias + col);
                                *(f32x4*)(C + ((size_t)l * NSEQ + row) * 6144 + cl) = v;
                                if (chunk == 0 || chunk == 3) { u32x2 w; w.x = pk2(v.x, v.y); w.y = pk2(v.z, v.w); *(u32x2*)(ash + ((size_t)(2 * l + (chunk == 3)) * 256 + row) * DM + (cl & 1023)) = w; }
                            } else {
                                *(f32x4*)(C + (size_t)row * ldc + col) = v;
                            }
                        }
                }
            }
    }
};
constexpr int EPL_OFF = 131072;
#define EPLP ((LAS float*)(size_t)EPL_OFF)
template <int NV>
__device__ __forceinline__ void epi_stage(LAS float* epl, const float* rss, int pm, int pn, const float* v0, const float* v1, const float* v2, const float* v3, const float* v4) {
    const int tid = threadIdx.x;
    if (tid < 256) { if (rss) epl[tid] = rstd_of(rss, pm * 256 + tid); }
    else {
        const int cl = tid - 256, col = pn * 256 + cl;
        if (NV > 0 && v0) epl[256 + cl] = v0[col];
        if (NV > 1 && v1) epl[512 + cl] = v1[col];
        if (NV > 2 && v2) epl[768 + cl] = v2[col];
        if (NV > 3 && v3) epl[1024 + cl] = v3[col];
        if (NV > 4 && v4) epl[1280 + cl] = v4[col];
    }
    asm volatile("s_waitcnt vmcnt(0) lgkmcnt(0)" ::: "memory");
    __builtin_amdgcn_s_barrier();
    asm volatile("" ::: "memory");
}
struct EpiU {
    static constexpr bool PERM = true, AFTER_DRAIN = false;
    bf16* U; const float* rss; const float* cvec; int ldo; int ldcv;
    __device__ __forceinline__ void operator()(const f32x4 (&acc)[2][2][4][2], const pg8::Unit& u, int wr, int wc, int fr, int fq) const {
        const bool prm = u.pm < 64;
        epi_stage<1>(EPLP, rss, u.pm, u.pn, prm ? cvec + (size_t)(u.pm >> 3) * ldcv : nullptr, nullptr, nullptr, nullptr, nullptr);
        const int cl = wc * 32 + 8 * fq, colb = u.pn * 256 + cl;
#pragma unroll
        for (int ai = 0; ai < 2; ++ai)
#pragma unroll
            for (int m = 0; m < 4; ++m) {
                const int rl = ai * 128 + wr * 64 + m * 16 + fr, row = u.pm * 256 + rl;
                const float rs = EPLP[rl];
                bf16* op = U + (size_t)row * ldo + colb;
#pragma unroll
                for (int bj = 0; bj < 2; ++bj) {
                    f32x4 c0, c1;
                    if (prm) { c0 = *(const LAS f32x4*)(EPLP + 256 + cl + bj * 128); c1 = *(const LAS f32x4*)(EPLP + 256 + cl + bj * 128 + 4); }
                    else { const float* cv = cvec + (size_t)seq_of_row(row) * ldcv + colb + bj * 128; c0 = *(const f32x4*)cv; c1 = *(const f32x4*)(cv + 4); }
                    const f32x4 v0 = acc[ai][bj][m][0] * rs + c0, v1 = acc[ai][bj][m][1] * rs + c1;
                    v4u w; w.x = pk2(v0.x, v0.y); w.y = pk2(v0.z, v0.w); w.z = pk2(v1.x, v1.y); w.w = pk2(v1.z, v1.w);
                    *(v4u*)(op + bj * 128) = w;
                }
            }
    }
};
struct EpiGate {
    static constexpr bool PERM = true, AFTER_DRAIN = false;
    bf16* GP; const float* rss; const float* cvec; float* fcp; float* fcs;
    __device__ __forceinline__ void operator()(const f32x4 (&acc)[2][2][4][2], const pg8::Unit& u, int wr, int wc, int fr, int fq) const {
        const bool prm = u.pm < 64;
        epi_stage<1>(EPLP, rss, u.pm, u.pn, prm ? cvec + (size_t)(u.pm >> 3) * DFF : nullptr, nullptr, nullptr, nullptr, nullptr);
        const int cl = wc * 32 + 8 * fq, colb = u.pn * 256 + cl;
#pragma unroll
        for (int ai = 0; ai < 2; ++ai)
#pragma unroll
            for (int m = 0; m < 4; ++m) {
                const int rl = ai * 128 + wr * 64 + m * 16 + fr, row = u.pm * 256 + rl;
                const float rs = EPLP[rl]; const int s = seq_of_row(row);
                bf16* op = GP + (size_t)row * DFF + colb;
                float* st = nullptr;
                if (row < MP) { const int tt = row & (TSEQ - 1); if (tt >= TSEQ - 2) st = fcp + ((size_t)s * 2 + (tt - (TSEQ - 2))) * DFF + colb; }
                else { const int tt = row & 3; if (tt >= 2) st = fcs + ((size_t)(s - NBP) * 2 + (tt - 2)) * DFF + colb; }
#pragma unroll
                for (int bj = 0; bj < 2; ++bj) {
                    f32x4 c0, c1;
                    if (prm) { c0 = *(const LAS f32x4*)(EPLP + 256 + cl + bj * 128); c1 = *(const LAS f32x4*)(EPLP + 256 + cl + bj * 128 + 4); }
                    else { const float* cv = cvec + (size_t)s * DFF + colb + bj * 128; c0 = *(const f32x4*)cv; c1 = *(const f32x4*)(cv + 4); }
                    const f32x4 v0 = acc[ai][bj][m][0] * rs + c0, v1 = acc[ai][bj][m][1] * rs + c1;
                    v4u w; w.x = pk2(v0.x, v0.y); w.y = pk2(v0.z, v0.w); w.z = pk2(v1.x, v1.y); w.w = pk2(v1.z, v1.w);
                    *(v4u*)(op + bj * 128) = w;
                    if (st) { *(f32x4*)(st + bj * 128) = v0; *(f32x4*)(st + bj * 128 + 4) = v1; }
                }
            }
    }
};
struct EpiUp {
    static constexpr bool PERM = true, AFTER_DRAIN = false;
    bf16* ACT; const bf16* GP; const float* rss; const float* cvec; const float* cw; const float* cb; const float* sfc;
    template <int BY> static __device__ __forceinline__ unsigned nb(unsigned cur, unsigned prev, int fr) {
        const unsigned s = (unsigned)__builtin_amdgcn_update_dpp(0, (int)cur, BY == 1 ? 0x111 : 0x112, 0xF, 0xF, true);
        const unsigned p = (unsigned)__builtin_amdgcn_update_dpp(0, (int)prev, BY == 1 ? 0x121 : 0x122, 0xF, 0xF, true);
        return fr < BY ? p : s;
    }
    __device__ __forceinline__ void operator()(const f32x4 (&acc)[2][2][4][2], const pg8::Unit& u, int wr, int wc, int fr, int fq) const {
        const bool prm = u.pm < 64;
        epi_stage<5>(EPLP, rss, u.pm, u.pn, prm ? cvec + (size_t)(u.pm >> 3) * DFF : nullptr, cw, cw + DFF, cw + 2 * DFF, cb);
        const int cl = wc * 32 + 8 * fq, colb = u.pn * 256 + cl;
#pragma unroll
        for (int ai = 0; ai < 2; ++ai)
#pragma unroll
            for (int bj = 0; bj < 2; ++bj) {
                const int cc = colb + bj * 128, lc = cl + bj * 128;
                const int rbase = u.pm * 256 + ai * 128 + wr * 64;
                v4u rb[5];
#pragma unroll
                for (int k = 0; k < 5; ++k) { const int row = rbase + 16 * (k - 1) + fr; rb[k] = *(const v4u*)(GP + (size_t)(row < 0 ? 0 : row) * DFF + cc); }
#pragma unroll
                for (int m = 0; m < 4; ++m) {
                    const int rl = ai * 128 + wr * 64 + m * 16 + fr, row = u.pm * 256 + rl;
                    const float rs = EPLP[rl];
                    const int tt = row < MP ? (row & (TSEQ - 1)) : (row & 3);
                    const int s = seq_of_row(row);
                    const v4u cur = rb[m + 1], prv = rb[m];
                    unsigned wq[4];
#pragma unroll
                    for (int hf = 0; hf < 2; ++hf) {
                        const unsigned q0 = hf ? cur.z : cur.x, q1 = hf ? cur.w : cur.y, v0 = hf ? prv.z : prv.x, v1 = hf ? prv.w : prv.y;
                        const unsigned p0 = nb<1>(q0, v0, fr), p1 = nb<1>(q1, v1, fr), o0 = nb<2>(q0, v0, fr), o1 = nb<2>(q1, v1, fr);
                        const f32x4 g0 = (f32x4){bflo(q0), bfhi(q0), bflo(q1), bfhi(q1)};
                        f32x4 g1 = (f32x4){bflo(p0), bfhi(p0), bflo(p1), bfhi(p1)}, g2 = (f32x4){bflo(o0), bfhi(o0), bflo(o1), bfhi(o1)}, c0;
                        if (prm) {
                            const f32x4 z4 = (f32x4){0.f, 0.f, 0.f, 0.f};
                            if (tt < 1) g1 = z4;
                            if (tt < 2) g2 = z4;
                            c0 = *(const LAS f32x4*)(EPLP + 256 + lc + 4 * hf);
                        } else {
                            if (tt < 1) g1 = *(const f32x4*)(sfc + ((size_t)(s - NBP) * 2 + 1) * DFF + cc + 4 * hf);
                            if (tt < 2) g2 = *(const f32x4*)(sfc + ((size_t)(s - NBP) * 2 + tt) * DFF + cc + 4 * hf);
                            c0 = *(const f32x4*)(cvec + (size_t)s * DFF + cc + 4 * hf);
                        }
                        const f32x4 uu = acc[ai][bj][m][hf] * rs + c0;
                        const f32x4 ga = *(const LAS f32x4*)(EPLP + 512 + lc + 4 * hf) * g2 + *(const LAS f32x4*)(EPLP + 768 + lc + 4 * hf) * g1 + *(const LAS f32x4*)(EPLP + 1024 + lc + 4 * hf) * g0 + *(const LAS f32x4*)(EPLP + 1280 + lc + 4 * hf);
                        wq[2 * hf] = pk2(siluf(ga.x) * uu.x, siluf(ga.y) * uu.y); wq[2 * hf + 1] = pk2(siluf(ga.z) * uu.z, siluf(ga.w) * uu.w);
                    }
                    v4u w; w.x = wq[0]; w.y = wq[1]; w.z = wq[2]; w.w = wq[3];
                    *(v4u*)(ACT + (size_t)row * DFF + cc) = w;
                }
            }
    }
};
template <int XM>
struct EpiRes {
    static constexpr bool PERM = false, AFTER_DRAIN = false;
    const float* xinP; const bf16* XRin; bf16* XRout; const float* gvec; const float* scn; const float* gamma; bf16* XS; float* rss;
    __device__ __forceinline__ void operator()(const f32x4 (&acc)[2][2][4][2], const pg8::Unit& u, int wr, int wc, int fr, int fq) const {
        const int s0 = u.pm >> 3;
        epi_stage<3>(EPLP, nullptr, u.pm, u.pn, gvec + (size_t)s0 * 6144, scn ? scn + (size_t)s0 * 6144 : nullptr, scn ? gamma : nullptr, nullptr, nullptr);
        const int cl = wc * 32 + 4 * fq, colb = u.pn * 256 + cl;
#pragma unroll
        for (int ai = 0; ai < 2; ++ai)
#pragma unroll
            for (int mp = 0; mp < 2; ++mp) {
                f32x4 xr[2][2][2];
#pragma unroll
                for (int m2 = 0; m2 < 2; ++m2) {
                    const size_t ro = (size_t)(u.pm * 256 + ai * 128 + wr * 64 + (2 * mp + m2) * 16 + fr) * DM + colb;
#pragma unroll
                    for (int bj = 0; bj < 2; ++bj)
#pragma unroll
                        for (int n = 0; n < 2; ++n) {
                            if (XM == 0) xr[m2][bj][n] = *(const f32x4*)(xinP + ro + bj * 128 + n * 16);
                            else { const u32x2 r = *(const u32x2*)(XRin + ro + bj * 128 + n * 16); xr[m2][bj][n] = (f32x4){bflo(r.x), bfhi(r.x), bflo(r.y), bfhi(r.y)}; }
                        }
                }
#pragma unroll
                for (int m2 = 0; m2 < 2; ++m2) {
                    const int m = 2 * mp + m2, row = u.pm * 256 + ai * 128 + wr * 64 + m * 16 + fr;
                    float ss = 0.f;
#pragma unroll
                    for (int bj = 0; bj < 2; ++bj)
#pragma unroll
                        for (int n = 0; n < 2; ++n) {
                            const int lc = cl + bj * 128 + n * 16, col = u.pn * 256 + lc;
                            const f32x4 xn = xr[m2][bj][n] + *(const LAS f32x4*)(EPLP + 256 + lc) * acc[ai][bj][m][n];
                            { u32x2 w; w.x = pk2(xn.x, xn.y); w.y = pk2(xn.z, xn.w); *(u32x2*)(XRout + (size_t)row * DM + col) = w; }
                            ss += (xn.x * xn.x + xn.y * xn.y) + (xn.z * xn.z + xn.w * xn.w);
                            if (scn) { const f32x4 v = xn * *(const LAS f32x4*)(EPLP + 768 + lc) * (*(const LAS f32x4*)(EPLP + 512 + lc) + 1.f);
                                u32x2 w; w.x = pk2(v.x, v.y); w.y = pk2(v.z, v.w); *(u32x2*)(XS + (size_t)row * DM + col) = w; }
                        }
                    ss += __shfl_xor(ss, 16); ss += __shfl_xor(ss, 32);
                    if (fq == 0) rss[(size_t)row * 16 + u.pn * 4 + wc] = ss;
                }
            }
    }
};
struct OneUnit {
    int pn;
    __device__ __forceinline__ bool next(int i, pg8::Unit& u) const { if (i > 0 || pn < 0) return false; u.pm = 0; u.pn = pn; return true; }
    __device__ __forceinline__ void a_ready(const pg8::Unit&) const {}
    __device__ __forceinline__ void done(const pg8::Unit&) const {}
};

#ifndef DBL_LOADS
#define DBL_LOADS 0
#endif
#ifndef PROBE_REGION
#define PROBE_REGION 0
#endif
#ifndef PROBE_VCU
#define PROBE_VCU 0
#endif
#define RB(id) do { if (PROBE_REGION == (id) && C.vcu == PROBE_VCU && threadIdx.x == 0) ((volatile LAS unsigned long long*)(ldsq(C) + MISC_OFF + 64))[0] = __builtin_amdgcn_s_memrealtime(); } while (0)
#define RE(id) do { if (PROBE_REGION == (id) && C.vcu == PROBE_VCU && threadIdx.x == 0) { volatile LAS unsigned long long* q_ = (volatile LAS unsigned long long*)(ldsq(C) + MISC_OFF + 64); q_[1] = q_[1] + (__builtin_amdgcn_s_memrealtime() - q_[0]); } } while (0)
__device__ __forceinline__ void st16_wt(unsigned char* ws, size_t off, const v4u v) {
    const __amdgpu_buffer_rsrc_t r = __builtin_amdgcn_make_buffer_rsrc(ws, (short)0, (int)WS_END, 0x00020000);
    __builtin_amdgcn_raw_buffer_store_b128(v, r, (unsigned)off, 0, 16);
}
__device__ __forceinline__ void st8_wt(void* p, const u32x2 v) { __hip_atomic_store((unsigned long long*)p, (unsigned long long)v.x | ((unsigned long long)v.y << 32), __ATOMIC_RELAXED, __HIP_MEMORY_SCOPE_AGENT); }
__device__ __forceinline__ void st4_wt(float* p, float v) { __hip_atomic_store((unsigned*)p, __builtin_bit_cast(unsigned, v), __ATOMIC_RELAXED, __HIP_MEMORY_SCOPE_AGENT); }
__device__ __forceinline__ void publish_add(unsigned* cnt) {
    if (!cnt) { __syncthreads(); return; }
    asm volatile("s_waitcnt vmcnt(0)" ::: "memory");
    __syncthreads();
    if (threadIdx.x == 0) (void)__hip_atomic_fetch_add(cnt, 1u, __ATOMIC_RELAXED, __HIP_MEMORY_SCOPE_AGENT);
}
__device__ __forceinline__ void poll_acquire(unsigned* cnt, unsigned need) {
    unsigned sp = 0;
    while (__hip_atomic_load(cnt, __ATOMIC_RELAXED, __HIP_MEMORY_SCOPE_AGENT) < need) { __builtin_amdgcn_s_sleep(2); if (++sp > (1u << 22)) break; }
    __builtin_amdgcn_fence(__ATOMIC_ACQUIRE, "agent");
    asm volatile("s_waitcnt vmcnt(0)" ::: "memory");
}
__device__ __forceinline__ float wave_sum(float v) {
#pragma unroll
    for (int o = 1; o < 64; o <<= 1) v += __shfl_xor(v, o);
    return v;
}
template <int MODE>
__device__ __forceinline__ void tr_item(const float* W, int N, int K, bf16* WT, int nblk, LAS float* scr, int item, int lane) {
    const int kb = item / nblk, nb = item - kb * nblk, k0 = 64 * kb, n0 = 64 * nb;
    const int c4 = (lane & 15) * 4, r0 = lane >> 4;
    int sc = n0 + c4;
    if (MODE == 1) { const int np = sc; sc = np < 3072 ? np : (np < 3584 ? np + 8 : (np < 3592 ? np - 512 : -1)); }
#pragma unroll 4
    for (int i = 0; i < 16; ++i) {
        const int kk = 4 * i + r0;
        const f32x4 v = sc >= 0 ? *(const f32x4*)(W + (size_t)(k0 + kk) * N + sc) : (f32x4){0.f, 0.f, 0.f, 0.f};
        LAS float* d = scr + kk * 65 + c4; d[0] = v.x; d[1] = v.y; d[2] = v.z; d[3] = v.w;
    }
    LDS_WAIT(); asm volatile("" ::: "memory");
    const int c = lane & 7;
#pragma unroll
    for (int j = 0; j < 8; ++j) { const int n = (lane >> 3) + 8 * j; const LAS float* s = scr + (8 * c) * 65 + n;
        v4u o; o.x = pk2(s[0 * 65], s[1 * 65]); o.y = pk2(s[2 * 65], s[3 * 65]); o.z = pk2(s[4 * 65], s[5 * 65]); o.w = pk2(s[6 * 65], s[7 * 65]);
        *(GAS v4u*)(WT + (size_t)(n0 + n) * K + k0 + 8 * c) = o; }
    LDS_WAIT(); asm volatile("" ::: "memory");
}
__device__ __forceinline__ void tr_job(Ctx& C, const float* W, bf16* WT, int N, int K, int mode, int ndest, int gw, int ngw, int& base) {
    int tid_ = threadIdx.x; asm volatile("" : "+v"(tid_)); const int lane = tid_ & 63; (void)lane;
    LAS float* scr = (LAS float*)(ldsq(C) + C.wave * 16640);
    const int nblk = ndest / 64, nit = nblk * (K / 64);
    int it = gw - (base % ngw); if (it < 0) it += ngw;
    for (; it < nit; it += ngw) { if (mode == 1) tr_item<1>(W, N, K, WT, nblk, scr, it, lane); else tr_item<0>(W, N, K, WT, nblk, scr, it, lane); }
    base += nit;
}
__device__ __forceinline__ void phase_p0(Ctx& C) {
    const int gw = C.vcu * NWAVES + C.wave, ngw = C.G * NWAVES;
    bf16* wada = (bf16*)(wsq(C) + WS_WADA);
    int base = 0;
    tr_job(C, inptr(I_WADA), wada, 6144, DM, 0, 6144, gw, ngw, base);
    tr_job(C, inptr(I_WADA) + (size_t)DM * 6144, wada + (size_t)6144 * DM, 6144, DM, 0, 6144, gw, ngw, base);
    bf16* ac = (bf16*)(wsq(C) + WS_AC);
    int tid_ = threadIdx.x; asm volatile("" : "+v"(tid_)); const int lane = tid_ & 63; (void)lane;
    for (int r = gw; r < NSEQ; r += ngw) {
        const float* src = r < NBP ? inptr(I_CP) + (size_t)r * DM : inptr(I_CS) + (size_t)(r - NBP) * DM;
#pragma unroll
        for (int j = 0; j < 4; ++j) { const f32x4 v = *(const f32x4*)(src + 256 * j + 4 * lane);
            u32x2 w; w.x = pk2(siluf(v.x), siluf(v.y)); w.y = pk2(siluf(v.z), siluf(v.w)); *(u32x2*)(ac + (size_t)r * DM + 256 * j + 4 * lane) = w; }
    }
}
__device__ __forceinline__ void x_to_xs(Ctx& C, int gw, int ngw) {
    const float* mod = (const float*)(wsq(C) + WS_MOD); bf16* xs = (bf16*)(wsq(C) + WS_XS); float* rss = (float*)(wsq(C) + WS_RSS);
    const float* gam = inptr(I_NMIX); const float* xp_ = inptr(I_XP); const float* xs_ = inptr(I_XS);
    int tid_ = threadIdx.x; asm volatile("" : "+v"(tid_)); const int lane = tid_ & 63; (void)lane;
    for (int row = gw; row < MROWS; row += ngw) {
        const float* src = row < MP ? xp_ + (size_t)row * DM : xs_ + (size_t)(row - MP) * DM;
        const int s = seq_of_row(row); const float* sc = mod + (size_t)s * 6144 + 1024;
        float ss = 0.f;
#pragma unroll
        for (int j = 0; j < 4; ++j) { const int col = 256 * j + 4 * lane; const f32x4 v = *(const f32x4*)(src + col);
            ss += (v.x * v.x + v.y * v.y) + (v.z * v.z + v.w * v.w);
            const f32x4 o = v * *(const f32x4*)(gam + col) * (*(const f32x4*)(sc + col) + 1.f);
            u32x2 w; w.x = pk2(o.x, o.y); w.y = pk2(o.z, o.w); *(u32x2*)(xs + (size_t)row * DM + col) = w; }
        ss = wave_sum(ss);
        if (lane < 16) rss[(size_t)row * 16 + lane] = lane == 0 ? ss : 0.f;
    }
}
__device__ __forceinline__ void phase_final(Ctx& C) {
    const int gw = C.vcu * NWAVES + C.wave, ngw = C.G * NWAVES;
    const float* rss = (const float*)(wsq(C) + WS_RSS); const float* gam = inptr(I_FNORM);
    int tid_ = threadIdx.x; asm volatile("" : "+v"(tid_)); const int lane = tid_ & 63; (void)lane;
    for (int row = gw; row < MROWS; row += ngw) {
        const float rs = rstd_of(rss, row); float* p = outq(C) + (size_t)row * DM; const bf16* xr = (const bf16*)(wsq(C) + WS_XR) + (size_t)row * DM;
#pragma unroll
        for (int j = 0; j < 4; ++j) { const int col = 256 * j + 4 * lane; const u32x2 r = *(const u32x2*)(xr + col);
            *(f32x4*)(p + col) = (f32x4){bflo(r.x), bfhi(r.x), bflo(r.y), bfhi(r.y)} * rs * *(const f32x4*)(gam + col); }
    }
}

__device__ __forceinline__ void gdn_prep_item(Ctx& C, int l, int b, int h, int n, unsigned* cnt) {
    int tid_ = threadIdx.x; asm volatile("" : "+v"(tid_)); const int tid = tid_, lane = tid & 63, wave = __builtin_amdgcn_readfirstlane(tid >> 6);
    LAS float* F32 = (LAS float*)(ldsq(C));
    LAS unsigned short* KH = (LAS unsigned short*)(ldsq(C) + 99328);
    LAS unsigned short* QH = (LAS unsigned short*)(ldsq(C) + 116736);
    LAS float* AM = (LAS float*)(ldsq(C) + 134144);
    LAS float* SC = (LAS float*)(ldsq(C) + 151552);
    const bf16* U = (const bf16*)(wsq(C) + WS_U);
    const int row0 = b * TSEQ + n * 64;
    const int idx = (b * 4 + h) * 32 + n;
#ifndef REP_STEPA
#define REP_STEPA 1
#endif
    for (int rpa_ = 0; rpa_ < REP_STEPA; ++rpa_)
    if (tid < 384) {
        const int cg = tid % 48, rs = tid / 48, which = cg >> 4, cc = (cg & 15) * 8;
        const int ucol = C_Q + which * 512 + h * 128 + cc, wcol = which * 512 + h * 128 + cc;
        const float* cw = inptr(I_GCW) + (size_t)l * 4 * 1536 + wcol;
        float w[4][8];
#pragma unroll
        for (int k = 0; k < 4; ++k) { const f32x4 a = *(const f32x4*)(cw + k * 1536), bq = *(const f32x4*)(cw + k * 1536 + 4);
            w[k][0] = a.x; w[k][1] = a.y; w[k][2] = a.z; w[k][3] = a.w; w[k][4] = bq.x; w[k][5] = bq.y; w[k][6] = bq.z; w[k][7] = bq.w; }
        const int t0 = 8 * rs;
        v4u rr[11];
#pragma unroll
        for (int k = 0; k < 11; ++k) { const int tg = n * 64 + t0 - 3 + k; rr[k] = *(const v4u*)(U + (size_t)(b * TSEQ + (tg < 0 ? 0 : tg)) * LDU + ucol); if (tg < 0) rr[k] = (v4u){0u, 0u, 0u, 0u}; }
        if (n == 31 && rs == 7) {
#pragma unroll
            for (int k = 0; k < 3; ++k) { float* gp = outq(C) + O_GCP + ((size_t)(l * NBP + b) * 3 + k) * 1536 + wcol; const v4u r = rr[8 + k];
                *(f32x4*)gp = (f32x4){bflo(r.x), bfhi(r.x), bflo(r.y), bfhi(r.y)}; *(f32x4*)(gp + 4) = (f32x4){bflo(r.z), bfhi(r.z), bflo(r.w), bfhi(r.w)}; }
        }
#pragma unroll
        for (int j = 0; j < 8; ++j) {
            LAS float* dst = F32 + (t0 + j) * 388 + cg * 8;
            float y[8];
#pragma unroll
            for (int i = 0; i < 8; ++i) y[i] = 0.f;
#pragma unroll
            for (int k = 0; k < 4; ++k) { const v4u r = rr[j + k];
                y[0] += w[k][0] * bflo(r.x); y[1] += w[k][1] * bfhi(r.x); y[2] += w[k][2] * bflo(r.y); y[3] += w[k][3] * bfhi(r.y);
                y[4] += w[k][4] * bflo(r.z); y[5] += w[k][5] * bfhi(r.z); y[6] += w[k][6] * bflo(r.w); y[7] += w[k][7] * bfhi(r.w); }
#pragma unroll
            for (int i = 0; i < 8; ++i) dst[i] = siluf(y[i]);
        }
    }
    __syncthreads();
    {
        const int p = tid >> 2, sub = tid & 3, t = p & 63, which = p >> 6;
        const LAS f32x4* src = (const LAS f32x4*)(F32 + t * 388 + which * 128 + sub * 32);
        float s = 0.f;
#pragma unroll
        for (int i = 0; i < 8; ++i) { const f32x4 v = src[i]; s += (v.x * v.x + v.y * v.y) + (v.z * v.z + v.w * v.w); }
        s += __builtin_bit_cast(float, __builtin_amdgcn_update_dpp(0, __builtin_bit_cast(int, s), 0xB1, 0xF, 0xF, true));
        s += __builtin_bit_cast(float, __builtin_amdgcn_update_dpp(0, __builtin_bit_cast(int, s), 0x4E, 0xF, 0xF, true));
        if (sub == 0) SC[which * 64 + t] = rsqrtf(s + EPS) * (which == 0 ? 0.08838834764831845f : 1.f);
    }
    if (wave == 0) {
        const int t = lane; const bf16* ur = U + (size_t)(row0 + t) * LDU;
        const float ga = bf2f(ur[C_GA + h]), gb = bf2f(ur[C_GB + h]);
        const float g = -__expf(inptr(I_GALOG)[l * 4 + h]) * softplusf(ga + inptr(I_GDTB)[l * 4 + h]);
        float cs = g;
#pragma unroll
        for (int o = 1; o < 64; o <<= 1) { const float v = __shfl_up(cs, o); if (lane >= o) cs += v; }
        SC[128 + t] = sigm(gb); SC[192 + t] = cs; SC[256 + t] = __expf(cs);
    }
    __syncthreads();
    {
        const int t = tid >> 3, cs = (tid & 7) * 16; const float rq = SC[t], rk = SC[64 + t];
        LAS f32x4* qrow = (LAS f32x4*)(F32 + t * 388 + cs); LAS f32x4* krow = (LAS f32x4*)(F32 + t * 388 + 128 + cs);
        f32x4 q4[4], k4[4];
#pragma unroll
        for (int i = 0; i < 4; ++i) { q4[i] = qrow[i] * rq; k4[i] = krow[i] * rk; qrow[i] = q4[i]; krow[i] = k4[i]; }
        *(LAS bf16x8*)(QH + t * 136 + cs) = pack8(q4[0], q4[1]); *(LAS bf16x8*)(QH + t * 136 + cs + 8) = pack8(q4[2], q4[3]);
        *(LAS bf16x8*)(KH + t * 136 + cs) = pack8(k4[0], k4[1]); *(LAS bf16x8*)(KH + t * 136 + cs + 8) = pack8(k4[2], k4[3]);
    }
    __syncthreads();
    {
        const int g = lane >> 4, c = lane & 15;
        LAS unsigned short* ATL = (LAS unsigned short*)(ldsq(C) + 152832);
        for (int job = wave; job < 26; job += 8) {
            int which, mt, nt;
            if (job < 16) { which = 1; mt = job >> 2; nt = job & 3; }
            else { const int k = job - 16; which = 0; mt = (k >= 6) ? 3 : (k >= 3) ? 2 : (k >= 1) ? 1 : 0; nt = k - (mt * (mt + 1)) / 2; }
            f32x4 acc = (f32x4){0.f, 0.f, 0.f, 0.f};
            if (mt >= nt) {
                const LAS unsigned short* ap = (which ? QH : KH) + (16 * mt + c) * 136 + 8 * g;
                const LAS unsigned short* bp = KH + (16 * nt + c) * 136 + 8 * g;
#pragma unroll
                for (int s = 0; s < 4; ++s) acc = mfma16(*(const LAS bf16x8*)(ap + 32 * s), *(const LAS bf16x8*)(bp + 32 * s), acc);
            }
            const int sidx = 16 * nt + c; const float gcs = SC[192 + sidx];
#pragma unroll
            for (int r = 0; r < 4; ++r) {
                const int t = 16 * mt + 4 * g + r; const float dec = __expf(SC[192 + t] - gcs);
                if (which == 0) AM[t * 68 + (sidx & 1) * 32 + (sidx >> 1)] = (sidx < t) ? SC[128 + t] * acc[r] * dec : 0.f;
                else ATL[t * 72 + (sidx & 32) + permpos(sidx & 31)] = f2bfs((sidx <= t) ? acc[r] * dec : 0.f);
            }
        }
    }
    __syncthreads();
#ifndef REP_SOLVE
#define REP_SOLVE 1
#endif
    for (int rps_ = 0; rps_ < REP_SOLVE; ++rps_)
    {
        const int c = tid >> 1, half = tid & 1; const bool isv = c < 128; const int fcol = isv ? 256 + c : c;
        float mine[32];
#pragma unroll
        for (int i = 0; i < 32; ++i) mine[i] = 0.f;
        f32x4 ar[2][8]; float rh[2], rb[2], re[2];
        ar[0][0] = *(const LAS f32x4*)(AM + half * 32); rh[0] = F32[fcol]; rb[0] = SC[128]; re[0] = SC[256];
#pragma unroll
        for (int i = 0; i < 64; ++i) {
            const int cur = i & 1, nxt = cur ^ 1;
            if (i + 1 < 64) {
                const int njn = (i + 2) >> 1;
#pragma unroll
                for (int q = 0; q * 4 < njn; ++q) ar[nxt][q] = *(const LAS f32x4*)(AM + (i + 1) * 68 + half * 32 + 4 * q);
                rh[nxt] = F32[(i + 1) * 388 + fcol]; rb[nxt] = SC[128 + i + 1]; re[nxt] = SC[256 + i + 1];
            }
            float rhs = rh[cur] * rb[cur]; if (!isv) rhs *= re[cur];
            float p0 = 0.f, p1 = 0.f, p2 = 0.f, p3 = 0.f;
            const int nj = (i + 1) >> 1;
#pragma unroll
            for (int q = 0; q * 4 < nj; ++q) {
                const f32x4 a = ar[cur][q];
                p0 += a.x * mine[4 * q]; if (4 * q + 1 < nj) p1 += a.y * mine[4 * q + 1]; if (4 * q + 2 < nj) p2 += a.z * mine[4 * q + 2]; if (4 * q + 3 < nj) p3 += a.w * mine[4 * q + 3];
            }
            const float part = (p0 + p1) + (p2 + p3);
            const float tot = part + __builtin_bit_cast(float, __builtin_amdgcn_update_dpp(0, __builtin_bit_cast(int, part), 0xB1, 0xF, 0xF, true));
            const float sol = rhs - tot;
            mine[i >> 1] = ((i & 1) == half) ? sol : mine[i >> 1];
        }
        const int d = c - 128; const int dpos = (d & ~31) + permpos(d & 31);
#pragma unroll
        for (int jj = 0; jj < 32; ++jj) { const int t = 2 * jj + half; if (isv) QH[t * 136 + c] = f2bfs(mine[jj]); else KH[t * 136 + dpos] = f2bfs(-mine[jj]); }
    }
    {
        const int t = tid >> 3, ds = (tid & 7) * 16; const float e = SC[256 + t];
        bf16* QT = (bf16*)(wsq(C) + WS_PQ) + (size_t)idx * 8192 + t * 128;
#pragma unroll
        for (int gq = 0; gq < 4; ++gq) { const f32x4 v = *(const LAS f32x4*)(F32 + t * 388 + ds + 4 * gq) * e;
            u32x2 w; w.x = pk2(v.x, v.y); w.y = pk2(v.z, v.w); st8_wt(QT + (ds & ~31) + 8 * gq + 4 * ((ds >> 4) & 1), w); }
    }
    {
        const int d = tid & 127, tq = tid >> 7; const float gl = SC[192 + 63];
        float kv[4][4];
#pragma unroll
        for (int gq = 0; gq < 4; ++gq)
#pragma unroll
            for (int i = 0; i < 4; ++i) { const int t = 16 * tq + 4 * gq + i; kv[gq][i] = F32[t * 388 + 128 + d] * __expf(gl - SC[192 + t]); }
        if (tid == 0) st4_wt((float*)(wsq(C) + WS_EGL) + idx, __expf(gl));
        __syncthreads();
        LAS unsigned short* KTL = (LAS unsigned short*)(ldsq(C) + 134144) + d * 64;
#pragma unroll
        for (int gq = 0; gq < 4; ++gq) { u32x2 w; w.x = pk2(kv[gq][0], kv[gq][1]); w.y = pk2(kv[gq][2], kv[gq][3]); *(LAS u32x2*)(KTL + ((16 * tq) & ~31) + 8 * gq + 4 * (tq & 1)) = w; }
    }
    __syncthreads();
    {
        unsigned char* wsb = wsq(C);
        const size_t pu = WS_PU + (size_t)idx * 16384, pw = WS_PW + (size_t)idx * 16384, pk = WS_PK + (size_t)idx * 16384, pa = WS_PA + (size_t)idx * 8192;
        LAS unsigned char* L = ldsq(C);
#pragma unroll
        for (int k = 0; k < 2; ++k) { const int e = tid + 512 * k, r = e >> 4, q = e & 15;
            st16_wt(wsb, pu + e * 16, *(const LAS v4u*)(L + 116736 + r * 272 + q * 16));
            st16_wt(wsb, pw + e * 16, *(const LAS v4u*)(L + 99328 + r * 272 + q * 16));
            st16_wt(wsb, pk + e * 16, *(const LAS v4u*)(L + 134144 + e * 16)); }
        { const int r = tid >> 3, q = tid & 7; st16_wt(wsb, pa + tid * 16, *(const LAS v4u*)(L + 152832 + r * 144 + q * 16)); }
    }
    publish_add(cnt);
}

constexpr int GC_NW = 0, GC_QT = 16384, GC_KT = 32768, GC_AT = 49152, GC_UT = 57344, GC_BUF = 73728, GC_PART = 147456;
__device__ __forceinline__ void gdn_chain_issue(LAS unsigned char* lds, const unsigned char* ws, int idx, int buf, int tid, int wave) {
    LAS unsigned char* base = lds + buf * GC_BUF;
    const unsigned char* nw = ws + WS_PW + (size_t)idx * 16384; const unsigned char* qt = ws + WS_PQ + (size_t)idx * 16384;
    const unsigned char* kt = ws + WS_PK + (size_t)idx * 16384; const unsigned char* at = ws + WS_PA + (size_t)idx * 8192; const unsigned char* ut = ws + WS_PU + (size_t)idx * 16384;
#pragma unroll
    for (int i = 0; i < 2; ++i) {
        const int L = tid + 512 * i; const int wb = (i * 512 + wave * 64) * 16;
        { const int r = L >> 4, ps = L & 15, q = ps ^ (r & 15); glds16(nw + r * 256 + q * 16, base + GC_NW + wb); glds16(qt + r * 256 + q * 16, base + GC_QT + wb); }
        glds16(ut + L * 16, base + GC_UT + wb);
        { const int r = L >> 3, ps = L & 7, q = ps ^ ((r >> 1) & 7); glds16(kt + r * 128 + q * 16, base + GC_KT + wb); }
    }
    { const int L = tid; const int r = L >> 3, ps = L & 7, q = ps ^ ((r >> 1) & 7); glds16(at + r * 128 + q * 16, base + GC_AT + wave * 1024); }
}
template <int PART>
__device__ __forceinline__ void gdn_chain_issue_part(LAS unsigned char* lds, const unsigned char* ws, int idx, int buf, int tid, int wave) {
    LAS unsigned char* base = lds + buf * GC_BUF;
#pragma unroll
    for (int i = 0; i < 2; ++i) {
        const int L = tid + 512 * i; const int wb = (i * 512 + wave * 64) * 16;
        if (PART == 0) { const int r = L >> 4, ps = L & 15, q = ps ^ (r & 15); glds16(ws + WS_PW + (size_t)idx * 16384 + r * 256 + q * 16, base + GC_NW + wb); }
        if (PART == 1) { const int r = L >> 4, ps = L & 15, q = ps ^ (r & 15); glds16(ws + WS_PQ + (size_t)idx * 16384 + r * 256 + q * 16, base + GC_QT + wb); }
        if (PART == 2) glds16(ws + WS_PU + (size_t)idx * 16384 + L * 16, base + GC_UT + wb);
        if (PART == 3) { const int r = L >> 3, ps = L & 7, q = ps ^ ((r >> 1) & 7); glds16(ws + WS_PK + (size_t)idx * 16384 + r * 128 + q * 16, base + GC_KT + wb); }
    }
    if (PART == 2) { const int L = tid; const int r = L >> 3, ps = L & 7, q = ps ^ ((r >> 1) & 7); glds16(ws + WS_PA + (size_t)idx * 8192 + r * 128 + q * 16, base + GC_AT + wave * 1024); }
}
__device__ __forceinline__ void gdn_chain(Ctx& C, int l, int b, int h) {
    int tid_ = threadIdx.x; asm volatile("" : "+v"(tid_)); const int tid = tid_, lane = tid & 63, w = __builtin_amdgcn_readfirstlane(tid >> 6), g = lane >> 4, c = lane & 15, e0 = 16 * w;
    LAS unsigned char* lds = ldsq(C);
    const bf16* U = (const bf16*)(wsq(C) + WS_U); bf16* O = (bf16*)(wsq(C) + WS_O);
    const float* egl_p = (const float*)(wsq(C) + WS_EGL);
    const int idx0 = (b * 4 + h) * 32;
    const float gnorm = inptr(I_GNORM)[l * 128 + e0 + c];
    f32x4 S[8];
#pragma unroll
    for (int i = 0; i < 8; ++i) S[i] = (f32x4){0.f, 0.f, 0.f, 0.f};
    const bf16* gzp = U + (size_t)(b * TSEQ + lane) * LDU + C_GZ + h * 128 + e0;
    bf16* orow = O + (size_t)(b * TSEQ + lane) * DM + 256 + h * 128 + e0;
    v4u gz0 = (v4u){0u, 0u, 0u, 0u}, gz1 = gz0;
    f32x4 op[4];
#pragma unroll
    for (int i = 0; i < 4; ++i) op[i] = (f32x4){0.f, 0.f, 0.f, 0.f};
    const int xa = c * 256 + (((c & 12) + (g ^ (c & 3))) << 4);
    const int m3 = (c >> 1) & 7;
    const int xk = c * 128 + (((m3 & 4) + (g ^ (m3 & 3))) << 4);
    unsigned* gcnt = (unsigned*)((gu32*)(wsq(C) + WS_CTL) + CW_GCNT + l * 32 * 64);
    if (tid == 0) { poll_acquire(gcnt, 32u); poll_acquire(gcnt + 64, 32u); }
    __syncthreads();
    gdn_chain_issue(lds, wsq(C), idx0, 0, tid, w);
    float egl = egl_p[idx0];
    asm volatile("s_waitcnt vmcnt(0)" ::: "memory");
    __syncthreads();
    for (int n = 0; n <= 32; ++n) {
        asm volatile("; GDNCHAIN_STEP_BEGIN");
        const int buf = n & 1;
        LAS unsigned char* B = lds + buf * GC_BUF;
        LAS unsigned short* SL = (LAS unsigned short*)(B + GC_UT) + e0;
        bf16x8 fa[16];
        f32x4 vn[4], o[4];
        v4u gn0 = gz0, gn1 = gz1; float egln = 0.f;
        RB(5);
        if (n < 32) {
#pragma unroll
            for (int mt = 0; mt < 4; ++mt) {
                const LAS unsigned short* up = SL + (16 * mt + 4 * g) * 128 + c;
                vn[mt] = (f32x4){bf2f(up[0]), bf2f(up[128]), bf2f(up[256]), bf2f(up[384])}; o[mt] = (f32x4){0.f, 0.f, 0.f, 0.f};
            }
            { const bf16* gp = gzp + (size_t)n * 64 * LDU; gn0 = *(const v4u*)gp; gn1 = *(const v4u*)(gp + 8); }
            if (n + 1 < 32) egln = egl_p[idx0 + n + 1];
            if (n + 1 < 32) gdn_chain_issue_part<0>(lds, wsq(C), idx0 + n + 1, buf ^ 1, tid, w);
            if (n + 1 < 32) gdn_chain_issue_part<1>(lds, wsq(C), idx0 + n + 1, buf ^ 1, tid, w);
        }
        if (n > 0) {
            asm volatile("s_waitcnt lgkmcnt(0)" ::: "memory");
            const LAS float* PART = (const LAS float*)(lds + GC_PART + (buf ^ 1) * 2048);
            *(LAS v4u*)(SL + lane * 128) = gz0; *(LAS v4u*)(SL + lane * 128 + 8) = gz1;
            unsigned short gzv[4][4];
#pragma unroll
            for (int mt = 0; mt < 4; ++mt)
#pragma unroll
                for (int r = 0; r < 4; ++r) gzv[mt][r] = SL[(16 * mt + 4 * g + r) * 128 + c];
#pragma unroll
            for (int mt = 0; mt < 4; ++mt) {
                f32x4 pr[4][2];
#pragma unroll
                for (int r = 0; r < 4; ++r) { const int t = 16 * mt + 4 * g + r; pr[r][0] = *(const LAS f32x4*)(PART + t * 8); pr[r][1] = *(const LAS f32x4*)(PART + t * 8 + 4); }
                __builtin_amdgcn_sched_barrier(0);
#pragma unroll
                for (int r = 0; r < 4; ++r) {
                    const f32x4 p0 = pr[r][0], p1 = pr[r][1];
                    const float tot = ((p0.x + p0.y) + (p0.z + p0.w)) + ((p1.x + p1.y) + (p1.z + p1.w));
                    const float rs = __builtin_amdgcn_rsqf(tot * (1.f / 128.f) + EPS);
                    SL[(16 * mt + 4 * g + r) * 128 + c] = f2bfs(op[mt][r] * rs * gnorm * siluf(bf2f(gzv[mt][r])));
                }
            }
            const v4u ov0 = *(const LAS v4u*)(SL + lane * 128), ov1 = *(const LAS v4u*)(SL + lane * 128 + 8);
            bf16* od = orow + (size_t)(n - 1) * 64 * DM; *(v4u*)od = ov0; *(v4u*)(od + 8) = ov1;
        }
        RE(5);
        if (n < 32) {
            RB(6);
            __builtin_amdgcn_sched_barrier(0);
#pragma unroll
            for (int mt = 0; mt < 4; ++mt)
#pragma unroll
                for (int s = 0; s < 4; ++s) fa[mt * 4 + s] = *(const LAS bf16x8*)(B + GC_NW + mt * 4096 + (xa ^ (s << 6)));
            bf16x8 Sb[4];
#pragma unroll
            for (int s = 0; s < 4; ++s) Sb[s] = pack8(S[2 * s], S[2 * s + 1]);
            __builtin_amdgcn_sched_barrier(0);
#pragma unroll
            for (int s = 0; s < 4; ++s)
#pragma unroll
                for (int mt = 0; mt < 4; ++mt) vn[mt] = mfma16(fa[mt * 4 + s], Sb[s], vn[mt]);
            if (n + 1 < 32) gdn_chain_issue_part<2>(lds, wsq(C), idx0 + n + 1, buf ^ 1, tid, w);
            __builtin_amdgcn_sched_barrier(0);
            RE(6); RB(7);
#pragma unroll
            for (int mt = 0; mt < 4; ++mt)
#pragma unroll
                for (int s = 0; s < 4; ++s) fa[mt * 4 + s] = *(const LAS bf16x8*)(B + GC_QT + mt * 4096 + (xa ^ (s << 6)));
            __builtin_amdgcn_sched_barrier(0);
#pragma unroll
            for (int s = 0; s < 4; ++s)
#pragma unroll
                for (int mt = 0; mt < 4; ++mt) o[mt] = mfma16(fa[mt * 4 + s], Sb[s], o[mt]);
            if (n + 1 < 32) gdn_chain_issue_part<3>(lds, wsq(C), idx0 + n + 1, buf ^ 1, tid, w);
            bf16x8 vb[2];
            vb[0] = pack8(vn[0], vn[1]); vb[1] = pack8(vn[2], vn[3]);
            __builtin_amdgcn_sched_barrier(0);
            RE(7); RB(8);
#pragma unroll
            for (int mt = 0; mt < 4; ++mt)
#pragma unroll
                for (int s = 0; s < 2; ++s) { fa[mt * 2 + s] = *(const LAS bf16x8*)(B + GC_AT + mt * 2048 + (xk ^ (s << 6))); fa[8 + mt * 2 + s] = *(const LAS bf16x8*)(B + GC_KT + mt * 2048 + (xk ^ (s << 6))); }
#pragma unroll
            for (int i = 0; i < 8; ++i) S[i] = S[i] * egl;
            __builtin_amdgcn_sched_barrier(0);
#pragma unroll
            for (int s = 0; s < 2; ++s)
#pragma unroll
                for (int mt = 0; mt < 4; ++mt) { o[mt] = mfma16(fa[mt * 2 + s], vb[s], o[mt]); S[mt] = mfma16(fa[8 + mt * 2 + s], vb[s], S[mt]); }
            __builtin_amdgcn_sched_barrier(0);
            RE(8); RB(9);
#pragma unroll
            for (int md = 0; md < 4; ++md)
#pragma unroll
                for (int s = 0; s < 2; ++s) fa[md * 2 + s] = *(const LAS bf16x8*)(B + GC_KT + (4 + md) * 2048 + (xk ^ (s << 6)));
            __builtin_amdgcn_sched_barrier(0);
#pragma unroll
            for (int s = 0; s < 2; ++s)
#pragma unroll
                for (int md = 0; md < 4; ++md) S[4 + md] = mfma16(fa[md * 2 + s], vb[s], S[4 + md]);
            LAS float* PARTW = (LAS float*)(lds + GC_PART + buf * 2048);
#pragma unroll
            for (int mt = 0; mt < 4; ++mt)
#pragma unroll
                for (int r = 0; r < 4; ++r) {
                    const float ss = dpp_sum16(o[mt][r] * o[mt][r]);
                    if (c == 4 * mt + r) PARTW[(16 * mt + 4 * g + r) * 8 + w] = ss;
                }
#pragma unroll
            for (int mt = 0; mt < 4; ++mt) op[mt] = o[mt];
            gz0 = gn0; gz1 = gn1; egl = egln;
            RE(9); RB(10);
            asm volatile("; GDNCHAIN_STEP_END");
            if (tid == 0 && n + 2 < 32) poll_acquire(gcnt + 64 * (n + 2), 32u);
            asm volatile("s_waitcnt vmcnt(0)" ::: "memory");
            __syncthreads();
            RE(10);
        }
    }
    float* sp = outq(C) + O_GDNP + (size_t)((l * NBP + b) * 4 + h) * 128 * 128;
#pragma unroll
    for (int i = 0; i < 8; ++i)
#pragma unroll
        for (int r = 0; r < 4; ++r) sp[(size_t)(16 * i + 4 * g + r) * 128 + e0 + c] = S[i][r];
    __syncthreads();
}

constexpr int HC_QM = 0, HC_KM = 9216, HC_QE = 18432, HC_VT = 27648, HC_KLT = 36864, HC_BUF = 46080, HC_SEG = 92160, HC_GLS = 94208, HC_PART = 94720;
__device__ __forceinline__ void hgrn_chain(Ctx& C, int l, int b, int h) {
    int tid_ = threadIdx.x; asm volatile("" : "+v"(tid_)); const int tid = tid_, lane = tid & 63, w = __builtin_amdgcn_readfirstlane(tid >> 6), g = lane >> 4, c = lane & 15, d = lane, ts = w;
    LAS unsigned char* lds = ldsq(C);
    const bf16* U = (const bf16*)(wsq(C) + WS_U); bf16* O = (bf16*)(wsq(C) + WS_O);
    float lb = 0.f;
    if (l == 1) { const float b0 = inptr(I_HGLB)[h * 64 + d], b1 = inptr(I_HGLB)[256 + h * 64 + d]; lb = __builtin_amdgcn_rcpf(1.f + __expf(b0 - b1)); }
    const float oml = 1.f - lb;
    const int nt = w >> 1, ep = w & 1;
    f32x4 S[4][2];
#pragma unroll
    for (int i = 0; i < 4; ++i) { S[i][0] = (f32x4){0.f, 0.f, 0.f, 0.f}; S[i][1] = (f32x4){0.f, 0.f, 0.f, 0.f}; }
    float hgn[2][4];
#pragma unroll
    for (int mi = 0; mi < 2; ++mi)
#pragma unroll
        for (int r = 0; r < 4; ++r) hgn[mi][r] = inptr(I_HGN)[l * 64 + 16 * (2 * ep + mi) + 4 * g + r];
    LAS float* SEG = (LAS float*)(lds + HC_SEG);
    unsigned short rq[8], rf[8], ri[8];
    {
        const bf16* up = U + (size_t)(b * TSEQ + 8 * ts) * LDU + h * 64 + d;
#pragma unroll
        for (int j = 0; j < 8; ++j) { rq[j] = up[(size_t)j * LDU + C_HQ]; rf[j] = up[(size_t)j * LDU + C_HF]; ri[j] = up[(size_t)j * LDU + C_HI]; }
    }
    for (int n = 0; n < 32; ++n) {
        const int buf = n & 1; const int row0 = b * TSEQ + n * 64;
        float q[8], kk[8], cs[8], v[8];
        float run = 0.f;
#pragma unroll
        for (int j = 0; j < 8; ++j) {
            const float z = bf2f(rf[j]); const float ez = __expf(-z); const float sg = __builtin_amdgcn_rcpf(1.f + ez);
            const float f = lb + oml * sg; run += __logf(f); cs[j] = run;
            kk[j] = oml * (1.f - sg);
            q[j] = siluf(bf2f(rq[j])); v[j] = bf2f(ri[j]);
        }
        SEG[ts * 64 + d] = run;
        u32x2 hz[2];
#pragma unroll
        for (int mi = 0; mi < 2; ++mi) hz[mi] = *(const u32x2*)(U + (size_t)(row0 + 16 * nt + c) * LDU + C_HZ + h * 64 + 16 * (2 * ep + mi) + 4 * g);
        if (n + 1 < 32) {
            const bf16* up = U + (size_t)(row0 + 64 + 8 * ts) * LDU + h * 64 + d;
#pragma unroll
            for (int j = 0; j < 8; ++j) { rq[j] = up[(size_t)j * LDU + C_HQ]; rf[j] = up[(size_t)j * LDU + C_HF]; ri[j] = up[(size_t)j * LDU + C_HI]; }
        }
        __syncthreads();
        float base = 0.f, gmid = 0.f, gl = 0.f;
#pragma unroll
        for (int k = 0; k < 8; ++k) { const float sv = SEG[k * 64 + d]; if (k < ts) base += sv; if (k < 4) gmid += sv; gl += sv; }
        LAS unsigned short* T = (LAS unsigned short*)(lds + buf * HC_BUF);
        {
            const int dpos = (d & ~31) + permpos(d & 31);
            float klv[8];
#pragma unroll
            for (int j = 0; j < 8; ++j) {
                const int t = 8 * ts + j; const float G = base + cs[j];
                const float e1 = fminf(fmaxf(G - gmid, -80.f), 80.f);
                T[HC_QM / 2 + t * 72 + d] = f2bfs(q[j] * __expf(e1));
                T[HC_KM / 2 + t * 72 + d] = f2bfs(kk[j] * __expf(-e1));
                T[HC_QE / 2 + t * 72 + dpos] = f2bfs(q[j] * __expf(G));
                klv[j] = kk[j] * __expf(gl - G);
            }
            const int p0 = 32 * (ts >> 2) + 16 * (ts & 1) + 4 * ((ts >> 1) & 1);
            u32x2 wv0, wv1, wk0, wk1;
            wv0.x = pk2(v[0], v[1]); wv0.y = pk2(v[2], v[3]); wv1.x = pk2(v[4], v[5]); wv1.y = pk2(v[6], v[7]);
            wk0.x = pk2(klv[0], klv[1]); wk0.y = pk2(klv[2], klv[3]); wk1.x = pk2(klv[4], klv[5]); wk1.y = pk2(klv[6], klv[7]);
            *(LAS u32x2*)(T + HC_VT / 2 + d * 72 + p0) = wv0; *(LAS u32x2*)(T + HC_VT / 2 + d * 72 + p0 + 8) = wv1;
            *(LAS u32x2*)(T + HC_KLT / 2 + d * 72 + p0) = wk0; *(LAS u32x2*)(T + HC_KLT / 2 + d * 72 + p0 + 8) = wk1;
            if (ts == 0) ((LAS float*)(lds + HC_GLS))[buf * 64 + d] = gl;
        }
        __syncthreads();
        f32x4 at[4];
#pragma unroll
        for (int ms = 0; ms < 4; ++ms) {
            at[ms] = (f32x4){0.f, 0.f, 0.f, 0.f};
            if (ms <= nt) {
#pragma unroll
                for (int s = 0; s < 2; ++s)
                    at[ms] = mfma16(*(const LAS bf16x8*)(T + HC_KM / 2 + (16 * ms + c) * 72 + 32 * s + 8 * g), *(const LAS bf16x8*)(T + HC_QM / 2 + (16 * nt + c) * 72 + 32 * s + 8 * g), at[ms]);
                if (ms == nt) {
#pragma unroll
                    for (int r = 0; r < 4; ++r) at[ms][r] = (4 * g + r <= c) ? at[ms][r] : 0.f;
                }
            }
        }
        bf16x8 atb[2]; atb[0] = pack8(at[0], at[1]); atb[1] = pack8(at[2], at[3]);
        f32x4 oT[2];
#pragma unroll
        for (int mi = 0; mi < 2; ++mi) {
            const int me = 2 * ep + mi; f32x4 acc = (f32x4){0.f, 0.f, 0.f, 0.f};
#pragma unroll
            for (int s = 0; s < 2; ++s)
                acc = mfma16(pack8(S[2 * s][mi], S[2 * s + 1][mi]), *(const LAS bf16x8*)(T + HC_QE / 2 + (16 * nt + c) * 72 + 32 * s + 8 * g), acc);
#pragma unroll
            for (int s = 0; s < 2; ++s)
                acc = mfma16(*(const LAS bf16x8*)(T + HC_VT / 2 + (16 * me + c) * 72 + 32 * s + 8 * g), atb[s], acc);
            oT[mi] = acc;
        }
        {
            const LAS float* GLS = (const LAS float*)(lds + HC_GLS) + buf * 64;
#pragma unroll
            for (int md = 0; md < 4; ++md) {
                const f32x4 lg = *(const LAS f32x4*)(GLS + 16 * md + 4 * g);
                const f32x4 lam = (f32x4){__expf(lg.x), __expf(lg.y), __expf(lg.z), __expf(lg.w)};
#pragma unroll
                for (int mi = 0; mi < 2; ++mi) {
                    const int me = 2 * ep + mi; f32x4 acc = S[md][mi] * lam;
#pragma unroll
                    for (int s = 0; s < 2; ++s)
                        acc = mfma16(*(const LAS bf16x8*)(T + HC_KLT / 2 + (16 * md + c) * 72 + 32 * s + 8 * g), *(const LAS bf16x8*)(T + HC_VT / 2 + (16 * me + c) * 72 + 32 * s + 8 * g), acc);
                    S[md][mi] = acc;
                }
            }
        }
        LAS float* PART = (LAS float*)(lds + HC_PART) + buf * 128;
        float ss = 0.f;
#pragma unroll
        for (int mi = 0; mi < 2; ++mi)
#pragma unroll
            for (int r = 0; r < 4; ++r) ss += oT[mi][r] * oT[mi][r];
        ss += __shfl_xor(ss, 16); ss += __shfl_xor(ss, 32);
        if (g == 0) PART[(16 * nt + c) * 2 + ep] = ss;
        __syncthreads();
        const float tot = PART[(16 * nt + c) * 2] + PART[(16 * nt + c) * 2 + 1];
        const float rs = rsqrtf(tot * (1.f / 64.f) + EPS);
#pragma unroll
        for (int mi = 0; mi < 2; ++mi) {
            const float z0 = bflo(hz[mi].x), z1 = bfhi(hz[mi].x), z2 = bflo(hz[mi].y), z3 = bfhi(hz[mi].y);
            u32x2 wv; wv.x = pk2(oT[mi][0] * rs * hgn[mi][0] * siluf(z0), oT[mi][1] * rs * hgn[mi][1] * siluf(z1));
            wv.y = pk2(oT[mi][2] * rs * hgn[mi][2] * siluf(z2), oT[mi][3] * rs * hgn[mi][3] * siluf(z3));
            *(u32x2*)(O + (size_t)(row0 + 16 * nt + c) * DM + h * 64 + 16 * (2 * ep + mi) + 4 * g) = wv;
        }
    }
    if (nt == 0) {
        float* sp = outq(C) + O_HGP + (size_t)((l * NBP + b) * 4 + h) * 64 * 64;
#pragma unroll
        for (int md = 0; md < 4; ++md)
#pragma unroll
            for (int mi = 0; mi < 2; ++mi)
#pragma unroll
                for (int r = 0; r < 4; ++r) sp[(size_t)(16 * md + 4 * g + r) * 64 + 16 * (2 * ep + mi) + c] = S[md][mi][r];
    }
    __syncthreads();
}

constexpr int L1_WT = 0, L1_XCB = 73728, L1_STA = 0, L1_STH = 32768;
__device__ __forceinline__ void lru_pass1_item(Ctx& C, int l, int b, int n, unsigned* cnt) {
    int tid_ = threadIdx.x; asm volatile("" : "+v"(tid_)); const int tid = tid_, lane = tid & 63, w = __builtin_amdgcn_readfirstlane(tid >> 6), g = lane >> 4, c = lane & 15;
    LAS unsigned char* lds = ldsq(C);
    const bf16* U = (const bf16*)(wsq(C) + WS_U); bf16* O = (bf16*)(wsq(C) + WS_O);
    LAS unsigned short* WT = (LAS unsigned short*)(lds + L1_WT);
    LAS unsigned short* XCB = (LAS unsigned short*)(lds + L1_XCB);
    const int row0 = b * TSEQ + n * 64;
    {
        const float* wa = inptr(I_LWA) + (size_t)l * 16384; const float* wx = inptr(I_LWX) + (size_t)l * 16384;
        for (int idx = tid; idx < 8192; idx += NTHR) {
            const int gate = idx >> 12, rem = idx & 4095, blk = rem >> 10, i = (rem >> 4) & 63, j4 = (rem & 15) * 4;
            const f32x4 v = *(const f32x4*)((gate ? wx : wa) + ((size_t)blk * 64 + i) * 64 + j4);
            LAS unsigned short* dst = WT + ((gate * 4 + blk) * 64 + j4) * 72 + i;
            dst[0] = f2bfs(v.x); dst[72] = f2bfs(v.y); dst[144] = f2bfs(v.z); dst[216] = f2bfs(v.w);
        }
    }
    {
        const int cg = tid & 31, rs = tid >> 5, ch0 = cg * 8, t0 = rs * 4;
        float cw[4][8], cb[8];
        const float* cwp = inptr(I_LCW) + (size_t)l * 4 * 256 + ch0; const float* cbp = inptr(I_LCB) + (size_t)l * 256 + ch0;
#pragma unroll
        for (int k = 0; k < 4; ++k) { const f32x4 a = *(const f32x4*)(cwp + k * 256), bq = *(const f32x4*)(cwp + k * 256 + 4);
            cw[k][0] = a.x; cw[k][1] = a.y; cw[k][2] = a.z; cw[k][3] = a.w; cw[k][4] = bq.x; cw[k][5] = bq.y; cw[k][6] = bq.z; cw[k][7] = bq.w; }
        { const f32x4 a = *(const f32x4*)cbp, bq = *(const f32x4*)(cbp + 4); cb[0] = a.x; cb[1] = a.y; cb[2] = a.z; cb[3] = a.w; cb[4] = bq.x; cb[5] = bq.y; cb[6] = bq.z; cb[7] = bq.w; }
        float x[7][8];
#pragma unroll
        for (int k = 0; k < 7; ++k) {
            const int tg = n * 64 + t0 - 3 + k;
            if (tg >= 0) { const v4u r = *(const v4u*)(U + (size_t)(b * TSEQ + tg) * LDU + C_LX + ch0);
                x[k][0] = bflo(r.x); x[k][1] = bfhi(r.x); x[k][2] = bflo(r.y); x[k][3] = bfhi(r.y); x[k][4] = bflo(r.z); x[k][5] = bfhi(r.z); x[k][6] = bflo(r.w); x[k][7] = bfhi(r.w);
                if (n == 31 && tg >= TSEQ - 3) { float* cp = outq(C) + O_LCP + ((size_t)(l * NBP + b) * 3 + (tg - (TSEQ - 3))) * 256 + ch0;
                    *(f32x4*)cp = (f32x4){x[k][0], x[k][1], x[k][2], x[k][3]}; *(f32x4*)(cp + 4) = (f32x4){x[k][4], x[k][5], x[k][6], x[k][7]}; }
            } else {
#pragma unroll
                for (int i = 0; i < 8; ++i) x[k][i] = 0.f; }
        }
#pragma unroll
        for (int j = 0; j < 4; ++j) {
            float y[8];
#pragma unroll
            for (int i = 0; i < 8; ++i) y[i] = cw[0][i] * x[j][i] + cw[1][i] * x[j + 1][i] + cw[2][i] * x[j + 2][i] + cw[3][i] * x[j + 3][i] + cb[i];
            v4u wv; wv.x = pk2(y[0], y[1]); wv.y = pk2(y[2], y[3]); wv.z = pk2(y[4], y[5]); wv.w = pk2(y[6], y[7]);
            *(LAS v4u*)(XCB + (t0 + j) * 264 + ch0) = wv;
            const v4u r = *(const v4u*)(U + (size_t)(row0 + t0 + j) * LDU + C_LZ + ch0);
            v4u gv; gv.x = pk2(gelu_tanh(bflo(r.x)), gelu_tanh(bfhi(r.x))); gv.y = pk2(gelu_tanh(bflo(r.y)), gelu_tanh(bfhi(r.y)));
            gv.z = pk2(gelu_tanh(bflo(r.z)), gelu_tanh(bfhi(r.z))); gv.w = pk2(gelu_tanh(bflo(r.w)), gelu_tanh(bfhi(r.w)));
            st16_wt(wsq(C), WS_O + ((size_t)(row0 + t0 + j) * DM + 768 + ch0) * 2, gv);
        }
    }
    __syncthreads();
    const int nb = w >> 1, njb = 2 * (w & 1);
    f32x4 pa[4][2], px[4][2];
    {
        bf16x8 fa[8], fb[8];
#pragma unroll
        for (int mt = 0; mt < 4; ++mt)
#pragma unroll
            for (int s = 0; s < 2; ++s) fa[mt * 2 + s] = *(const LAS bf16x8*)(XCB + (16 * mt + c) * 264 + 64 * nb + 32 * s + 8 * g);
#pragma unroll
        for (int gate = 0; gate < 2; ++gate)
#pragma unroll
            for (int q = 0; q < 2; ++q)
#pragma unroll
                for (int s = 0; s < 2; ++s) fb[(gate * 2 + q) * 2 + s] = *(const LAS bf16x8*)(WT + ((gate * 4 + nb) * 64 + 16 * (njb + q) + c) * 72 + 32 * s + 8 * g);
        __builtin_amdgcn_sched_barrier(0);
#pragma unroll
        for (int mt = 0; mt < 4; ++mt)
#pragma unroll
            for (int q = 0; q < 2; ++q) {
                f32x4 a = (f32x4){0.f, 0.f, 0.f, 0.f}, x = a;
#pragma unroll
                for (int s = 0; s < 2; ++s) { a = mfma16(fa[mt * 2 + s], fb[q * 2 + s], a); x = mfma16(fa[mt * 2 + s], fb[(2 + q) * 2 + s], x); }
                pa[mt][q] = a; px[mt][q] = x;
            }
    }
    unsigned short oa[2][4][4], oh[2][4][4];
    const float* bap = inptr(I_LBA) + l * 256; const float* bxp = inptr(I_LBX) + l * 256; const float* lamp = inptr(I_LLAM) + l * 256;
#pragma unroll
    for (int q = 0; q < 2; ++q) {
        const int ch = 64 * nb + 16 * (njb + q) + c;
        const float ba = bap[ch], bx = bxp[ch], sp = softplusf(-lamp[ch]);
        float pc = 1.f, hc = 0.f;
#pragma unroll
        for (int mt = 0; mt < 4; ++mt) {
            float a[4], bb[4];
#pragma unroll
            for (int r = 0; r < 4; ++r) {
                const float xcv = bf2f(XCB[(16 * mt + 4 * g + r) * 264 + ch]);
                const float rr = sigm(pa[mt][q][r] + ba), ii = sigm(px[mt][q][r] + bx);
                const float la = -8.f * rr * sp, x2 = 2.f * la;
                a[r] = __expf(la);
                const float om = -x2 * (1.f + x2 * (0.5f + x2 * (0.16666667f + x2 * (0.041666668f + x2 * 0.0083333338f))));
                bb[r] = sqrtf(fmaxf(om, 0.f)) * ii * xcv;
            }
            const float P = a[0] * a[1] * a[2] * a[3];
            const float H = ((bb[0] * a[1] + bb[1]) * a[2] + bb[2]) * a[3] + bb[3];
            float ps = pc, hs = hc, pstart = pc, hstart = hc;
#pragma unroll
            for (int k = 0; k < 4; ++k) {
                const float Pk = __shfl(P, c + 16 * k), Hk = __shfl(H, c + 16 * k);
                hs = Pk * hs + Hk; ps = Pk * ps;
                if (g == k + 1) { hstart = hs; pstart = ps; }
            }
            pc = ps; hc = hs;
            float pp = pstart, hh = hstart;
#pragma unroll
            for (int r = 0; r < 4; ++r) { pp = pp * a[r]; hh = a[r] * hh + bb[r]; oa[q][mt][r] = f2bfs(pp); oh[q][mt][r] = f2bfs(hh); }
        }
        if (g == 0) { float* sp_ = (float*)(wsq(C) + WS_LSUM) + ((size_t)(b * 32 + n) * 2) * 256 + ch; st4_wt(sp_, pc); st4_wt(sp_ + 256, hc); }
    }
    __syncthreads();
    {
        LAS unsigned short* STA = (LAS unsigned short*)(lds + L1_STA); LAS unsigned short* STH = (LAS unsigned short*)(lds + L1_STH);
#pragma unroll
        for (int q = 0; q < 2; ++q)
#pragma unroll
            for (int mt = 0; mt < 4; ++mt)
#pragma unroll
                for (int r = 0; r < 4; ++r) { const int off = (16 * mt + 4 * g + r) * 256 + 64 * nb + 16 * (njb + q) + c; STA[off] = oa[q][mt][r]; STH[off] = oh[q][mt][r]; }
    }
    __syncthreads();
    {
        unsigned char* wsb = wsq(C);
#pragma unroll
        for (int k = 0; k < 4; ++k) { const int e = (tid + 512 * k) * 8;
            st16_wt(wsb, WS_ACUM + ((size_t)row0 * 256 + e) * 2, *(const LAS v4u*)(lds + L1_STA + e * 2)); st16_wt(wsb, WS_HLOC + ((size_t)row0 * 256 + e) * 2, *(const LAS v4u*)(lds + L1_STH + e * 2)); }
    }
    publish_add(cnt);
}
__device__ __forceinline__ void lru_pass3_item(Ctx& C, int l, int b, int n) {
    int tid_ = threadIdx.x; asm volatile("" : "+v"(tid_)); const int tid = tid_;
    const int cg = tid & 31, rs = tid >> 5, ch0 = cg * 8, row0 = b * TSEQ + n * 64;
    const float* sum = (const float*)(wsq(C) + WS_LSUM) + (size_t)(b * 32) * 2 * 256 + ch0;
    float hin[8];
#pragma unroll
    for (int i = 0; i < 8; ++i) hin[i] = 0.f;
    for (int k = 0; k < n; ++k) {
        const f32x4 p0 = *(const f32x4*)(sum + (size_t)k * 512), p1 = *(const f32x4*)(sum + (size_t)k * 512 + 4), h0 = *(const f32x4*)(sum + (size_t)k * 512 + 256), h1 = *(const f32x4*)(sum + (size_t)k * 512 + 260);
        hin[0] = p0.x * hin[0] + h0.x; hin[1] = p0.y * hin[1] + h0.y; hin[2] = p0.z * hin[2] + h0.z; hin[3] = p0.w * hin[3] + h0.w;
        hin[4] = p1.x * hin[4] + h1.x; hin[5] = p1.y * hin[5] + h1.y; hin[6] = p1.z * hin[6] + h1.z; hin[7] = p1.w * hin[7] + h1.w;
    }
    const bf16* ga = (const bf16*)(wsq(C) + WS_ACUM); const bf16* gh = (const bf16*)(wsq(C) + WS_HLOC); bf16* O = (bf16*)(wsq(C) + WS_O);
#pragma unroll
    for (int j = 0; j < 4; ++j) {
        const int row = row0 + rs * 4 + j;
        const v4u a = *(const v4u*)(ga + (size_t)row * 256 + ch0), h = *(const v4u*)(gh + (size_t)row * 256 + ch0), gl = *(const v4u*)(O + (size_t)row * DM + 768 + ch0);
        v4u o;
        o.x = pk2((bflo(h.x) + bflo(a.x) * hin[0]) * bflo(gl.x), (bfhi(h.x) + bfhi(a.x) * hin[1]) * bfhi(gl.x));
        o.y = pk2((bflo(h.y) + bflo(a.y) * hin[2]) * bflo(gl.y), (bfhi(h.y) + bfhi(a.y) * hin[3]) * bfhi(gl.y));
        o.z = pk2((bflo(h.z) + bflo(a.z) * hin[4]) * bflo(gl.z), (bfhi(h.z) + bfhi(a.z) * hin[5]) * bfhi(gl.z));
        o.w = pk2((bflo(h.w) + bflo(a.w) * hin[6]) * bflo(gl.w), (bfhi(h.w) + bfhi(a.w) * hin[7]) * bfhi(gl.w));
        *(v4u*)(O + (size_t)row * DM + 768 + ch0) = o;
    }
    if (n == 31 && rs == 0) {
        const f32x4 p0 = *(const f32x4*)(sum + (size_t)31 * 512), p1 = *(const f32x4*)(sum + (size_t)31 * 512 + 4), h0 = *(const f32x4*)(sum + (size_t)31 * 512 + 256), h1 = *(const f32x4*)(sum + (size_t)31 * 512 + 260);
        float* lp = outq(C) + O_LRUP + (size_t)(l * NBP + b) * 256 + ch0;
        *(f32x4*)lp = (f32x4){p0.x * hin[0] + h0.x, p0.y * hin[1] + h0.y, p0.z * hin[2] + h0.z, p0.w * hin[3] + h0.w};
        *(f32x4*)(lp + 4) = (f32x4){p1.x * hin[4] + h1.x, p1.y * hin[5] + h1.y, p1.z * hin[6] + h1.z, p1.w * hin[7] + h1.w};
    }
}

__device__ __forceinline__ void gdn_dec_item(Ctx& C, int l, int seq, int h) {
    int tid_ = threadIdx.x; asm volatile("" : "+v"(tid_)); const int tid = tid_, lane = tid & 63, w = __builtin_amdgcn_readfirstlane(tid >> 6);
    LAS float* XQ = (LAS float*)(ldsq(C));
    LAS float* SCd = (LAS float*)(ldsq(C) + 6144);
    LAS float* RED = (LAS float*)(ldsq(C) + 6400);
    LAS float* SS = (LAS float*)(ldsq(C) + 6400 + 16384);
    const bf16* U = (const bf16*)(wsq(C) + WS_U); bf16* O = (bf16*)(wsq(C) + WS_O);
    const int row0 = MP + seq * 4;
    const int e = tid & 127, dq = tid >> 7;
    const size_t sbase = ((size_t)((l * NSQ + seq) * 4 + h) * 128 + dq * 32) * 128 + e;
    float S[32];
    { const float* sp_ = inptr(I_SGDN) + sbase;
#pragma unroll
      for (int i = 0; i < 32; ++i) S[i] = sp_[(size_t)i * 128]; }
    if (tid < 384) {
        const int which = tid >> 7, cc = tid & 127, ucol = C_Q + which * 512 + h * 128 + cc, wcol = which * 512 + h * 128 + cc;
        float xs[7], cw[4];
#pragma unroll
        for (int k = 0; k < 3; ++k) xs[k] = inptr(I_SGC)[((size_t)(l * NSQ + seq) * 3 + k) * 1536 + wcol];
#pragma unroll
        for (int t = 0; t < 4; ++t) xs[3 + t] = bf2f(U[(size_t)(row0 + t) * LDU + ucol]);
#pragma unroll
        for (int k = 0; k < 4; ++k) cw[k] = inptr(I_GCW)[(size_t)(l * 4 + k) * 1536 + wcol];
#pragma unroll
        for (int t = 0; t < 4; ++t) XQ[t * 384 + tid] = siluf(cw[0] * xs[t] + cw[1] * xs[t + 1] + cw[2] * xs[t + 2] + cw[3] * xs[t + 3]);
#pragma unroll
        for (int k = 0; k < 3; ++k) outq(C)[O_GCS + ((size_t)(l * NSQ + seq) * 3 + k) * 1536 + wcol] = xs[4 + k];
    }
    __syncthreads();
    {
        const int t = w & 3, which = w >> 2;
        const float a = XQ[t * 384 + which * 128 + lane], bq = XQ[t * 384 + which * 128 + 64 + lane];
        const float s = wave_sum(a * a + bq * bq);
        if (lane == 0) SCd[which * 4 + t] = rsqrtf(s + EPS) * (which == 0 ? 0.08838834764831845f : 1.f);
        if (tid < 4) {
            const bf16* ur = U + (size_t)(row0 + tid) * LDU;
            const float g = -__expf(inptr(I_GALOG)[l * 4 + h]) * softplusf(bf2f(ur[C_GA + h]) + inptr(I_GDTB)[l * 4 + h]);
            SCd[8 + tid] = __expf(g); SCd[12 + tid] = sigm(bf2f(ur[C_GB + h]));
        }
    }
    __syncthreads();
#pragma unroll
    for (int t = 0; t < 4; ++t) {
        const float a = SCd[8 + t], beta = SCd[12 + t], rk = SCd[4 + t], rq = SCd[t];
        const LAS float* kp = XQ + t * 384 + 128 + dq * 32; const LAS float* qp = XQ + t * 384 + dq * 32;
        float part = 0.f;
#pragma unroll
        for (int i = 0; i < 32; ++i) { S[i] *= a; part += kp[i] * S[i]; }
        RED[((t * 2 + 0) * 4 + dq) * 128 + e] = part * rk;
        __syncthreads();
        const float kS = (RED[((t * 2) * 4 + 0) * 128 + e] + RED[((t * 2) * 4 + 1) * 128 + e]) + (RED[((t * 2) * 4 + 2) * 128 + e] + RED[((t * 2) * 4 + 3) * 128 + e]);
        const float dv = beta * (XQ[t * 384 + 256 + e] - kS) * rk;
        float part2 = 0.f;
#pragma unroll
        for (int i = 0; i < 32; ++i) { S[i] += kp[i] * dv; part2 += qp[i] * S[i]; }
        RED[((t * 2 + 1) * 4 + dq) * 128 + e] = part2 * rq;
    }
    __syncthreads();
    {
        const int t = tid >> 7;
        const float o = (RED[((t * 2 + 1) * 4 + 0) * 128 + e] + RED[((t * 2 + 1) * 4 + 1) * 128 + e]) + (RED[((t * 2 + 1) * 4 + 2) * 128 + e] + RED[((t * 2 + 1) * 4 + 3) * 128 + e]);
        const float ss = wave_sum(o * o);
        if (lane == 0) SS[w] = ss;
        __syncthreads();
        const float rs = rsqrtf((SS[2 * t] + SS[2 * t + 1]) * (1.f / 128.f) + EPS);
        const float gz = bf2f(U[(size_t)(row0 + t) * LDU + C_GZ + h * 128 + e]);
        O[(size_t)(row0 + t) * DM + 256 + h * 128 + e] = f2bfs(o * rs * inptr(I_GNORM)[l * 128 + e] * siluf(gz));
    }
    { float* op_ = outq(C) + O_GDNS + sbase;
#pragma unroll
      for (int i = 0; i < 32; ++i) op_[(size_t)i * 128] = S[i]; }
    __syncthreads();
}
__device__ __forceinline__ void hl_dec_item(Ctx& C, int l, int seq) {
    int tid_ = threadIdx.x; asm volatile("" : "+v"(tid_)); const int tid = tid_, lane = tid & 63, wv_ = 0; (void)wv_;
    LAS float* QK = (LAS float*)(ldsq(C));
    LAS float* REDh = (LAS float*)(ldsq(C) + 16384);
    LAS float* XCs = (LAS float*)(ldsq(C) + 24576);
    const bf16* U = (const bf16*)(wsq(C) + WS_U); bf16* O = (bf16*)(wsq(C) + WS_O);
    const int row0 = MP + seq * 4;
    if (tid < 256) {
        const int ch = tid; float lb = 0.f;
        if (l == 1) { const float b0 = inptr(I_HGLB)[ch], b1 = inptr(I_HGLB)[256 + ch]; lb = __builtin_amdgcn_rcpf(1.f + __expf(b0 - b1)); }
        const float oml = 1.f - lb;
#pragma unroll
        for (int t = 0; t < 4; ++t) {
            const bf16* ur = U + (size_t)(row0 + t) * LDU;
            const float z = bf2f(ur[C_HF + ch]); const float sg = sigm(z);
            QK[t * 256 + ch] = siluf(bf2f(ur[C_HQ + ch])); QK[1024 + t * 256 + ch] = oml * (1.f - sg); QK[2048 + t * 256 + ch] = lb + oml * sg; QK[3072 + t * 256 + ch] = bf2f(ur[C_HI + ch]);
        }
    } else {
        const int ch = tid - 256; float xs[7], cw[4];
#pragma unroll
        for (int k = 0; k < 3; ++k) xs[k] = inptr(I_SLC)[((size_t)(l * NSQ + seq) * 3 + k) * 256 + ch];
#pragma unroll
        for (int t = 0; t < 4; ++t) xs[3 + t] = bf2f(U[(size_t)(row0 + t) * LDU + C_LX + ch]);
#pragma unroll
        for (int k = 0; k < 4; ++k) cw[k] = inptr(I_LCW)[(l * 4 + k) * 256 + ch];
        const float cb = inptr(I_LCB)[l * 256 + ch];
#pragma unroll
        for (int t = 0; t < 4; ++t) XCs[t * 256 + ch] = cw[0] * xs[t] + cw[1] * xs[t + 1] + cw[2] * xs[t + 2] + cw[3] * xs[t + 3] + cb;
#pragma unroll
        for (int k = 0; k < 3; ++k) outq(C)[O_LCS + ((size_t)(l * NSQ + seq) * 3 + k) * 256 + ch] = xs[4 + k];
    }
    __syncthreads();
    {
        const int hh = tid >> 7, dh = (tid >> 6) & 1, e = tid & 63;
        const size_t sbase = ((size_t)((l * NSQ + seq) * 4 + hh) * 64 + dh * 32) * 64 + e;
        float S[32];
#pragma unroll
        for (int i = 0; i < 32; ++i) S[i] = inptr(I_SHG)[sbase + (size_t)i * 64];
#pragma unroll
        for (int t = 0; t < 4; ++t) {
            const float v = QK[3072 + t * 256 + hh * 64 + e]; const int dd = hh * 64 + dh * 32;
            float part = 0.f;
#pragma unroll
            for (int i = 0; i < 32; ++i) { S[i] = QK[2048 + t * 256 + dd + i] * S[i] + QK[1024 + t * 256 + dd + i] * v; part += QK[t * 256 + dd + i] * S[i]; }
            REDh[((t * 4 + hh) * 2 + dh) * 64 + e] = part;
        }
#pragma unroll
        for (int i = 0; i < 32; ++i) outq(C)[O_HGS + sbase + (size_t)i * 64] = S[i];
    }
    __syncthreads();
#pragma unroll
    for (int rep = 0; rep < 2; ++rep) {
        const int id = tid + 512 * rep, t = id >> 8, hh = (id >> 6) & 3, e = id & 63;
        const float o = REDh[((t * 4 + hh) * 2) * 64 + e] + REDh[((t * 4 + hh) * 2 + 1) * 64 + e];
        const float rs = rsqrtf(wave_sum(o * o) * (1.f / 64.f) + EPS);
        const float hz = bf2f(U[(size_t)(row0 + t) * LDU + C_HZ + hh * 64 + e]);
        O[(size_t)(row0 + t) * DM + hh * 64 + e] = f2bfs(o * rs * inptr(I_HGN)[l * 64 + e] * siluf(hz));
    }
    if (tid < 256) {
        const int ch = tid, blk = ch >> 6, jl = ch & 63;
        float pa[4] = {0.f, 0.f, 0.f, 0.f}, px[4] = {0.f, 0.f, 0.f, 0.f};
        const float* wa = inptr(I_LWA) + (size_t)(l * 4 + blk) * 4096 + jl; const float* wx = inptr(I_LWX) + (size_t)(l * 4 + blk) * 4096 + jl;
#pragma unroll 8
        for (int i = 0; i < 64; ++i) {
            const float a = wa[i * 64], x = wx[i * 64];
#pragma unroll
            for (int t = 0; t < 4; ++t) { const float xc = XCs[t * 256 + blk * 64 + i]; pa[t] += xc * a; px[t] += xc * x; }
        }
        const float ba = inptr(I_LBA)[l * 256 + ch], bx = inptr(I_LBX)[l * 256 + ch], sp = softplusf(-inptr(I_LLAM)[l * 256 + ch]);
        float hcur = inptr(I_SLRU)[(size_t)(l * NSQ + seq) * 256 + ch];
#pragma unroll
        for (int t = 0; t < 4; ++t) {
            const float rr = sigm(pa[t] + ba), ii = sigm(px[t] + bx), la = -8.f * rr * sp;
            hcur = __expf(la) * hcur + sqrtf(fmaxf(0.f, -expm1f(2.f * la))) * ii * XCs[t * 256 + ch];
            const float lz = bf2f(U[(size_t)(row0 + t) * LDU + C_LZ + ch]);
            O[(size_t)(row0 + t) * DM + 768 + ch] = f2bfs(hcur * gelu_tanh(lz));
        }
        outq(C)[O_LRUS + (size_t)(l * NSQ + seq) * 256 + ch] = hcur;
    }
    __syncthreads();
}

template <int XM>
__device__ __forceinline__ void side_gemm_res(Ctx& C, const bf16* A, const bf16* Bt, int K, const float* xin, const bf16* XRin, bf16* XRout, const float* gvec, const float* scn, const float* gamma, bf16* XS, float* rss) {
    int tid_ = threadIdx.x; asm volatile("" : "+v"(tid_)); const int tid = tid_, lane = tid & 63, w = __builtin_amdgcn_readfirstlane(tid >> 6), g = lane >> 4, c = lane & 15;
    int bx_ = (int)blockIdx.x; asm volatile("" : "+s"(bx_));
    const int rb = bx_ >> 4, cb = bx_ & 15, rt = w >> 2, ct = w & 3;
    if (bx_ >= 256) return;
    const int row = rb * 32 + rt * 16 + c;
    LAS unsigned char* lds = ldsq(C);
    const int nch = K >> 7;
    const unsigned char* abase = (const unsigned char*)(A + (size_t)(rb * 32) * K); const unsigned char* bbase = (const unsigned char*)(Bt + (size_t)(cb * 64) * K);
    const int rA = tid >> 4, psA = tid & 15, qA = psA ^ (rA & 15);
    const int rB1 = (tid + 512) >> 4;
#define SIDE_ISSUE(ch, bufi) do { LAS unsigned char* d_ = lds + (bufi) * 24576; const size_t ko_ = (size_t)(ch) * 256; \
        glds16(abase + (size_t)rA * K * 2 + ko_ + qA * 16, d_ + w * 1024); \
        glds16(bbase + (size_t)rA * K * 2 + ko_ + qA * 16, d_ + 8192 + w * 1024); \
        glds16(bbase + (size_t)rB1 * K * 2 + ko_ + (psA ^ (rB1 & 15)) * 16, d_ + 8192 + 8192 + w * 1024); } while (0)
    const int xa = c * 256 + (((c & 12) + (g ^ (c & 3))) << 4);
    f32x4 acc0 = (f32x4){0.f, 0.f, 0.f, 0.f}, acc1 = acc0;
    SIDE_ISSUE(0, 0);
    for (int ch = 0; ch < nch; ++ch) {
        asm volatile("s_waitcnt vmcnt(0)" ::: "memory");
        __syncthreads();
        if (ch + 1 < nch) SIDE_ISSUE(ch + 1, (ch + 1) & 1);
        const LAS unsigned char* bfr = lds + (ch & 1) * 24576;
        bf16x8 fa[4], fb[4];
#pragma unroll
        for (int s = 0; s < 4; ++s) { fa[s] = *(const LAS bf16x8*)(bfr + rt * 4096 + (xa ^ (s << 6))); fb[s] = *(const LAS bf16x8*)(bfr + 8192 + ct * 4096 + (xa ^ (s << 6))); }
        acc0 = mfma16(fb[0], fa[0], acc0); acc1 = mfma16(fb[1], fa[1], acc1); acc0 = mfma16(fb[2], fa[2], acc0); acc1 = mfma16(fb[3], fa[3], acc1);
    }
#undef SIDE_ISSUE
    __syncthreads();
    const f32x4 acc = acc0 + acc1;
    const int col = cb * 64 + ct * 16 + 4 * g, grow = MP + row, s = NBP + (row >> 2);
    f32x4 x0;
    if (XM == 0) x0 = *(const f32x4*)(xin + (size_t)row * DM + col);
    else { const u32x2 r = *(const u32x2*)(XRin + (size_t)grow * DM + col); x0 = (f32x4){bflo(r.x), bfhi(r.x), bflo(r.y), bfhi(r.y)}; }
    const f32x4 xn = x0 + *(const f32x4*)(gvec + (size_t)s * 6144 + col) * acc;
    { u32x2 wq; wq.x = pk2(xn.x, xn.y); wq.y = pk2(xn.z, xn.w); *(u32x2*)(XRout + (size_t)grow * DM + col) = wq; }
    if (scn) { const f32x4 v = xn * *(const f32x4*)(gamma + col) * (*(const f32x4*)(scn + (size_t)s * 6144 + col) + 1.f);
        u32x2 wv; wv.x = pk2(v.x, v.y); wv.y = pk2(v.z, v.w); *(u32x2*)(XS + (size_t)grow * DM + col) = wv; }
    float ss = (xn.x * xn.x + xn.y * xn.y) + (xn.z * xn.z + xn.w * xn.w);
    ss += __shfl_xor(ss, 16); ss += __shfl_xor(ss, 32);
    LAS float* red = (LAS float*)(ldsq(C));
    if (g == 0) red[(rt * 16 + c) * 4 + ct] = ss;
    __syncthreads();
    if (tid < 32) { const f32x4 p = *(const LAS f32x4*)(red + tid * 4); rss[(size_t)(MP + rb * 32 + tid) * 16 + cb] = (p.x + p.y) + (p.z + p.w); }
    __syncthreads();
}

__device__ __forceinline__ void cvec_units(Ctx& C, int r, int ashi, int ashi2, bool do1, bool dogu) {
    const bf16* ash = (const bf16*)(wsq(C) + WS_ASH) + (size_t)ashi * 256 * DM; const bf16* ash2 = (const bf16*)(wsq(C) + WS_ASH) + (size_t)ashi2 * 256 * DM;
    if (do1) {
        OneUnit S{(r >= 0 && r < 15) ? r : -1};
        pg8::Gemm g{ash, (const bf16*)(wsq(C) + WS_WIN), 256, LDU, DM};
        EpiModCvec E{(float*)(wsq(C) + WS_CV1), LDU, nullptr, NSEQ, 0, nullptr};
        pg8::gemm_phase<EpiModCvec, OneUnit, false, true>(ldsq(C), g, S, E);
    }
    if (dogu) {
        const int r2 = do1 ? r - 15 : r;
        { OneUnit S{(r2 >= 0 && r2 < 11) ? r2 : -1};
          pg8::Gemm g{ash2, (const bf16*)(wsq(C) + WS_WG), 256, DFF, DM};
          EpiModCvec E{(float*)(wsq(C) + WS_CVG), DFF, nullptr, NSEQ, 0, nullptr};
          pg8::gemm_phase<EpiModCvec, OneUnit, false, true>(ldsq(C), g, S, E); }
        { OneUnit S{(r2 >= 11 && r2 < 22) ? r2 - 11 : -1};
          pg8::Gemm g{ash2, (const bf16*)(wsq(C) + WS_WU), 256, DFF, DM};
          EpiModCvec E{(float*)(wsq(C) + WS_CVU), DFF, nullptr, NSEQ, 0, nullptr};
          pg8::gemm_phase<EpiModCvec, OneUnit, false, true>(ldsq(C), g, S, E); }
    }
}
constexpr int CW_QHEAD = 12288 + 256;
constexpr int Q_PREP = 1024, Q_LRU1 = Q_PREP + 256, Q_DEC = Q_LRU1 + 640, Q_CONV = Q_DEC + 64, Q_LRU3 = Q_CONV + 256;
__device__ __forceinline__ void phase_m12(Ctx& C, int l) {
    int v_ = (int)blockIdx.x; asm volatile("" : "+s"(v_)); const int v = v_;
    unsigned* gcnt = (unsigned*)((gu32*)(wsq(C) + WS_CTL) + CW_GCNT + l * 32 * 64);
    unsigned* lcnt = (unsigned*)((gu32*)(wsq(C) + WS_CTL) + CW_LCNT + l * 64);
    unsigned* qhead = (unsigned*)((gu32*)(wsq(C) + WS_CTL) + CW_QHEAD + l * 64);
    if (v < 32) gdn_chain(C, l, v >> 2, v & 3);
    else if (v < 64) { const int r = v - 32; hgrn_chain(C, l, r >> 2, r & 3); }
    LAS unsigned* qslot = (LAS unsigned*)(ldsq(C) + MISC_OFF + 96);
    bool lru_ok = false;
    for (;;) {
        __syncthreads();
        if (threadIdx.x == 0) *qslot = __hip_atomic_fetch_add(qhead, 1u, __ATOMIC_RELAXED, __HIP_MEMORY_SCOPE_AGENT);
        __syncthreads();
        const int j = (int)*qslot;
        if (j >= Q_LRU3) break;
        if (j < Q_PREP) { const int n = j >> 5, bh = j & 31; gdn_prep_item(C, l, bh >> 2, bh & 3, n, gcnt + 64 * n); }
        else if (j < Q_LRU1) { const int it = j - Q_PREP; lru_pass1_item(C, l, it >> 5, it & 31, lcnt); }
        else if (j < Q_DEC) { const int it = j - Q_LRU1; if (it < 512) gdn_dec_item(C, l, it >> 2, it & 3); else hl_dec_item(C, l, it - 512); }
        else if (j < Q_CONV) {
            const int gw = (j - Q_DEC) * NWAVES + C.wave, ngw = 64 * NWAVES; int base = 0;
            tr_job(C, inptr(I_WOUT) + (size_t)l * DM * DM, (bf16*)(wsq(C) + WS_WOUT), DM, DM, 0, DM, gw, ngw, base);
            tr_job(C, inptr(I_WD) + (size_t)l * DFF * DM, (bf16*)(wsq(C) + WS_WD), DM, DFF, 0, DM, gw, ngw, base);
            if (l == 0) tr_job(C, inptr(I_WIN) + (size_t)DM * 3592, (bf16*)(wsq(C) + WS_WIN), 3592, DM, 1, LDU, gw, ngw, base);
        } else {
            if (!lru_ok) { if (threadIdx.x == 0) poll_acquire(lcnt, 256u); __syncthreads(); lru_ok = true; }
            const int it = j - Q_CONV; lru_pass3_item(C, l, it >> 5, it & 31);
        }
    }
}

#ifndef MK_PER_PHASE
#define MK_PER_PHASE 0
#endif
constexpr int NPHASE = 18;
struct Args { const float* in[N_IN]; float* out; unsigned char* ws; int ph_lo, ph_hi; };
static_assert(sizeof(Args) == N_IN * 8 + 24, "Args has no padding");
__global__ void __launch_bounds__(NTHR, 2) mega_fwd(Args args) {
    extern __shared__ __attribute__((aligned(16))) unsigned char lds_raw[];
    Ctx C;
    C.lds_ = (LAS unsigned char*)lds_raw;
    C.wave = __builtin_amdgcn_readfirstlane((int)threadIdx.x >> 6);
    C.G = gridDim.x; { const int bx = blockIdx.x; C.vcu = (bx & 7) * (C.G >> 3) + (bx >> 3); }
    C.out_ = args.out; C.ws_ = args.ws;
    for (int u = threadIdx.x; u < (LDS_BYTES - LDSCTL_OFF) / 4; u += NTHR) ((LAS unsigned*)(ldsq(C) + LDSCTL_OFF))[u] = 0u;
    __syncthreads();
#if MK_PER_PHASE
    const int lo = args.ph_lo, hi = args.ph_hi;
#else
    constexpr int lo = 0, hi = NPHASE;
#endif
    if (hi - lo > 1) (void)xcd_barrier_post((unsigned*)((gu32*)(wsq(C) + WS_CTL) + CW_BAR), (volatile LAS unsigned*)(size_t)(MISC_OFF + 32));
#ifndef PROBE_MASK
#define PROBE_MASK 0u
#endif
#define PRB ((volatile LAS unsigned long long*)(ldsq(C) + MISC_OFF + 64))
#ifndef PROBE_PRE
#define PROBE_PRE 0
#endif
#define prb_thr ((PROBE_MASK != 0u || PROBE_REGION != 0) && C.vcu == PROBE_VCU && threadIdx.x == 0)
#define PH_BEGIN(k) do { if (prb_thr && ((PROBE_MASK >> (k)) & 1u)) PRB[0] = __builtin_amdgcn_s_memrealtime(); } while (0)
#define PH_END_(k) do { if (prb_thr && ((PROBE_MASK >> (k)) & 1u)) PRB[1] = PRB[1] + (__builtin_amdgcn_s_memrealtime() - PRB[0]); } while (0)
#define PH_END(k) do { if (!PROBE_PRE) PH_END_(k); } while (0)
#define PH_PRE(k) do { if (PROBE_PRE) PH_END_(k); } while (0)
#define IN(k) (lo <= (k) && (k) < hi)
#define SEAM(k) do { if (IN(k) && IN((k) + 1)) { XcdBarrier b2_; b2_.bar = (unsigned*)((gu32*)(wsq(C) + WS_CTL) + CW_BAR); b2_.x = xb_xcc_id(); b2_.st = (volatile LAS unsigned*)(size_t)(MISC_OFF + 32); xcd_barrier(b2_); } } while (0)
#define MODP ((const float*)(wsq(C) + WS_MOD))
#define RSSP ((float*)(wsq(C) + WS_RSS))
#define XSb ((bf16*)(wsq(C) + WS_XS))
#define Ub ((bf16*)(wsq(C) + WS_U))
#define Ob ((bf16*)(wsq(C) + WS_O))
#define GPb ((bf16*)(wsq(C) + WS_GP))
#define ACTb ((bf16*)(wsq(C) + WS_ACT))

    PH_BEGIN(0);
    if (IN(0)) { phase_p0(C); }
    SEAM(0);
    PH_END(0); PH_BEGIN(1);
    if (IN(1)) {
        pg8::Gemm g{(const bf16*)(wsq(C) + WS_AC), (const bf16*)(wsq(C) + WS_WADA), 256, 12288, DM};
        pg8::StaticOrder S; S.init(256, 12288, C.G, bxq());
        EpiModCvec E{(float*)(wsq(C) + WS_MOD), 6144, inptr(I_BADA), NSEQ, 1, (bf16*)(wsq(C) + WS_ASH)};
        pg8::gemm_phase<EpiModCvec, pg8::StaticOrder, false, true>(ldsq(C), g, S, E);
        if ((int)blockIdx.x >= 48) {
            const int gw = ((int)blockIdx.x - 48) * NWAVES + C.wave, ngw = (C.G - 48) * NWAVES; int base = 0;
            tr_job(C, inptr(I_WIN), (bf16*)(wsq(C) + WS_WIN), 3592, DM, 1, LDU, gw, ngw, base);
            tr_job(C, inptr(I_WG), (bf16*)(wsq(C) + WS_WG), DFF, DM, 0, DFF, gw, ngw, base);
            tr_job(C, inptr(I_WU), (bf16*)(wsq(C) + WS_WU), DFF, DM, 0, DFF, gw, ngw, base);
        }
    }
    SEAM(1);
    PH_END(1); PH_BEGIN(2);
    if (IN(2)) {
        if (C.vcu < 37) cvec_units(C, C.vcu, 0, 1, true, true);
        else x_to_xs(C, (C.vcu - 37) * NWAVES + C.wave, (C.G - 37) * NWAVES);
    }
    SEAM(2);
    PH_END(2);
#pragma unroll 1
    for (int l = 0; l < 2; ++l) {
        const int p = 3 + 7 * l;
        PH_BEGIN(p);
        if (IN(p)) {
            pg8::Gemm g{XSb, (const bf16*)(wsq(C) + WS_WIN), MROWS, LDU, DM};
            pg8::StaticOrder S; S.init(MROWS, LDU, C.G, bxq());
            EpiU E{Ub, RSSP, (const float*)(wsq(C) + WS_CV1), LDU, LDU};
            pg8::gemm_phase<EpiU, pg8::StaticOrder, true, true>(ldsq(C), g, S, E);
            if (l == 1) cvec_units(C, bxq() - 222, 3, 3, false, true);
        }
        SEAM(p);
        PH_END(p); PH_BEGIN(p + 1);
        if (IN(p + 1)) phase_m12(C, l);
        PH_PRE(p + 1);
        SEAM(p + 1);
        PH_END(p + 1); PH_BEGIN(p + 2);
        PH_PRE(p + 2);
        PH_END(p + 2); PH_BEGIN(p + 3);
        if (IN(p + 3)) {
            pg8::Gemm g{Ob, (const bf16*)(wsq(C) + WS_WOUT), MP, DM, DM};
            pg8::StaticOrder S; S.init(MP, DM, C.G, bxq());
            const float* modl = MODP + (size_t)l * NSEQ * 6144;
            bf16* xrb = (bf16*)(wsq(C) + WS_XR); const bf16* ybb = (const bf16*)outq(C);
            if (l == 0) {
                EpiRes<0> E{inptr(I_XP), nullptr, xrb, modl + 2048, modl + 4096, inptr(I_NFFN), XSb, RSSP};
                pg8::gemm_phase<EpiRes<0>, pg8::StaticOrder, true, true>(ldsq(C), g, S, E);
                side_gemm_res<0>(C, Ob + (size_t)MP * DM, (const bf16*)(wsq(C) + WS_WOUT), DM, inptr(I_XS), nullptr, xrb, modl + 2048, modl + 4096, inptr(I_NFFN), XSb, RSSP);
            } else {
                EpiRes<1> E{nullptr, ybb, xrb, modl + 2048, modl + 4096, inptr(I_NFFN) + DM, XSb, RSSP};
                pg8::gemm_phase<EpiRes<1>, pg8::StaticOrder, true, true>(ldsq(C), g, S, E);
                side_gemm_res<1>(C, Ob + (size_t)MP * DM, (const bf16*)(wsq(C) + WS_WOUT), DM, nullptr, ybb, xrb, modl + 2048, modl + 4096, inptr(I_NFFN) + DM, XSb, RSSP);
            }
        }
        SEAM(p + 3);
        PH_END(p + 3); PH_BEGIN(p + 4);
        if (IN(p + 4)) {
            pg8::Gemm g{XSb, (const bf16*)(wsq(C) + WS_WG), MROWS, DFF, DM};
            pg8::StaticOrder S; S.init(MROWS, DFF, C.G, bxq());
            EpiGate E{GPb, RSSP, (const float*)(wsq(C) + WS_CVG), outq(C) + O_FCP + (size_t)l * NBP * 2 * DFF, outq(C) + O_FCS + (size_t)l * NSQ * 2 * DFF};
            pg8::gemm_phase<EpiGate, pg8::StaticOrder, true, true>(ldsq(C), g, S, E);
            if (l == 0) cvec_units(C, bxq() - 214, 2, 2, true, false);
        }
        SEAM(p + 4);
        PH_END(p + 4); PH_BEGIN(p + 5);
        if (IN(p + 5)) {
            pg8::Gemm g{XSb, (const bf16*)(wsq(C) + WS_WU), MROWS, DFF, DM};
            pg8::StaticOrder S; S.init(MROWS, DFF, C.G, bxq());
            EpiUp E{ACTb, GPb, RSSP, (const float*)(wsq(C) + WS_CVU), inptr(I_FCW) + (size_t)l * 3 * DFF, inptr(I_FCB) + (size_t)l * DFF, inptr(I_SFC) + (size_t)l * NSQ * 2 * DFF};
            pg8::gemm_phase<EpiUp, pg8::StaticOrder, true, true>(ldsq(C), g, S, E);
        }
        SEAM(p + 5);
        PH_END(p + 5); PH_BEGIN(p + 6);
        if (IN(p + 6)) {
            pg8::Gemm g{ACTb, (const bf16*)(wsq(C) + WS_WD), MP, DM, DFF};
            pg8::StaticOrder S; S.init(MP, DM, C.G, bxq());
            const float* modl = MODP + (size_t)l * NSEQ * 6144; const float* mod1 = MODP + (size_t)NSEQ * 6144;
            bf16* xrb = (bf16*)(wsq(C) + WS_XR); bf16* ybb = (bf16*)outq(C);
            {
                EpiRes<1> E{nullptr, xrb, l == 0 ? ybb : xrb, modl + 5120, l == 0 ? mod1 + 1024 : nullptr, inptr(I_NMIX) + DM, XSb, RSSP};
                pg8::gemm_phase<EpiRes<1>, pg8::StaticOrder, true, true>(ldsq(C), g, S, E);
                side_gemm_res<1>(C, ACTb + (size_t)MP * DFF, (const bf16*)(wsq(C) + WS_WD), DFF, nullptr, xrb, l == 0 ? ybb : xrb, modl + 5120, l == 0 ? mod1 + 1024 : nullptr, inptr(I_NMIX) + DM, XSb, RSSP);
            }
            if (l == 0) {
                const int gw = C.vcu * NWAVES + C.wave, ngw = C.G * NWAVES; int base = 0;
                tr_job(C, inptr(I_WG) + (size_t)DM * DFF, (bf16*)(wsq(C) + WS_WG), DFF, DM, 0, DFF, gw, ngw, base);
                tr_job(C, inptr(I_WU) + (size_t)DM * DFF, (bf16*)(wsq(C) + WS_WU), DFF, DM, 0, DFF, gw, ngw, base);
            }
        }
        SEAM(p + 6);
        PH_END(p + 6);
    }
    PH_BEGIN(17);
    if (IN(17)) phase_final(C);
    PH_END(17);
    if (prb_thr) { const unsigned long long tgt = __builtin_amdgcn_s_memrealtime() + 4ull * PRB[1]; while (__builtin_amdgcn_s_memrealtime() < tgt) __builtin_amdgcn_s_sleep(8); }
#undef IN
#undef SEAM
}

#ifndef MK_PER_PHASE
#define MK_PER_PHASE 0
#endif
extern "C" void kernel_launch(void* const* d_in, const int* in_sizes, int n_in, void* d_out, int out_size, void* d_ws, size_t ws_size, hipStream_t stream) {
    static int grid = 0;
    if (grid == 0) {
        int dev = 0, cus = 0;
        if (n_in != N_IN || (size_t)out_size != O_END || ws_size < WS_END) { fprintf(stderr, "kernel_launch: unexpected problem (n_in %d, out %d, ws %zu)\n", n_in, out_size, ws_size); grid = -1; return; }
        if (hipGetDevice(&dev) != hipSuccess || hipDeviceGetAttribute(&cus, hipDeviceAttributeMultiprocessorCount, dev) != hipSuccess) { grid = -1; return; }
        if (hipFuncSetAttribute((const void*)mega_fwd, hipFuncAttributeMaxDynamicSharedMemorySize, LDS_BYTES) != hipSuccess) { fprintf(stderr, "kernel_launch: hipFuncSetAttribute failed\n"); grid = -1; return; }
        int per_cu = 0;
        if (hipOccupancyMaxActiveBlocksPerMultiprocessor(&per_cu, (const void*)mega_fwd, NTHR, LDS_BYTES) != hipSuccess || per_cu < 1) fprintf(stderr, "kernel_launch: occupancy query says %d blocks per CU\n", per_cu);
        (void)hipGetLastError();
        grid = cus & ~7;
    }
    if (grid < 0) return;
    (void)hipMemsetAsync((char*)d_ws + WS_CTL, 0, CTL_ZERO_BYTES, stream);
    Args a{};
    for (int i = 0; i < N_IN; ++i) a.in[i] = (const float*)d_in[i];
    a.out = (float*)d_out; a.ws = (unsigned char*)d_ws;
#if MK_PER_PHASE
    for (int p = 0; p < NPHASE; ++p) { a.ph_lo = p; a.ph_hi = p + 1; hipLaunchKernelGGL(mega_fwd, dim3(grid), dim3(NTHR), LDS_BYTES, stream, a); }
#else
    a.ph_lo = 0; a.ph_hi = NPHASE;
    hipLaunchKernelGGL(mega_fwd, dim3(grid), dim3(NTHR), LDS_BYTES, stream, a);
#endif
}
```

```cpp
#include <hip/hip_runtime.h>
#include <cstdio>
#include <cstdint>
#ifndef PROBE_REGION
#define PROBE_REGION 0
#endif
#ifndef PROBE_VCU
#define PROBE_VCU 0
#endif
namespace pg8 {
#define PG8_LAS __attribute__((address_space(3)))
typedef unsigned short bf16_t;
typedef short bf16x8 __attribute__((ext_vector_type(8)));
typedef float f32x4 __attribute__((ext_vector_type(4)));
typedef unsigned u32x4 __attribute__((ext_vector_type(4)));
constexpr int BM = 256, BK = 64, HALF = 128, HTB = HALF * BK * 2  , STAGE_BYTES = 8 * HTB, NXCD = 8, WGM = 8;

__host__ __device__ __forceinline__ int lds_byte(int r, int c) { const int st = (r >> 4) * 2 + (c >> 5), rr = r & 15, cc = c & 31, ob = rr * 64 + cc * 2; return st * 1024 + (ob ^ (((ob >> 9) & 1) << 5)); }
__host__ __device__ __forceinline__ void stage_rc(int b, int& R, int& C) { const int st = b / 1024, sb = b % 1024, swz = sb ^ (((sb >> 9) & 1) << 5); R = (st >> 1) * 16 + swz / 64; C = (st & 1) * 32 + (swz % 64) / 2; }
__host__ __device__ __forceinline__ int perm32(int rho) { const int n = rho >> 4, i = rho & 15; return 8 * (i >> 2) + 4 * n + (i & 3); }

struct Unit { int pm, pn; };
struct Gemm { const bf16_t* A; const bf16_t* Bt; int M, N, K; };

template <int M_, int N_, int ND_ = 0>
struct StaticOrder {
    static constexpr int nM = M_ / BM, nN = N_ / BM, nwg = nM * nN;
    int G, c, nd;
    __host__ __device__ void init(int G_, int c_) { G = G_; c = c_;
        const int nshort = ((nwg + G - 1) / G) * G - nwg; nd = (ND_ > 0 && ND_ <= nshort && ND_ <= G && G / NXCD + 1 + ND_ < nwg / NXCD) ? ND_ : 0; }
    static __host__ __device__ int chunk(int wgid) { constexpr int q = nwg / NXCD, r = nwg % NXCD; const int xcd = wgid % NXCD, off = wgid / NXCD; return (xcd < r ? xcd * (q + 1) : r * (q + 1) + (xcd - r) * q) + off; }
    __host__ __device__ bool next(int i, Unit& u) const {
        const int L = i * G + c; if (L >= nwg) return false;
        int wgid;
        if (i == 0 && c >= G - nd) wgid = nwg - nd + (c - (G - nd));
        else { wgid = chunk(L); if (wgid >= nwg - nd) wgid = chunk((G - nd) + (wgid - (nwg - nd))); }
        constexpr int nig = WGM * nN; const int gid = wgid / nig, fm = gid * WGM, gsz = (nM - fm) < WGM ? (nM - fm) : WGM;
        u.pm = fm + ((wgid % nig) % gsz); u.pn = (wgid % nig) / gsz; return true;
    }
    __device__ __forceinline__ void a_ready(const Unit&) const {}
    __device__ __forceinline__ void done(const Unit&) const {}
};

__device__ __forceinline__ unsigned cvt_pk_bf16(float lo, float hi) { unsigned r; asm volatile("v_cvt_pk_bf16_f32 %0, %1, %2" : "=v"(r) : "v"(lo), "v"(hi)); return r; }
template <class Epi, class Sched, bool ALIGN_EPI = false, bool SP2 = false>
__device__ __forceinline__ void gemm_phase(PG8_LAS unsigned char* lds, const Gemm g, const Sched& S, const Epi& E) {
    int tid_ = threadIdx.x; asm volatile("" : "+v"(tid_)); const int tid = tid_, wid = __builtin_amdgcn_readfirstlane(tid >> 6), lane = tid & 63, wr = wid >> 2, wc = wid & 3, fr = lane & 15, fq = lane >> 4;
    const int K = g.K, nt = K / BK;
    unsigned voffA[2], voffB[2];
#pragma unroll
    for (int i = 0; i < 2; ++i) { int R, C; stage_rc(tid * 16 + i * 8192, R, C); const int Rb = Epi::PERM ? ((R & ~31) + perm32(R & 31)) : R;
        voffA[i] = (unsigned)(R * K + C) * 2u; voffB[i] = (unsigned)(Rb * K + C) * 2u; }
    const size_t kstep = (size_t)(BK * 2);
    const size_t hstep = (size_t)HALF * K * 2;
    const size_t tstep = 2 * hstep;
    const unsigned ldsw = (unsigned)wid * 1024u;
    const int aoff = lds_byte(wr * 64 + fr, fq * 8), boff = lds_byte(wc * 32 + fr, fq * 8);
#define PG8_SA(b, h) (((b) * 2 + (h)) * HTB)
#define PG8_SB(b, h) ((4 + (b) * 2 + (h)) * HTB)
#define PG8_STAGE(bufoff, gbase, voff) do { _Pragma("unroll") for (int _i = 0; _i < 2; ++_i) \
        __builtin_amdgcn_global_load_lds((const unsigned*)((const char*)(gbase) + (voff)[_i]), (PG8_LAS unsigned*)(lds + (bufoff) + ldsw + _i * 8192), 16, 0, 0); } while (0)
#define PG8_LDA(dst, b, h) do { _Pragma("unroll") for (int m = 0; m < 4; ++m) _Pragma("unroll") for (int k = 0; k < 2; ++k) dst[m][k] = *(const PG8_LAS bf16x8*)(lds + PG8_SA(b, h) + aoff + m * 2048 + k * 1024); } while (0)
#define PG8_LDB(dst, b, h) do { _Pragma("unroll") for (int n = 0; n < 2; ++n) _Pragma("unroll") for (int k = 0; k < 2; ++k) dst[n][k] = *(const PG8_LAS bf16x8*)(lds + PG8_SB(b, h) + boff + n * 2048 + k * 1024); } while (0)
#define PG8_MMA(ai, bj, At, Bt) do { __builtin_amdgcn_s_setprio(1); _Pragma("unroll") for (int m = 0; m < 4; ++m) _Pragma("unroll") for (int n = 0; n < 2; ++n) _Pragma("unroll") for (int k = 0; k < 2; ++k) \
        acc[ai][bj][m][n] = __builtin_amdgcn_mfma_f32_16x16x32_bf16(Bt[n][k], At[m][k], acc[ai][bj][m][n], 0, 0, 0); __builtin_amdgcn_s_setprio(0); } while (0)
#define PG8_WAIT_V(n) asm volatile("s_waitcnt vmcnt(" #n ")" ::: "memory")
#define PG8_WAIT_L(n) asm volatile("s_waitcnt lgkmcnt(" #n ")" ::: "memory")
#define PG8_BAR __builtin_amdgcn_s_barrier()
#define PG8_SCHED __builtin_amdgcn_sched_barrier(0)
    Unit cur, nxt; int ui = 0;
    if (!S.next(0, cur)) return;
    f32x4 acc[2][2][4][2];
#pragma unroll
    for (int a = 0; a < 2; ++a)
#pragma unroll
        for (int b = 0; b < 2; ++b)
#pragma unroll
            for (int m = 0; m < 4; ++m)
#pragma unroll
                for (int n = 0; n < 2; ++n) acc[a][b][m][n] = (f32x4){0.f, 0.f, 0.f, 0.f};
    bf16x8 At[4][2], B0[2][2], B1[2][2];
    const char* cA = (const char*)g.A + (size_t)cur.pm * tstep; const char* cB = (const char*)g.Bt + (size_t)cur.pn * tstep;
    S.a_ready(cur);
    if constexpr (SP2) {
        PG8_STAGE(PG8_SB(0, 0), cB, voffB); PG8_STAGE(PG8_SB(0, 1), cB + hstep, voffB); PG8_STAGE(PG8_SA(0, 0), cA, voffA); PG8_STAGE(PG8_SA(0, 1), cA + hstep, voffA);
        if (wr == 1) PG8_BAR;
        PG8_WAIT_V(2); PG8_BAR;
        PG8_STAGE(PG8_SB(1, 0), cB + kstep, voffB); PG8_STAGE(PG8_SA(1, 0), cA + kstep, voffA); PG8_STAGE(PG8_SB(1, 1), cB + hstep + kstep, voffB);
        PG8_WAIT_V(6); PG8_BAR;
    } else {
        PG8_STAGE(PG8_SB(0, 0), cB, voffB); PG8_STAGE(PG8_SA(0, 0), cA, voffA); PG8_STAGE(PG8_SB(0, 1), cB + hstep, voffB); PG8_STAGE(PG8_SA(0, 1), cA + hstep, voffA);
        if (wr == 1) PG8_BAR;
        PG8_WAIT_V(4); PG8_BAR;
        PG8_STAGE(PG8_SB(1, 0), cB + kstep, voffB); PG8_STAGE(PG8_SA(1, 0), cA + kstep, voffA); PG8_STAGE(PG8_SB(1, 1), cB + hstep + kstep, voffB);
        PG8_WAIT_V(6); PG8_BAR;
    }
    for (;;) {
        const bool has_next = S.next(ui + 1, nxt);
        const char* nA = has_next ? (const char*)g.A + (size_t)nxt.pm * tstep : cA; const char* nB = has_next ? (const char*)g.Bt + (size_t)nxt.pn * tstep : cB;
        for (int t = 0; t < nt; t += 2) {
            const bool last = (t == nt - 2);
            const char* a1 = cA + (size_t)(t + 1) * kstep;
            const char* a2 = last ? nA : cA + (size_t)(t + 2) * kstep; const char* b2 = last ? nB : cB + (size_t)(t + 2) * kstep;
            const char* a3 = a2 + kstep; const char* b3 = b2 + kstep;
            if (last && has_next) S.a_ready(nxt);
            if (last) E.stage_dma(cur);
            if constexpr (SP2) {
            PG8_LDB(B0, 0, 0); PG8_LDB(B1, 0, 1); PG8_SCHED; PG8_LDA(At, 0, 0); PG8_STAGE(PG8_SA(1, 1), a1 + hstep, voffA);
            PG8_WAIT_V(8); PG8_WAIT_L(0); PG8_BAR; PG8_MMA(0, 0, At, B0); PG8_MMA(0, 1, At, B1); PG8_BAR; PG8_SCHED;
            PG8_LDA(At, 0, 1); PG8_STAGE(PG8_SB(0, 0), b2, voffB); PG8_STAGE(PG8_SB(0, 1), b2 + hstep, voffB); PG8_STAGE(PG8_SA(0, 0), a2, voffA);
            PG8_WAIT_V(8); PG8_WAIT_L(0); PG8_BAR; PG8_MMA(1, 0, At, B0); PG8_MMA(1, 1, At, B1); PG8_BAR; PG8_SCHED;
            PG8_LDB(B0, 1, 0); PG8_LDB(B1, 1, 1); PG8_SCHED; PG8_LDA(At, 1, 0); PG8_STAGE(PG8_SA(0, 1), a2 + hstep, voffA);
            PG8_WAIT_V(8); PG8_WAIT_L(0); PG8_BAR; PG8_MMA(0, 0, At, B0); PG8_MMA(0, 1, At, B1); PG8_BAR; PG8_SCHED;
            PG8_LDA(At, 1, 1); PG8_STAGE(PG8_SB(1, 0), b3, voffB); PG8_STAGE(PG8_SB(1, 1), b3 + hstep, voffB); PG8_STAGE(PG8_SA(1, 0), a3, voffA);
            PG8_WAIT_V(8); PG8_WAIT_L(0); PG8_BAR; PG8_MMA(1, 0, At, B0); PG8_MMA(1, 1, At, B1); PG8_BAR; PG8_SCHED;
            } else {
            PG8_LDB(B0, 0, 0); PG8_SCHED; PG8_LDA(At, 0, 0); PG8_STAGE(PG8_SA(1, 1), a1 + hstep, voffA);
            PG8_WAIT_L(8); PG8_BAR; PG8_WAIT_L(0); PG8_MMA(0, 0, At, B0); PG8_BAR; PG8_SCHED;
            PG8_LDB(B1, 0, 1); PG8_STAGE(PG8_SB(0, 0), b2, voffB);
            PG8_BAR; PG8_WAIT_L(0); PG8_MMA(0, 1, At, B1); PG8_BAR;
            PG8_LDA(At, 0, 1); PG8_STAGE(PG8_SA(0, 0), a2, voffA);
            PG8_BAR; PG8_WAIT_L(0); PG8_MMA(1, 0, At, B0); PG8_BAR; PG8_SCHED;
            PG8_STAGE(PG8_SB(0, 1), b2 + hstep, voffB);
            PG8_WAIT_V(6); PG8_BAR; PG8_MMA(1, 1, At, B1); PG8_BAR;
            PG8_LDB(B0, 1, 0); PG8_SCHED; PG8_LDA(At, 1, 0); PG8_STAGE(PG8_SA(0, 1), a2 + hstep, voffA);
            PG8_WAIT_L(8); PG8_BAR; PG8_WAIT_L(0); PG8_MMA(0, 0, At, B0); PG8_BAR; PG8_SCHED;
            PG8_LDB(B1, 1, 1); PG8_STAGE(PG8_SB(1, 0), b3, voffB);
            PG8_BAR; PG8_WAIT_L(0); PG8_MMA(0, 1, At, B1); PG8_BAR;
            PG8_LDA(At, 1, 1); PG8_STAGE(PG8_SA(1, 0), a3, voffA);
            PG8_BAR; PG8_WAIT_L(0); PG8_MMA(1, 0, At, B0); PG8_BAR; PG8_SCHED;
            PG8_STAGE(PG8_SB(1, 1), b3 + hstep, voffB);
            PG8_WAIT_V(6); PG8_BAR; PG8_MMA(1, 1, At, B1); PG8_BAR;
            }
        }
        if constexpr (ALIGN_EPI) { if (wr == 0) PG8_BAR; }
        if constexpr (!Epi::AFTER_DRAIN) {
            if (PROBE_REGION == Epi::PID && (int)((blockIdx.x & 7) * (gridDim.x >> 3) + (blockIdx.x >> 3)) == PROBE_VCU && threadIdx.x == 0) ((volatile PG8_LAS unsigned long long*)(size_t)163200)[0] = __builtin_amdgcn_s_memrealtime();
            E(acc, cur, wr, wc, fr, fq); S.done(cur);
            if (PROBE_REGION == Epi::PID && (int)((blockIdx.x & 7) * (gridDim.x >> 3) + (blockIdx.x >> 3)) == PROBE_VCU && threadIdx.x == 0) { volatile PG8_LAS unsigned long long* q_ = (volatile PG8_LAS unsigned long long*)(size_t)163200; q_[1] = q_[1] + (__builtin_amdgcn_s_memrealtime() - q_[0]); }
        }
        if (!has_next) break;
#pragma unroll
        for (int a = 0; a < 2; ++a)
#pragma unroll
            for (int b = 0; b < 2; ++b)
#pragma unroll
                for (int m = 0; m < 4; ++m)
#pragma unroll
                    for (int n = 0; n < 2; ++n) acc[a][b][m][n] = (f32x4){0.f, 0.f, 0.f, 0.f};
        cur = nxt; cA = nA; cB = nB; ++ui;
        if constexpr (ALIGN_EPI) { if (wr == 1) PG8_BAR; }
    }
    PG8_WAIT_V(0);
    if constexpr (!ALIGN_EPI) { if (wr == 0) PG8_BAR; }
    PG8_BAR;
    if constexpr (Epi::AFTER_DRAIN) { E.fused(acc, cur, wr, wc, fr, fq, lds, wid, lane); S.done(cur); }
#undef PG8_SA
#undef PG8_SB
#undef PG8_STAGE
#undef PG8_LDA
#undef PG8_LDB
#undef PG8_MMA
#undef PG8_WAIT_V
#undef PG8_WAIT_L
#undef PG8_BAR
#undef PG8_SCHED
}
}
#define GAS __attribute__((address_space(1)))
#define LAS __attribute__((address_space(3)))
typedef unsigned short bf16;
typedef unsigned v4u __attribute__((ext_vector_type(4)));
typedef float f32x4 __attribute__((ext_vector_type(4)));
typedef short bf16x8 __attribute__((ext_vector_type(8)));
typedef GAS unsigned gu32;
typedef GAS unsigned long long gu64;
#define RLX_AGENT __ATOMIC_RELAXED, __HIP_MEMORY_SCOPE_AGENT
#define LDS_WAIT() asm volatile("s_waitcnt lgkmcnt(0)" ::: "memory")
#define VM_WAIT() asm volatile("s_waitcnt vmcnt(0)" ::: "memory")
__device__ __forceinline__ unsigned long long rt() { return __builtin_amdgcn_s_memrealtime(); }
__device__ __forceinline__ unsigned f2bf(float f) { unsigned u = __builtin_bit_cast(unsigned, f); return (u + 0x7fffu + ((u >> 16) & 1u)) >> 16; }
__device__ __forceinline__ unsigned pk2(float lo, float hi) { unsigned r; asm("v_cvt_pk_bf16_f32 %0, %1, %2" : "=v"(r) : "v"(lo), "v"(hi)); return r; }

#define XB_TMO      128
#define XB_XCNT(j)  (256  + 64 * (j))
#define XB_XSUB(j)  (1280 + 64 * (j))
#define XB_XGEN(j)  (2304 + 64 * (j))
#define XB_TOP      3328
#define XB_TOPGEN   3392
#define XCD_BAR_WORDS 3456
#define XB_SPIN_CAP (1u << 18)

__device__ __forceinline__ unsigned xb_ld(unsigned* p)              { return __hip_atomic_load(p, __ATOMIC_RELAXED, __HIP_MEMORY_SCOPE_AGENT); }
__device__ __forceinline__ unsigned xb_add(unsigned* p, unsigned v) { return __hip_atomic_fetch_add(p, v, __ATOMIC_RELAXED, __HIP_MEMORY_SCOPE_AGENT); }
__device__ __forceinline__ unsigned xb_xcc_id() { return (unsigned)__builtin_amdgcn_s_getreg((3 << 11) | 20) & 0xFu; }
#define XB_SPIN(cond, bar) do { unsigned _sp = 0; while (cond) { __builtin_amdgcn_s_sleep(1); \
    if ((++_sp & 255u) == 0u) { if (xb_ld(&(bar)[XB_TMO])) break; if (_sp > XB_SPIN_CAP) { atomicAdd(&(bar)[XB_TMO], 1u); break; } } } } while (0)

struct XcdBarrier {
    unsigned* bar; unsigned x;
    volatile LAS unsigned* st;
};

__device__ __forceinline__ XcdBarrier xcd_barrier_post(unsigned* bar, volatile LAS unsigned* st) {
    XcdBarrier b; b.bar = bar; b.x = xb_xcc_id(); b.st = st;
    if (threadIdx.x == 0) (void)xb_add(&bar[XB_XCNT(b.x)], 1u);
    return b;
}
__device__ __forceinline__ void xcd_barrier_complete(unsigned* bar, unsigned x, unsigned& nloc, unsigned& nx) {
    const unsigned G = gridDim.x * gridDim.y * gridDim.z;
    unsigned sum, cnt, mine, sp = 0u;
    for (;;) {
        sum = 0u; cnt = 0u; mine = 0u;
#pragma unroll
        for (unsigned j = 0; j < 16; ++j) { const unsigned c = xb_ld(&bar[XB_XCNT(j)]); sum += c; cnt += (c > 0u) ? 1u : 0u; mine = (j == x) ? c : mine; }
        if (sum == G) break;
        __builtin_amdgcn_s_sleep(1);
        if ((++sp & 255u) == 0u) { if (xb_ld(&bar[XB_TMO])) break; if (sp > XB_SPIN_CAP) { atomicAdd(&bar[XB_TMO], 1u); break; } }
    }
    nloc = mine > 0u ? mine : 1u; nx = cnt > 0u ? cnt : 1u;
}

__device__ __forceinline__ void xcd_barrier(const XcdBarrier& b) {
    asm volatile("s_waitcnt vmcnt(0)" ::: "memory");
    __syncthreads();
    if (threadIdx.x == 0) {
        unsigned* bar = b.bar;
        __builtin_amdgcn_s_waitcnt(0);
        unsigned nloc = b.st[0], nx = b.st[1];
        if (nloc == 0u) { xcd_barrier_complete(bar, b.x, nloc, nx); b.st[0] = nloc; b.st[1] = nx; }
        const unsigned old = xb_add(&bar[XB_XSUB(b.x)], 1u);
        const unsigned gen = old / nloc;
        if (old + 1u == (gen + 1u) * nloc) {
            __builtin_amdgcn_fence(__ATOMIC_RELEASE, "agent");
            asm volatile("s_waitcnt vmcnt(0)" ::: "memory");
            const unsigned og = xb_add(&bar[XB_TOP], 1u);
            const unsigned tg = og / nx;
            if (og + 1u == (tg + 1u) * nx) xb_add(&bar[XB_TOPGEN], 1u);
            else XB_SPIN(xb_ld(&bar[XB_TOPGEN]) == tg, bar);
            __builtin_amdgcn_fence(__ATOMIC_ACQUIRE, "agent");
            xb_add(&bar[XB_XGEN(b.x)], 1u);
            asm volatile("s_waitcnt vmcnt(0)" ::: "memory");
        } else {
            XB_SPIN(xb_ld(&bar[XB_XGEN(b.x)]) == gen, bar);
            __builtin_amdgcn_fence(__ATOMIC_ACQUIRE, "agent");
            asm volatile("s_waitcnt vmcnt(0)" ::: "memory");
        }
    }
    __syncthreads();
}
constexpr int NWAVES = 8, NTHR = 512;
constexpr int DM = 1024, TSEQ = 2048, NBP = 8, NSQ = 128, TSMP = 4, NSEQ = 136;
constexpr int MP = 16384, MROWS = 16896;
constexpr int DFF = 2816, LDU = 3840;
constexpr float EPS = 1e-6f;
constexpr int C_HQ = 0, C_HF = 256, C_HI = 512, C_HZ = 768, C_Q = 1024, C_K = 1536, C_V = 2048, C_GZ = 2560, C_LX = 3072, C_LZ = 3328, C_GA = 3584, C_GB = 3588;
enum { I_XP = 0, I_XS, I_SHG, I_SGDN, I_SGC, I_SLRU, I_SLC, I_SFC, I_CP, I_CS, I_NMIX, I_NFFN, I_WADA, I_BADA, I_WIN, I_HGLB, I_HGN, I_GCW, I_GALOG, I_GDTB, I_GNORM,
       I_LCW, I_LCB, I_LWA, I_LBA, I_LWX, I_LBX, I_LLAM, I_WOUT, I_WG, I_WU, I_FCW, I_FCB, I_WD, I_FNORM, N_IN };
constexpr size_t O_YP = 0, O_YS = 16777216, O_HGP = 17301504, O_GDNP = 17563648, O_GCP = 18612224, O_LRUP = 18685952, O_LCP = 18690048, O_FCP = 18702336,
                 O_HGS = 18792448, O_GDNS = 22986752, O_GCS = 39763968, O_LRUS = 40943616, O_LCS = 41009152, O_FCS = 41205760, O_END = 42647552;
constexpr size_t MiB = 1u << 20;
constexpr size_t WS_CTL = 0, CTL_ZERO_BYTES = 65536;
constexpr size_t WS_WIN = 1 * MiB;
constexpr size_t WS_WOUT = 9 * MiB;
constexpr size_t WS_WG = 11 * MiB;
constexpr size_t WS_WU = 17 * MiB;
constexpr size_t WS_WD = 23 * MiB;
constexpr size_t WS_AC = 29 * MiB;
constexpr size_t WS_ASH = 30 * MiB;
constexpr size_t WS_MOD = 32 * MiB;
constexpr size_t WS_CV1 = 39 * MiB;
constexpr size_t WS_CVG = 41 * MiB;
constexpr size_t WS_CVU = 43 * MiB;
constexpr size_t WS_RSS = 45 * MiB;
constexpr size_t WS_XS = 47 * MiB;
constexpr size_t WS_PQ = 47 * MiB, WS_PK = 63 * MiB;
constexpr size_t WS_U = 80 * MiB;
constexpr size_t WS_O = 204 * MiB;
constexpr size_t WS_WADA = 204 * MiB;
constexpr size_t WS_PW = 237 * MiB, WS_PU = 253 * MiB, WS_PA = 269 * MiB, WS_EGL = 277 * MiB;
constexpr size_t WS_GP = 80 * MiB;
constexpr size_t WS_ACT = 171 * MiB;
constexpr size_t WS_LSUM = 277 * MiB + 65536;
constexpr size_t WS_ACUM = 278 * MiB, WS_HLOC = 286 * MiB;
constexpr size_t WS_XR = 262 * MiB;
constexpr size_t WS_END = 295 * MiB;
constexpr int CW_BAR = 4096;
constexpr int CW_GCNT = 8192;
constexpr int CW_LCNT = 12288;
constexpr int LDS_BYTES = 163840, LDSCTL_OFF = 162816, MISC_OFF = LDSCTL_OFF + 320;

typedef float f32x2 __attribute__((ext_vector_type(2)));
typedef unsigned u32x2 __attribute__((ext_vector_type(2)));
struct Ctx {
    LAS unsigned char* lds_;
    int wave, vcu, G;
    float* out_; unsigned char* ws_;
};
__device__ __forceinline__ LAS unsigned char* ldsq(const Ctx& C) { LAS unsigned char* p = C.lds_; asm volatile("" : "+s"(p)); return p; }
__device__ __forceinline__ int bxq() { int b = (int)blockIdx.x; asm volatile("" : "+s"(b)); return b; }
__device__ __forceinline__ unsigned char* wsq(const Ctx& C) { unsigned char* p = C.ws_; asm volatile("" : "+s"(p)); return p; }
__device__ __forceinline__ float* outq(const Ctx& C) { float* p = C.out_; asm volatile("" : "+s"(p)); return p; }
__device__ __forceinline__ const float* inptr(int i) {
    unsigned long long ka = (unsigned long long)__builtin_amdgcn_kernarg_segment_ptr();
    asm volatile("" : "+s"(ka));
    return *(const float* const __attribute__((address_space(4)))*)(ka + 8ull * (unsigned)i);
}
__device__ __forceinline__ float bf2f(unsigned short h) { return __builtin_bit_cast(float, (unsigned)h << 16); }
__device__ __forceinline__ float bflo(unsigned w) { return __builtin_bit_cast(float, w << 16); }
__device__ __forceinline__ float bfhi(unsigned w) { return __builtin_bit_cast(float, w & 0xffff0000u); }
__device__ __forceinline__ unsigned short f2bfs(float f) { return (unsigned short)(pk2(f, f) & 0xffffu); }
__device__ __forceinline__ float sigm(float x) { return __builtin_amdgcn_rcpf(1.f + __expf(-x)); }
__device__ __forceinline__ float siluf(float x) { return x * __builtin_amdgcn_rcpf(1.f + __expf(-x)); }
__device__ __forceinline__ float softplusf(float x) { return x > 20.f ? x : log1pf(__expf(x)); }
__device__ __forceinline__ float gelu_tanh(float x) { const float u = 0.7978845608028654f * (x + 0.044715f * x * x * x); return x * __builtin_amdgcn_rcpf(1.f + __expf(-2.f * u)); }
__device__ __forceinline__ float dpp_sum16(float v) {
    v += __builtin_bit_cast(float, __builtin_amdgcn_update_dpp(0, __builtin_bit_cast(int, v), 0xB1, 0xF, 0xF, true));
    v += __builtin_bit_cast(float, __builtin_amdgcn_update_dpp(0, __builtin_bit_cast(int, v), 0x4E, 0xF, 0xF, true));
    v += __builtin_bit_cast(float, __builtin_amdgcn_update_dpp(0, __builtin_bit_cast(int, v), 0x141, 0xF, 0xF, true));
    v += __builtin_bit_cast(float, __builtin_amdgcn_update_dpp(0, __builtin_bit_cast(int, v), 0x140, 0xF, 0xF, true));
    return v;
}
__device__ __forceinline__ int permpos(int d) { return 8 * ((d >> 2) & 3) + 4 * ((d >> 4) & 1) + (d & 3); }
__device__ __forceinline__ int seq_of_row(int row) { return row < MP ? (row >> 11) : NBP + ((row - MP) >> 2); }
__device__ __forceinline__ bf16x8 pack8(const f32x4 a, const f32x4 b) {
    v4u w; w.x = pk2(a.x, a.y); w.y = pk2(a.z, a.w); w.z = pk2(b.x, b.y); w.w = pk2(b.z, b.w); return __builtin_bit_cast(bf16x8, w);
}
__device__ __forceinline__ f32x4 mfma16(const bf16x8 a, const bf16x8 b, const f32x4 c) { return __builtin_amdgcn_mfma_f32_16x16x32_bf16(a, b, c, 0, 0, 0); }
__device__ __forceinline__ void glds16(const void* g, LAS unsigned char* l) { __builtin_amdgcn_global_load_lds((const unsigned*)g, (LAS unsigned*)l, 16, 0, 0); }
__device__ __forceinline__ float rstd_of(const float* rss, int row) {
    const f32x4* p = (const f32x4*)(rss + (size_t)row * 16); const f32x4 a = p[0], b = p[1], c = p[2], d = p[3];
    const float s = ((a.x + a.y) + (a.z + a.w)) + ((b.x + b.y) + (b.z + b.w)) + ((c.x + c.y) + (c.z + c.w)) + ((d.x + d.y) + (d.z + d.w));
    return rsqrtf(s * (1.f / DM) + EPS);
}

struct EpiModCvec {
    static constexpr int PID = 40;
    static constexpr bool PERM = false, AFTER_DRAIN = false;
    __device__ __forceinline__ void stage_dma(const pg8::Unit&) const {}
    float* C; int ldc; const float* bias; int rowmax; int adaln; bf16* ash;
    __device__ __forceinline__ void operator()(const f32x4 (&acc)[2][2][4][2], const pg8::Unit& u, int wr, int wc, int fr, int fq) const {
        const int colb = u.pn * 256 + wc * 32 + 4 * fq;
#pragma unroll
        for (int ai = 0; ai < 2; ++ai)
#pragma unroll
            for (int m = 0; m < 4; ++m) {
                const int row = ai * 128 + wr * 64 + m * 16 + fr;
                if (row < rowmax) {
#pragma unroll
                    for (int bj = 0; bj < 2; ++bj)
#pragma unroll
                        for (int n = 0; n < 2; ++n) {
                            const int col = colb + bj * 128 + n * 16; f32x4 v = acc[ai][bj][m][n];
                            if (adaln) {
                                const int l = col / 6144, cl = col - l * 6144, chunk = cl >> 10;
                                v = v + *(const f32x4*)(bias + col);
                                *(f32x4*)(C + ((size_t)l * NSEQ + row) * 6144 + cl) = v;
                                if (chunk == 0 || chunk == 3) { u32x2 w; w.x = pk2(v.x, v.y); w.y = pk2(v.z, v.w); *(u32x2*)(ash + ((size_t)(2 * l + (chunk == 3)) * 256 + row) * DM + (cl & 1023)) = w; }
                            } else {
                                *(f32x4*)(C + (size_t)row * ldc + col) = v;
                            }
                        }
                }
            }
    }
};
constexpr int EPL_OFF = 131072;
#define EPLP ((LAS float*)(size_t)EPL_OFF)
__device__ __forceinline__ void epi_dma(const float* rss, int pm, int pn, const float* v0, const float* v1, const float* v2, const float* v3, const float* v4) {
    int tid_ = threadIdx.x; asm volatile("" : "+v"(tid_)); const int tid = tid_, w = __builtin_amdgcn_readfirstlane(tid >> 6), lane = tid & 63;
    LAS unsigned char* e = (LAS unsigned char*)EPLP;
    if (rss) {
        const unsigned char* src = (const unsigned char*)(rss + (size_t)pm * 256 * 16);
        glds16(src + (size_t)tid * 16, e + 8192 + w * 1024); glds16(src + (size_t)(tid + 512) * 16, e + 8192 + 8192 + w * 1024);
    }
    const float* vp = w == 0 ? v0 : w == 1 ? v1 : w == 2 ? v2 : w == 3 ? v3 : w == 4 ? v4 : nullptr;
    if (vp) glds16((const unsigned char*)(vp + pn * 256) + lane * 16, e + 1024 + w * 1024);
}
__device__ __forceinline__ void epi_rstd(bool have) {
    int tid_ = threadIdx.x; asm volatile("" : "+v"(tid_)); const int tid = tid_;
    if (have && tid < 256) {
        const LAS f32x4* p = (const LAS f32x4*)(EPLP + 2048 + tid * 16); const f32x4 a = p[0], b = p[1], c = p[2], d = p[3];
        const float s = ((a.x + a.y) + (a.z + a.w)) + ((b.x + b.y) + (b.z + b.w)) + ((c.x + c.y) + (c.z + c.w)) + ((d.x + d.y) + (d.z + d.w));
        EPLP[tid] = rsqrtf(s * (1.f / DM) + EPS);
    }
    asm volatile("s_waitcnt lgkmcnt(0)" ::: "memory");
    __builtin_amdgcn_s_barrier();
    asm volatile("" ::: "memory");
}
struct EpiU {
    static constexpr int PID = 41;
    static constexpr bool PERM = true, AFTER_DRAIN = false;
    bf16* U; const float* rss; const float* cvec; int ldo; int ldcv;
    __device__ __forceinline__ void stage_dma(const pg8::Unit& u) const { epi_dma(rss, u.pm, u.pn, u.pm < 64 ? cvec + (size_t)(u.pm >> 3) * ldcv : nullptr, nullptr, nullptr, nullptr, nullptr); }
    __device__ __forceinline__ void operator()(const f32x4 (&acc)[2][2][4][2], const pg8::Unit& u, int wr, int wc, int fr, int fq) const {
        const bool prm = u.pm < 64;
        epi_rstd(true);
        const int cl = wc * 32 + 8 * fq, colb = u.pn * 256 + cl;
#pragma unroll
        for (int ai = 0; ai < 2; ++ai)
#pragma unroll
            for (int m = 0; m < 4; ++m) {
                const int rl = ai * 128 + wr * 64 + m * 16 + fr, row = u.pm * 256 + rl;
                const float rs = EPLP[rl];
                bf16* op = U + (size_t)row * ldo + colb;
#pragma unroll
                for (int bj = 0; bj < 2; ++bj) {
                    f32x4 c0, c1;
                    if (prm) { c0 = *(const LAS f32x4*)(EPLP + 256 + cl + bj * 128); c1 = *(const LAS f32x4*)(EPLP + 256 + cl + bj * 128 + 4); }
                    else { const float* cv = cvec + (size_t)seq_of_row(row) * ldcv + colb + bj * 128; c0 = *(const f32x4*)cv; c1 = *(const f32x4*)(cv + 4); }
                    const f32x4 v0 = acc[ai][bj][m][0] * rs + c0, v1 = acc[ai][bj][m][1] * rs + c1;
                    v4u w; w.x = pk2(v0.x, v0.y); w.y = pk2(v0.z, v0.w); w.z = pk2(v1.x, v1.y); w.w = pk2(v1.z, v1.w);
                    *(v4u*)(op + bj * 128) = w;
                }
            }
    }
};
struct EpiGate {
    static constexpr int PID = 42;
    static constexpr bool PERM = true, AFTER_DRAIN = false;
    __device__ __forceinline__ void stage_dma(const pg8::Unit& u) const { epi_dma(rss, u.pm, u.pn, u.pm < 64 ? cvec + (size_t)(u.pm >> 3) * DFF : nullptr, nullptr, nullptr, nullptr, nullptr); }
    bf16* GP; const float* rss; const float* cvec; float* fcp; float* fcs;
    __device__ __forceinline__ void operator()(const f32x4 (&acc)[2][2][4][2], const pg8::Unit& u, int wr, int wc, int fr, int fq) const {
        const bool prm = u.pm < 64;
        epi_rstd(true);
        const int cl = wc * 32 + 8 * fq, colb = u.pn * 256 + cl;
#pragma unroll
        for (int ai = 0; ai < 2; ++ai)
#pragma unroll
            for (int m = 0; m < 4; ++m) {
                const int rl = ai * 128 + wr * 64 + m * 16 + fr, row = u.pm * 256 + rl;
                const float rs = EPLP[rl]; const int s = seq_of_row(row);
                bf16* op = GP + (size_t)row * DFF + colb;
                float* st = nullptr;
                if (row < MP) { const int tt = row & (TSEQ - 1); if (tt >= TSEQ - 2) st = fcp + ((size_t)s * 2 + (tt - (TSEQ - 2))) * DFF + colb; }
                else { const int tt = row & 3; if (tt >= 2) st = fcs + ((size_t)(s - NBP) * 2 + (tt - 2)) * DFF + colb; }
#pragma unroll
                for (int bj = 0; bj < 2; ++bj) {
                    f32x4 c0, c1;
                    if (prm) { c0 = *(const LAS f32x4*)(EPLP + 256 + cl + bj * 128); c1 = *(const LAS f32x4*)(EPLP + 256 + cl + bj * 128 + 4); }
                    else { const float* cv = cvec + (size_t)s * DFF + colb + bj * 128; c0 = *(const f32x4*)cv; c1 = *(const f32x4*)(cv + 4); }
                    const f32x4 v0 = acc[ai][bj][m][0] * rs + c0, v1 = acc[ai][bj][m][1] * rs + c1;
                    v4u w; w.x = pk2(v0.x, v0.y); w.y = pk2(v0.z, v0.w); w.z = pk2(v1.x, v1.y); w.w = pk2(v1.z, v1.w);
                    *(v4u*)(op + bj * 128) = w;
                    if (st) { *(f32x4*)(st + bj * 128) = v0; *(f32x4*)(st + bj * 128 + 4) = v1; }
                }
            }
    }
};
struct EpiUp {
    static constexpr int PID = 43;
    static constexpr bool PERM = true, AFTER_DRAIN = false;
    __device__ __forceinline__ void stage_dma(const pg8::Unit& u) const { epi_dma(rss, u.pm, u.pn, u.pm < 64 ? cvec + (size_t)(u.pm >> 3) * DFF : nullptr, cw, cw + DFF, cw + 2 * DFF, cb); }
    bf16* ACT; const bf16* GP; const float* rss; const float* cvec; const float* cw; const float* cb; const float* sfc;
    template <int BY> static __device__ __forceinline__ unsigned nb(unsigned cur, unsigned prev) {
        const unsigned p = (unsigned)__builtin_amdgcn_update_dpp(0, (int)prev, BY == 1 ? 0x121 : 0x122, 0xF, 0xF, true);
        return (unsigned)__builtin_amdgcn_update_dpp((int)p, (int)cur, BY == 1 ? 0x111 : 0x112, 0xF, 0xF, false);
    }
    static __device__ __forceinline__ float su(float g, float uu) { return g * uu * __builtin_amdgcn_rcpf(1.f + __builtin_amdgcn_exp2f(g)); }
    __device__ __forceinline__ void operator()(const f32x4 (&acc)[2][2][4][2], const pg8::Unit& u, int wr, int wc, int fr, int fq) const {
        constexpr float NLN2 = -0.6931471805599453f, NL2E = -1.4426950408889634f;
        const bool prm = u.pm < 64;
        const int cl = wc * 32 + 8 * fq, colb = u.pn * 256 + cl;
        const int rw = u.pm * 256 + wr * 64 + fr;
        v4u rb[5];
#define EU_LD(it, k) (*(const v4u*)(GP + (size_t)max(rw + ((it) >> 1) * 128 + 16 * ((k) - 1), 0) * DFF + colb + ((it) & 1) * 128))
#pragma unroll
        for (int k = 0; k < 5; ++k) rb[k] = EU_LD(0, k);
        {
            int tid_ = threadIdx.x; asm volatile("" : "+v"(tid_)); const int tid = tid_;
            if (tid < 256) {
                const LAS f32x4* p = (const LAS f32x4*)(EPLP + 2048 + tid * 16); const f32x4 a = p[0], b = p[1], c = p[2], d = p[3];
                const float s = ((a.x + a.y) + (a.z + a.w)) + ((b.x + b.y) + (b.z + b.w)) + ((c.x + c.y) + (c.z + c.w)) + ((d.x + d.y) + (d.z + d.w));
                EPLP[tid] = rsqrtf(s * (1.f / DM) + EPS) * NLN2;
            } else {
                LAS float* q = EPLP + tid;
                const float c0 = q[0], w0 = q[256], w1 = q[512], w2 = q[768], bb = q[1024];
                q[0] = c0 * NLN2; q[256] = w0 * NL2E; q[512] = w1 * NL2E; q[768] = w2 * NL2E; q[1024] = bb * NL2E;
            }
            asm volatile("s_waitcnt lgkmcnt(0)" ::: "memory");
            __builtin_amdgcn_s_barrier();
            asm volatile("" ::: "memory");
        }
#pragma unroll
        for (int it = 0; it < 4; ++it) {
            const int ai = it >> 1, bj = it & 1;
            const int cc = colb + bj * 128, lc = cl + bj * 128;
#pragma unroll
            for (int m = 0; m < 4; ++m) {
                const int rl = ai * 128 + wr * 64 + m * 16 + fr, row = u.pm * 256 + rl;
                const float rs = EPLP[rl];
                const v4u cur = rb[m + 1], prv = rb[m];
                unsigned wq[4];
#pragma unroll
                for (int hf = 0; hf < 2; ++hf) {
                    const unsigned q0 = hf ? cur.z : cur.x, q1 = hf ? cur.w : cur.y, v0 = hf ? prv.z : prv.x, v1 = hf ? prv.w : prv.y;
                    const unsigned p0 = nb<1>(q0, v0), p1 = nb<1>(q1, v1), o0 = nb<2>(q0, v0), o1 = nb<2>(q1, v1);
                    const f32x4 g0 = (f32x4){bflo(q0), bfhi(q0), bflo(q1), bfhi(q1)};
                    f32x4 g1 = (f32x4){bflo(p0), bfhi(p0), bflo(p1), bfhi(p1)}, g2 = (f32x4){bflo(o0), bfhi(o0), bflo(o1), bfhi(o1)}, c0;
                    if (prm) {
                        if (ai == 0 && m == 0) {
                            if (wr == 0 && (u.pm & 7) == 0) { const f32x4 z4 = (f32x4){0.f, 0.f, 0.f, 0.f}; if (fr < 1) g1 = z4; if (fr < 2) g2 = z4; }
                        }
                        c0 = *(const LAS f32x4*)(EPLP + 256 + lc + 4 * hf);
                    } else {
                        const int tt = row & 3, s = seq_of_row(row);
                        if (tt < 1) g1 = *(const f32x4*)(sfc + ((size_t)(s - NBP) * 2 + 1) * DFF + cc + 4 * hf);
                        if (tt < 2) g2 = *(const f32x4*)(sfc + ((size_t)(s - NBP) * 2 + tt) * DFF + cc + 4 * hf);
                        c0 = *(const f32x4*)(cvec + (size_t)s * DFF + cc + 4 * hf) * NLN2;
                    }
                    const f32x4 uu = acc[ai][bj][m][hf] * rs + c0;
                    const f32x4 ga = *(const LAS f32x4*)(EPLP + 512 + lc + 4 * hf) * g2 + *(const LAS f32x4*)(EPLP + 768 + lc + 4 * hf) * g1 + *(const LAS f32x4*)(EPLP + 1024 + lc + 4 * hf) * g0 + *(const LAS f32x4*)(EPLP + 1280 + lc + 4 * hf);
                    wq[2 * hf] = pk2(su(ga.x, uu.x), su(ga.y, uu.y)); wq[2 * hf + 1] = pk2(su(ga.z, uu.z), su(ga.w, uu.w));
                }
                v4u w; w.x = wq[0]; w.y = wq[1]; w.z = wq[2]; w.w = wq[3];
                *(v4u*)(ACT + (size_t)row * DFF + cc) = w;
                if (it < 3) { rb[m] = EU_LD(it + 1, m); if (m == 3) rb[4] = EU_LD(it + 1, 4); }
            }
        }
#undef EU_LD
    }
};
template <int XM>
struct EpiRes {
    static constexpr int PID = 44;
    static constexpr bool PERM = false, AFTER_DRAIN = false;
    const float* xinP; const bf16* XRin; bf16* XRout; const float* gvec; const float* scn; const float* gamma; bf16* XS; float* rss;
    __device__ __forceinline__ void stage_dma(const pg8::Unit& u) const { const int s0 = u.pm >> 3; epi_dma(nullptr, u.pm, u.pn, gvec + (size_t)s0 * 6144, scn ? scn + (size_t)s0 * 6144 : nullptr, scn ? gamma : nullptr, nullptr, nullptr); }
    __device__ __forceinline__ void row_out(const f32x4 (&xr)[2][2], const f32x4 (&acc)[2][2][4][2], int ai, int m, const pg8::Unit& u, int wr, int wc, int fr, int fq, int cl) const {
        const int row = u.pm * 256 + ai * 128 + wr * 64 + m * 16 + fr;
        float ss = 0.f;
#pragma unroll
        for (int bj = 0; bj < 2; ++bj)
#pragma unroll
            for (int n = 0; n < 2; ++n) {
                const int lc = cl + bj * 128 + n * 16, col = u.pn * 256 + lc;
                const f32x4 xn = xr[bj][n] + *(const LAS f32x4*)(EPLP + 256 + lc) * acc[ai][bj][m][n];
                { u32x2 w; w.x = pk2(xn.x, xn.y); w.y = pk2(xn.z, xn.w); *(u32x2*)(XRout + (size_t)row * DM + col) = w; }
                ss += (xn.x * xn.x + xn.y * xn.y) + (xn.z * xn.z + xn.w * xn.w);
                if (scn) { const f32x4 v = xn * *(const LAS f32x4*)(EPLP + 768 + lc) * (*(const LAS f32x4*)(EPLP + 512 + lc) + 1.f);
                    u32x2 w; w.x = pk2(v.x, v.y); w.y = pk2(v.z, v.w); *(u32x2*)(XS + (size_t)row * DM + col) = w; }
            }
        ss += __shfl_xor(ss, 16); ss += __shfl_xor(ss, 32);
        if (fq == 0) rss[(size_t)row * 16 + u.pn * 4 + wc] = ss;
    }
    __device__ __forceinline__ void operator()(const f32x4 (&acc)[2][2][4][2], const pg8::Unit& u, int wr, int wc, int fr, int fq) const {
        epi_rstd(false);
        const int cl = wc * 32 + 4 * fq, colb = u.pn * 256 + cl;
        if (XM == 0) {
#pragma unroll
            for (int ai = 0; ai < 2; ++ai)
#pragma unroll
                for (int mp = 0; mp < 2; ++mp) {
                    f32x4 xr[2][2][2];
#pragma unroll
                    for (int m2 = 0; m2 < 2; ++m2) { const size_t ro = (size_t)(u.pm * 256 + ai * 128 + wr * 64 + (2 * mp + m2) * 16 + fr) * DM + colb;
#pragma unroll
                        for (int bj = 0; bj < 2; ++bj)
#pragma unroll
                            for (int n = 0; n < 2; ++n) xr[m2][bj][n] = *(const f32x4*)(xinP + ro + bj * 128 + n * 16); }
#pragma unroll
                    for (int m2 = 0; m2 < 2; ++m2) row_out(xr[m2], acc, ai, 2 * mp + m2, u, wr, wc, fr, fq, cl);
                }
        } else {
#pragma unroll
            for (int ai = 0; ai < 2; ++ai) {
                u32x2 xq[4][2][2];
#pragma unroll
                for (int m = 0; m < 4; ++m) { const size_t ro = (size_t)(u.pm * 256 + ai * 128 + wr * 64 + m * 16 + fr) * DM + colb;
#pragma unroll
                    for (int bj = 0; bj < 2; ++bj)
#pragma unroll
                        for (int n = 0; n < 2; ++n) xq[m][bj][n] = *(const u32x2*)(XRin + ro + bj * 128 + n * 16); }
#pragma unroll
                for (int m = 0; m < 4; ++m) {
                    f32x4 xr[2][2];
#pragma unroll
                    for (int bj = 0; bj < 2; ++bj)
#pragma unroll
                        for (int n = 0; n < 2; ++n) { const u32x2 r = xq[m][bj][n]; xr[bj][n] = (f32x4){bflo(r.x), bfhi(r.x), bflo(r.y), bfhi(r.y)}; }
                    row_out(xr, acc, ai, m, u, wr, wc, fr, fq, cl);
                }
            }
        }
    }
};
struct OneUnit {
    int pn;
    __device__ __forceinline__ bool next(int i, pg8::Unit& u) const { if (i > 0 || pn < 0) return false; u.pm = 0; u.pn = pn; return true; }
    __device__ __forceinline__ void a_ready(const pg8::Unit&) const {}
    __device__ __forceinline__ void done(const pg8::Unit&) const {}
};

#ifndef DBL_LOADS
#define DBL_LOADS 0
#endif
#ifndef PROBE_REGION
#define PROBE_REGION 0
#endif
#ifndef PROBE_VCU
#define PROBE_VCU 0
#endif
#define RB(id) do { if (PROBE_REGION == (id) && C.vcu == PROBE_VCU && threadIdx.x == 0) ((volatile LAS unsigned long long*)(ldsq(C) + MISC_OFF + 64))[0] = __builtin_amdgcn_s_memrealtime(); } while (0)
#define RE(id) do { if (PROBE_REGION == (id) && C.vcu == PROBE_VCU && threadIdx.x == 0) { volatile LAS unsigned long long* q_ = (volatile LAS unsigned long long*)(ldsq(C) + MISC_OFF + 64); q_[1] = q_[1] + (__builtin_amdgcn_s_memrealtime() - q_[0]); } } while (0)
__device__ __forceinline__ void st16_wt(unsigned char* ws, size_t off, const v4u v) {
    const __amdgpu_buffer_rsrc_t r = __builtin_amdgcn_make_buffer_rsrc(ws, (short)0, (int)WS_END, 0x00020000);
    __builtin_amdgcn_raw_buffer_store_b128(v, r, (unsigned)off, 0, 16);
}
__device__ __forceinline__ void st8_wt(void* p, const u32x2 v) { __hip_atomic_store((unsigned long long*)p, (unsigned long long)v.x | ((unsigned long long)v.y << 32), __ATOMIC_RELAXED, __HIP_MEMORY_SCOPE_AGENT); }
__device__ __forceinline__ void st4_wt(float* p, float v) { __hip_atomic_store((unsigned*)p, __builtin_bit_cast(unsigned, v), __ATOMIC_RELAXED, __HIP_MEMORY_SCOPE_AGENT); }
__device__ __forceinline__ void publish_add(unsigned* cnt) {
    if (!cnt) { __syncthreads(); return; }
    asm volatile("s_waitcnt vmcnt(0)" ::: "memory");
    __syncthreads();
    if (threadIdx.x == 0) (void)__hip_atomic_fetch_add(cnt, 1u, __ATOMIC_RELAXED, __HIP_MEMORY_SCOPE_AGENT);
}
__device__ __forceinline__ void poll_acquire(unsigned* cnt, unsigned need) {
    unsigned sp = 0;
    while (__hip_atomic_load(cnt, __ATOMIC_RELAXED, __HIP_MEMORY_SCOPE_AGENT) < need) { __builtin_amdgcn_s_sleep(2); if (++sp > (1u << 22)) break; }
    __builtin_amdgcn_fence(__ATOMIC_ACQUIRE, "agent");
    asm volatile("s_waitcnt vmcnt(0)" ::: "memory");
}
__device__ __forceinline__ float wave_sum(float v) {
#pragma unroll
    for (int o = 1; o < 64; o <<= 1) v += __shfl_xor(v, o);
    return v;
}
template <int MODE>
__device__ __forceinline__ void tr_item(const float* W, int N, int K, bf16* WT, int nblk, LAS float* scr, int item, int lane) {
    const int kb = item / nblk, nb = item - kb * nblk, k0 = 64 * kb, n0 = 64 * nb;
    const int c4 = (lane & 15) * 4, r0 = lane >> 4;
    int sc = n0 + c4;
    if (MODE == 1) { const int np = sc; sc = np < 3072 ? np : (np < 3584 ? np + 8 : (np < 3592 ? np - 512 : -1)); }
    f32x4 tv[16];
#pragma unroll
    for (int i = 0; i < 16; ++i) tv[i] = sc >= 0 ? *(const f32x4*)(W + (size_t)(k0 + 4 * i + r0) * N + sc) : (f32x4){0.f, 0.f, 0.f, 0.f};
#pragma unroll
    for (int i = 0; i < 16; ++i) { LAS float* d = scr + (4 * i + r0) * 65 + c4; d[0] = tv[i].x; d[1] = tv[i].y; d[2] = tv[i].z; d[3] = tv[i].w; }
    LDS_WAIT(); asm volatile("" ::: "memory");
    const int c = lane & 7;
#pragma unroll
    for (int j = 0; j < 8; ++j) { const int n = (lane >> 3) + 8 * j; const LAS float* s = scr + (8 * c) * 65 + n;
        v4u o; o.x = pk2(s[0 * 65], s[1 * 65]); o.y = pk2(s[2 * 65], s[3 * 65]); o.z = pk2(s[4 * 65], s[5 * 65]); o.w = pk2(s[6 * 65], s[7 * 65]);
        *(GAS v4u*)(WT + (size_t)(n0 + n) * K + k0 + 8 * c) = o; }
    LDS_WAIT(); asm volatile("" ::: "memory");
}
__device__ __forceinline__ void tr_job(Ctx& C, const float* W, bf16* WT, int N, int K, int mode, int ndest, int gw, int ngw, int& base) {
    int tid_ = threadIdx.x; asm volatile("" : "+v"(tid_)); const int lane = tid_ & 63; (void)lane;
    LAS float* scr = (LAS float*)(ldsq(C) + C.wave * 16640);
    const int nblk = ndest / 64, nit = nblk * (K / 64);
    int it = gw - (base % ngw); if (it < 0) it += ngw;
    for (; it < nit; it += ngw) { if (mode == 1) tr_item<1>(W, N, K, WT, nblk, scr, it, lane); else tr_item<0>(W, N, K, WT, nblk, scr, it, lane); }
    base += nit;
}
__device__ __forceinline__ void phase_p0(Ctx& C) {
    const int gw = C.vcu * NWAVES + C.wave, ngw = C.G * NWAVES;
    bf16* wada = (bf16*)(wsq(C) + WS_WADA);
    int base = 0;
    tr_job(C, inptr(I_WADA), wada, 6144, DM, 0, 6144, gw, ngw, base);
    tr_job(C, inptr(I_WADA) + (size_t)DM * 6144, wada + (size_t)6144 * DM, 6144, DM, 0, 6144, gw, ngw, base);
    bf16* ac = (bf16*)(wsq(C) + WS_AC);
    int tid_ = threadIdx.x; asm volatile("" : "+v"(tid_)); const int lane = tid_ & 63; (void)lane;
    for (int r = gw; r < NSEQ; r += ngw) {
        const float* src = r < NBP ? inptr(I_CP) + (size_t)r * DM : inptr(I_CS) + (size_t)(r - NBP) * DM;
#pragma unroll
        for (int j = 0; j < 4; ++j) { const f32x4 v = *(const f32x4*)(src + 256 * j + 4 * lane);
            u32x2 w; w.x = pk2(siluf(v.x), siluf(v.y)); w.y = pk2(siluf(v.z), siluf(v.w)); *(u32x2*)(ac + (size_t)r * DM + 256 * j + 4 * lane) = w; }
    }
}
__device__ __forceinline__ void x_to_xs(Ctx& C, int gw, int ngw) {
    const float* mod = (const float*)(wsq(C) + WS_MOD); bf16* xs = (bf16*)(wsq(C) + WS_XS); float* rss = (float*)(wsq(C) + WS_RSS);
    const float* gam = inptr(I_NMIX); const float* xp_ = inptr(I_XP); const float* xs_ = inptr(I_XS);
    int tid_ = threadIdx.x; asm volatile("" : "+v"(tid_)); const int lane = tid_ & 63; (void)lane;
    for (int row = gw; row < MROWS; row += ngw) {
        const float* src = row < MP ? xp_ + (size_t)row * DM : xs_ + (size_t)(row - MP) * DM;
        const int s = seq_of_row(row); const float* sc = mod + (size_t)s * 6144 + 1024;
        float ss = 0.f;
#pragma unroll
        for (int j = 0; j < 4; ++j) { const int col = 256 * j + 4 * lane; const f32x4 v = *(const f32x4*)(src + col);
            ss += (v.x * v.x + v.y * v.y) + (v.z * v.z + v.w * v.w);
            const f32x4 o = v * *(const f32x4*)(gam + col) * (*(const f32x4*)(sc + col) + 1.f);
            u32x2 w; w.x = pk2(o.x, o.y); w.y = pk2(o.z, o.w); *(u32x2*)(xs + (size_t)row * DM + col) = w; }
        ss = wave_sum(ss);
        if (lane < 16) rss[(size_t)row * 16 + lane] = lane == 0 ? ss : 0.f;
    }
}
__device__ __forceinline__ void phase_final(Ctx& C) {
    const int gw = C.vcu * NWAVES + C.wave, ngw = C.G * NWAVES;
    const float* rss = (const float*)(wsq(C) + WS_RSS); const float* gam = inptr(I_FNORM);
    int tid_ = threadIdx.x; asm volatile("" : "+v"(tid_)); const int lane = tid_ & 63; (void)lane;
    for (int row = gw; row < MROWS; row += ngw) {
        const float rs = rstd_of(rss, row); float* p = outq(C) + (size_t)row * DM; const bf16* xr = (const bf16*)(wsq(C) + WS_XR) + (size_t)row * DM;
#pragma unroll
        for (int j = 0; j < 4; ++j) { const int col = 256 * j + 4 * lane; const u32x2 r = *(const u32x2*)(xr + col);
            *(f32x4*)(p + col) = (f32x4){bflo(r.x), bfhi(r.x), bflo(r.y), bfhi(r.y)} * rs * *(const f32x4*)(gam + col); }
    }
}

typedef float f32x2 __attribute__((ext_vector_type(2)));
template <int I0>
__device__ __forceinline__ void solve2_rows(f32x2 (&m)[32], f32x4 (&ar)[2][8], f32x2 (&rr)[2], float (&rb)[2], float (&re)[2],
                                            const LAS float* AM, const LAS float* F32, const LAS float* SC, int half, int cp) {
#pragma unroll
        for (int ii = 0; ii < 16; ++ii) {
            const int i = I0 + ii;
            const int cur = i & 1, nxt = cur ^ 1;
            if (i + 1 < 64) {
                const int njn = (i + 2) >> 1;
#pragma unroll
                for (int q = 0; q * 4 < njn; ++q) ar[nxt][q] = *(const LAS f32x4*)(AM + (i + 1) * 68 + half * 32 + 4 * q);
                rr[nxt] = (f32x2){F32[(i + 1) * 388 + 256 + cp], F32[(i + 1) * 388 + 128 + cp]}; rb[nxt] = SC[128 + i + 1]; re[nxt] = SC[256 + i + 1];
            }
            const f32x2 rhs = rr[cur] * (f32x2){rb[cur], rb[cur] * re[cur]};
            f32x2 p0 = (f32x2){0.f, 0.f}, p1 = p0, p2 = p0, p3 = p0;
            const int nj = (i + 1) >> 1;
#pragma unroll
            for (int q = 0; q * 4 < nj; ++q) {
                const f32x4 a = ar[cur][q];
                p0 += a.x * m[4 * q];
                if (4 * q + 1 < nj) p1 += a.y * m[4 * q + 1];
                if (4 * q + 2 < nj) p2 += a.z * m[4 * q + 2];
                if (4 * q + 3 < nj) p3 += a.w * m[4 * q + 3];
            }
            const f32x2 part = (p0 + p1) + (p2 + p3);
            float px = part.x, py = part.y; asm volatile("" : "+v"(px), "+v"(py));
            const float ox = __builtin_bit_cast(float, __builtin_amdgcn_update_dpp(0, __builtin_bit_cast(int, px), 0xB1, 0xF, 0xF, true));
            const float oy = __builtin_bit_cast(float, __builtin_amdgcn_update_dpp(0, __builtin_bit_cast(int, py), 0xB1, 0xF, 0xF, true));
            const f32x2 sol = (f32x2){rhs.x - (px + ox), rhs.y - (py + oy)};
            const bool own = (i & 1) == half;
            m[i >> 1] = own ? sol : m[i >> 1];
        }
}
__device__ __forceinline__ void gdn_prep_item(Ctx& C, int l, int b, int h, int n, unsigned* pend) {
    int tid_ = threadIdx.x; asm volatile("" : "+v"(tid_)); const int tid = tid_, lane = tid & 63, wave = __builtin_amdgcn_readfirstlane(tid >> 6);
    LAS float* F32 = (LAS float*)(ldsq(C));
    LAS unsigned short* KH = (LAS unsigned short*)(ldsq(C) + 99328);
    LAS unsigned short* QH = (LAS unsigned short*)(ldsq(C) + 116736);
    LAS float* AM = (LAS float*)(ldsq(C) + 134144);
    LAS float* SC = (LAS float*)(ldsq(C) + 151552);
    LAS unsigned* attdone = (LAS unsigned*)(ldsq(C) + MISC_OFF + 112);
    if (tid == 0) __hip_atomic_store(attdone, 0u, __ATOMIC_RELAXED, __HIP_MEMORY_SCOPE_WORKGROUP);
    const bf16* U = (const bf16*)(wsq(C) + WS_U);
    const int row0 = b * TSEQ + n * 64;
    const int idx = (b * 4 + h) * 32 + n;
#ifndef REP_STEPA
#define REP_STEPA 1
#endif
    for (int rpa_ = 0; rpa_ < REP_STEPA; ++rpa_)
    if (tid < 384) {
        const int cg = tid % 48, rs = tid / 48, which = cg >> 4, cc = (cg & 15) * 8;
        const int ucol = C_Q + which * 512 + h * 128 + cc, wcol = which * 512 + h * 128 + cc;
        const float* cw = inptr(I_GCW) + (size_t)l * 4 * 1536 + wcol;
        float w[4][8];
#pragma unroll
        for (int k = 0; k < 4; ++k) { const f32x4 a = *(const f32x4*)(cw + k * 1536), bq = *(const f32x4*)(cw + k * 1536 + 4);
            w[k][0] = a.x; w[k][1] = a.y; w[k][2] = a.z; w[k][3] = a.w; w[k][4] = bq.x; w[k][5] = bq.y; w[k][6] = bq.z; w[k][7] = bq.w; }
        const int t0 = 8 * rs;
        v4u rr[11];
#pragma unroll
        for (int k = 0; k < 11; ++k) { const int tg = n * 64 + t0 - 3 + k; rr[k] = *(const v4u*)(U + (size_t)(b * TSEQ + (tg < 0 ? 0 : tg)) * LDU + ucol); if (tg < 0) rr[k] = (v4u){0u, 0u, 0u, 0u}; }
        if (n == 31 && rs == 7) {
#pragma unroll
            for (int k = 0; k < 3; ++k) { float* gp = outq(C) + O_GCP + ((size_t)(l * NBP + b) * 3 + k) * 1536 + wcol; const v4u r = rr[8 + k];
                *(f32x4*)gp = (f32x4){bflo(r.x), bfhi(r.x), bflo(r.y), bfhi(r.y)}; *(f32x4*)(gp + 4) = (f32x4){bflo(r.z), bfhi(r.z), bflo(r.w), bfhi(r.w)}; }
        }
#pragma unroll
        for (int j = 0; j < 8; ++j) {
            LAS float* dst = F32 + (t0 + j) * 388 + cg * 8;
            float y[8];
#pragma unroll
            for (int i = 0; i < 8; ++i) y[i] = 0.f;
#pragma unroll
            for (int k = 0; k < 4; ++k) { const v4u r = rr[j + k];
                y[0] += w[k][0] * bflo(r.x); y[1] += w[k][1] * bfhi(r.x); y[2] += w[k][2] * bflo(r.y); y[3] += w[k][3] * bfhi(r.y);
                y[4] += w[k][4] * bflo(r.z); y[5] += w[k][5] * bfhi(r.z); y[6] += w[k][6] * bflo(r.w); y[7] += w[k][7] * bfhi(r.w); }
#pragma unroll
            for (int i = 0; i < 8; ++i) dst[i] = siluf(y[i]);
        }
    } else if (wave == 7) {
        const int t = lane; const bf16* ur = U + (size_t)(row0 + t) * LDU;
        const float ga = bf2f(ur[C_GA + h]), gb = bf2f(ur[C_GB + h]);
        const float g = -__expf(inptr(I_GALOG)[l * 4 + h]) * softplusf(ga + inptr(I_GDTB)[l * 4 + h]);
        float cs = g;
#pragma unroll
        for (int o = 1; o < 64; o <<= 1) { const float v = __shfl_up(cs, o); if (lane >= o) cs += v; }
        SC[128 + t] = sigm(gb); SC[192 + t] = cs; SC[256 + t] = __expf(cs);
    }
    if (pend) asm volatile("s_waitcnt vmcnt(0)" ::: "memory");
    __syncthreads();
    if (pend && tid == 0) (void)__hip_atomic_fetch_add(pend, 1u, __ATOMIC_RELAXED, __HIP_MEMORY_SCOPE_AGENT);
    {
        const int p = tid >> 2, sub = tid & 3, t = p & 63, which = p >> 6;
        const LAS f32x4* src = (const LAS f32x4*)(F32 + t * 388 + which * 128 + sub * 32);
        float s = 0.f;
#pragma unroll
        for (int i = 0; i < 8; ++i) { const f32x4 v = src[i]; s += (v.x * v.x + v.y * v.y) + (v.z * v.z + v.w * v.w); }
        s += __builtin_bit_cast(float, __builtin_amdgcn_update_dpp(0, __builtin_bit_cast(int, s), 0xB1, 0xF, 0xF, true));
        s += __builtin_bit_cast(float, __builtin_amdgcn_update_dpp(0, __builtin_bit_cast(int, s), 0x4E, 0xF, 0xF, true));
        if (sub == 0) SC[which * 64 + t] = rsqrtf(s + EPS) * (which == 0 ? 0.08838834764831845f : 1.f);
    }
    __syncthreads();
    {
        const int t = tid >> 3, cs = (tid & 7) * 16; const float rq = SC[t], rk = SC[64 + t];
        LAS f32x4* qrow = (LAS f32x4*)(F32 + t * 388 + cs); LAS f32x4* krow = (LAS f32x4*)(F32 + t * 388 + 128 + cs);
        f32x4 q4[4], k4[4];
#pragma unroll
        for (int i = 0; i < 4; ++i) { q4[i] = qrow[i] * rq; k4[i] = krow[i] * rk; qrow[i] = q4[i]; krow[i] = k4[i]; }
        *(LAS bf16x8*)(QH + t * 136 + cs) = pack8(q4[0], q4[1]); *(LAS bf16x8*)(QH + t * 136 + cs + 8) = pack8(q4[2], q4[3]);
        *(LAS bf16x8*)(KH + t * 136 + cs) = pack8(k4[0], k4[1]); *(LAS bf16x8*)(KH + t * 136 + cs + 8) = pack8(k4[2], k4[3]);
    }
    __syncthreads();
    LAS unsigned short* ATL = (LAS unsigned short*)(ldsq(C) + 152832);
#define GP_TILE(which, mt, nt) do { \
        const int g_ = lane >> 4, c_ = lane & 15; \
        f32x4 acc_ = (f32x4){0.f, 0.f, 0.f, 0.f}; \
        if ((mt) >= (nt)) { \
            const LAS unsigned short* ap_ = ((which) ? QH : KH) + (16 * (mt) + c_) * 136 + 8 * g_; \
            const LAS unsigned short* bp_ = KH + (16 * (nt) + c_) * 136 + 8 * g_; \
            _Pragma("unroll") for (int s_ = 0; s_ < 4; ++s_) acc_ = mfma16(*(const LAS bf16x8*)(ap_ + 32 * s_), *(const LAS bf16x8*)(bp_ + 32 * s_), acc_); \
        } \
        const int sidx_ = 16 * (nt) + c_; const float gcs_ = SC[192 + sidx_]; \
        _Pragma("unroll") for (int r_ = 0; r_ < 4; ++r_) { \
            const int t_ = 16 * (mt) + 4 * g_ + r_; const float dec_ = __expf(SC[192 + t_] - gcs_); \
            if ((which) == 0) AM[t_ * 68 + (sidx_ & 1) * 32 + (sidx_ >> 1)] = (sidx_ < t_) ? SC[128 + t_] * acc_[r_] * dec_ : 0.f; \
            else ATL[t_ * 72 + (sidx_ & 32) + permpos(sidx_ & 31)] = f2bfs((sidx_ <= t_) ? acc_[r_] * dec_ : 0.f); \
        } } while (0)
    for (int k = wave; k < 10; k += 8) { const int mt = (k >= 6) ? 3 : (k >= 3) ? 2 : (k >= 1) ? 1 : 0, nt = k - (mt * (mt + 1)) / 2; GP_TILE(0, mt, nt); }
    __syncthreads();
    float kv[2][4][4];
    if (wave < 4) {
        const int cp = tid >> 1, half = tid & 1;
        f32x2 m2[32];
#pragma unroll
        for (int i = 0; i < 32; ++i) m2[i] = (f32x2){0.f, 0.f};
        f32x4 ar[2][8]; f32x2 rr[2]; float rb[2], re[2];
        ar[0][0] = *(const LAS f32x4*)(AM + half * 32); rr[0] = (f32x2){F32[256 + cp], F32[128 + cp]}; rb[0] = SC[128]; re[0] = SC[256];
        solve2_rows<0>(m2, ar, rr, rb, re, AM, F32, SC, half, cp); solve2_rows<16>(m2, ar, rr, rb, re, AM, F32, SC, half, cp);
        solve2_rows<32>(m2, ar, rr, rb, re, AM, F32, SC, half, cp); solve2_rows<48>(m2, ar, rr, rb, re, AM, F32, SC, half, cp);
        while (__hip_atomic_load(attdone, __ATOMIC_ACQUIRE, __HIP_MEMORY_SCOPE_WORKGROUP) < 4u) {}
        const int dpos = (cp & ~31) + permpos(cp & 31);
#pragma unroll
        for (int jj = 0; jj < 32; ++jj) { const int t = 2 * jj + half; QH[t * 136 + cp] = f2bfs(m2[jj].x); KH[t * 136 + dpos] = f2bfs(-m2[jj].y); }
    } else {
        for (int job = wave - 4; job < 16; job += 4) { const int mt = job >> 2, nt = job & 3; GP_TILE(1, mt, nt); }
        if (lane == 0) __hip_atomic_fetch_add(attdone, 1u, __ATOMIC_RELEASE, __HIP_MEMORY_SCOPE_WORKGROUP);
        const int t2 = tid - 256;
#pragma unroll
        for (int it = 0; it < 2; ++it) {
            const int tt = t2 + 256 * it, t = tt >> 3, ds = (tt & 7) * 16; const float e = SC[256 + t];
            bf16* QT = (bf16*)(wsq(C) + WS_PQ) + (size_t)idx * 8192 + t * 128;
#pragma unroll
            for (int gq = 0; gq < 4; ++gq) { const f32x4 v = *(const LAS f32x4*)(F32 + t * 388 + ds + 4 * gq) * e;
                u32x2 w; w.x = pk2(v.x, v.y); w.y = pk2(v.z, v.w); st8_wt(QT + (ds & ~31) + 8 * gq + 4 * ((ds >> 4) & 1), w); }
        }
        const int d = t2 & 127; const float gl = SC[192 + 63];
#pragma unroll
        for (int it = 0; it < 2; ++it) {
            const int tq = (t2 >> 7) * 2 + it;
#pragma unroll
            for (int gq = 0; gq < 4; ++gq)
#pragma unroll
                for (int i = 0; i < 4; ++i) { const int t = 16 * tq + 4 * gq + i; kv[it][gq][i] = F32[t * 388 + 128 + d] * __expf(gl - SC[192 + t]); }
        }
        if (t2 == 0) st4_wt((float*)(wsq(C) + WS_EGL) + idx, __expf(gl));
    }
    __syncthreads();
    if (wave >= 4) {
        const int t2 = tid - 256, d = t2 & 127;
        LAS unsigned short* KTL = (LAS unsigned short*)(ldsq(C) + 134144) + d * 64;
#pragma unroll
        for (int it = 0; it < 2; ++it) {
            const int tq = (t2 >> 7) * 2 + it;
#pragma unroll
            for (int gq = 0; gq < 4; ++gq) { u32x2 w; w.x = pk2(kv[it][gq][0], kv[it][gq][1]); w.y = pk2(kv[it][gq][2], kv[it][gq][3]); *(LAS u32x2*)(KTL + ((16 * tq) & ~31) + 8 * gq + 4 * (tq & 1)) = w; }
        }
    }
    __syncthreads();
    {
        unsigned char* wsb = wsq(C);
        const size_t pu = WS_PU + (size_t)idx * 16384, pw = WS_PW + (size_t)idx * 16384, pk = WS_PK + (size_t)idx * 16384, pa = WS_PA + (size_t)idx * 8192;
        LAS unsigned char* L = ldsq(C);
#pragma unroll
        for (int k = 0; k < 2; ++k) { const int e = tid + 512 * k, r = e >> 4, q = e & 15;
            st16_wt(wsb, pu + e * 16, *(const LAS v4u*)(L + 116736 + r * 272 + q * 16));
            st16_wt(wsb, pw + e * 16, *(const LAS v4u*)(L + 99328 + r * 272 + q * 16));
            st16_wt(wsb, pk + e * 16, *(const LAS v4u*)(L + 134144 + e * 16)); }
        { const int r = tid >> 3, q = tid & 7; st16_wt(wsb, pa + tid * 16, *(const LAS v4u*)(L + 152832 + r * 144 + q * 16)); }
    }
}

constexpr int GC_NW = 0, GC_QT = 16384, GC_KT = 32768, GC_AT = 49152, GC_UT = 57344, GC_BUF = 73728, GC_PART = 147456;
__device__ __forceinline__ void gdn_chain_issue(LAS unsigned char* lds, const unsigned char* ws, int idx, int buf, int tid, int wave) {
    LAS unsigned char* base = lds + buf * GC_BUF;
    const unsigned char* nw = ws + WS_PW + (size_t)idx * 16384; const unsigned char* qt = ws + WS_PQ + (size_t)idx * 16384;
    const unsigned char* kt = ws + WS_PK + (size_t)idx * 16384; const unsigned char* at = ws + WS_PA + (size_t)idx * 8192; const unsigned char* ut = ws + WS_PU + (size_t)idx * 16384;
#pragma unroll
    for (int i = 0; i < 2; ++i) {
        const int L = tid + 512 * i; const int wb = (i * 512 + wave * 64) * 16;
        { const int r = L >> 4, ps = L & 15, q = ps ^ (r & 15); glds16(nw + r * 256 + q * 16, base + GC_NW + wb); glds16(qt + r * 256 + q * 16, base + GC_QT + wb); }
        glds16(ut + L * 16, base + GC_UT + wb);
        { const int r = L >> 3, ps = L & 7, q = ps ^ ((r >> 1) & 7); glds16(kt + r * 128 + q * 16, base + GC_KT + wb); }
    }
    { const int L = tid; const int r = L >> 3, ps = L & 7, q = ps ^ ((r >> 1) & 7); glds16(at + r * 128 + q * 16, base + GC_AT + wave * 1024); }
}
__device__ __forceinline__ void gdn_chain_issue_h(LAS unsigned char* lds, const unsigned char* ws, int idx, int buf, int ht, int hw) {
    LAS unsigned char* base = lds + buf * GC_BUF;
    const unsigned char* nw = ws + WS_PW + (size_t)idx * 16384; const unsigned char* qt = ws + WS_PQ + (size_t)idx * 16384;
    const unsigned char* kt = ws + WS_PK + (size_t)idx * 16384; const unsigned char* at = ws + WS_PA + (size_t)idx * 8192; const unsigned char* ut = ws + WS_PU + (size_t)idx * 16384;
#pragma unroll
    for (int i = 0; i < 4; ++i) {
        const int L = ht + 256 * i; const int wb = (i * 256 + hw * 64) * 16;
        { const int r = L >> 4, ps = L & 15, q = ps ^ (r & 15); glds16(nw + r * 256 + q * 16, base + GC_NW + wb); glds16(qt + r * 256 + q * 16, base + GC_QT + wb); }
        glds16(ut + L * 16, base + GC_UT + wb);
        { const int r = L >> 3, ps = L & 7, q = ps ^ ((r >> 1) & 7); glds16(kt + r * 128 + q * 16, base + GC_KT + wb); }
    }
#pragma unroll
    for (int i = 0; i < 2; ++i) { const int L = ht + 256 * i; const int r = L >> 3, ps = L & 7, q = ps ^ ((r >> 1) & 7); glds16(at + r * 128 + q * 16, base + GC_AT + (i * 256 + hw * 64) * 16); }
}
__device__ __forceinline__ void gdn_chain(Ctx& C, int l, int b, int h) {
    int tid_ = threadIdx.x; asm volatile("" : "+v"(tid_)); const int tid = tid_, lane = tid & 63, w = __builtin_amdgcn_readfirstlane(tid >> 6), g = lane >> 4, c = lane & 15;
    LAS unsigned char* lds = ldsq(C);
    const bf16* U = (const bf16*)(wsq(C) + WS_U); bf16* O = (bf16*)(wsq(C) + WS_O);
    const float* egl_p = (const float*)(wsq(C) + WS_EGL);
    const int idx0 = (b * 4 + h) * 32;
    unsigned* gcnt = (unsigned*)((gu32*)(wsq(C) + WS_CTL) + CW_GCNT + l * 32 * 64);
    const bool helper = w >= 4;
    const int hw = w - 4, ht = tid - 256;
    if (tid == 256) {
        for (int k = 0; k < 6; ++k) { unsigned sp = 0; while (__hip_atomic_load(gcnt + 64 * k, __ATOMIC_RELAXED, __HIP_MEMORY_SCOPE_AGENT) < 32u) { __builtin_amdgcn_s_sleep(2); if (++sp > (1u << 22)) break; } }
        __builtin_amdgcn_fence(__ATOMIC_ACQUIRE, "agent"); asm volatile("s_waitcnt vmcnt(0)" ::: "memory");
    }
    __syncthreads();
    if (helper) gdn_chain_issue_h(lds, wsq(C), idx0, 0, ht, hw);
    asm volatile("s_waitcnt vmcnt(0)" ::: "memory");
    __syncthreads();
    if (!helper) {
        const int e0 = 32 * w;
        f32x4 S[8][2];
#pragma unroll
        for (int i = 0; i < 8; ++i) { S[i][0] = (f32x4){0.f, 0.f, 0.f, 0.f}; S[i][1] = S[i][0]; }
        const int xa = c * 256 + (((c & 12) + (g ^ (c & 3))) << 4);
        const int m3 = (c >> 1) & 7;
        const int xk = c * 128 + (((m3 & 4) + (g ^ (m3 & 3))) << 4);
        for (int n = 0; n <= 32; ++n) {
            if (n < 32) {
                const int buf = n & 1;
                LAS unsigned char* B = lds + buf * GC_BUF;
                LAS unsigned short* UT = (LAS unsigned short*)(B + GC_UT);
                const float egl = egl_p[idx0 + n];
                f32x4 vn[4][2], o[4][2];
#pragma unroll
                for (int mt = 0; mt < 4; ++mt)
#pragma unroll
                    for (int j = 0; j < 2; ++j) { const LAS unsigned short* up = UT + (16 * mt + 4 * g) * 128 + e0 + 16 * j + c;
                        vn[mt][j] = (f32x4){bf2f(up[0]), bf2f(up[128]), bf2f(up[256]), bf2f(up[384])}; o[mt][j] = (f32x4){0.f, 0.f, 0.f, 0.f}; }
                bf16x8 Sb[4][2];
#pragma unroll
                for (int s = 0; s < 4; ++s) { Sb[s][0] = pack8(S[2 * s][0], S[2 * s + 1][0]); Sb[s][1] = pack8(S[2 * s][1], S[2 * s + 1][1]); }
                bf16x8 f[8];
#define LD_NWQT(base, m0) do { _Pragma("unroll") for (int mt_ = 0; mt_ < 2; ++mt_) _Pragma("unroll") for (int s_ = 0; s_ < 4; ++s_) f[mt_ * 4 + s_] = *(const LAS bf16x8*)(B + (base) + ((m0) + mt_) * 4096 + (xa ^ (s_ << 6))); } while (0)
#define LD_K(base, m0) do { _Pragma("unroll") for (int mt_ = 0; mt_ < 4; ++mt_) _Pragma("unroll") for (int s_ = 0; s_ < 2; ++s_) f[mt_ * 2 + s_] = *(const LAS bf16x8*)(B + (base) + ((m0) + mt_) * 2048 + (xk ^ (s_ << 6))); } while (0)
#pragma unroll
                for (int mp = 0; mp < 2; ++mp) {
                    __builtin_amdgcn_sched_barrier(0);
                    LD_NWQT(GC_NW, 2 * mp);
                    __builtin_amdgcn_sched_barrier(0);
#pragma unroll
                    for (int s = 0; s < 4; ++s)
#pragma unroll
                        for (int q = 0; q < 2; ++q) { vn[2 * mp + q][0] = mfma16(f[q * 4 + s], Sb[s][0], vn[2 * mp + q][0]); vn[2 * mp + q][1] = mfma16(f[q * 4 + s], Sb[s][1], vn[2 * mp + q][1]); }
                }
#pragma unroll
                for (int mp = 0; mp < 2; ++mp) {
                    __builtin_amdgcn_sched_barrier(0);
                    LD_NWQT(GC_QT, 2 * mp);
                    __builtin_amdgcn_sched_barrier(0);
#pragma unroll
                    for (int s = 0; s < 4; ++s)
#pragma unroll
                        for (int q = 0; q < 2; ++q) { o[2 * mp + q][0] = mfma16(f[q * 4 + s], Sb[s][0], o[2 * mp + q][0]); o[2 * mp + q][1] = mfma16(f[q * 4 + s], Sb[s][1], o[2 * mp + q][1]); }
                }
                bf16x8 vb[2][2];
#pragma unroll
                for (int j = 0; j < 2; ++j) { vb[0][j] = pack8(vn[0][j], vn[1][j]); vb[1][j] = pack8(vn[2][j], vn[3][j]); }
                __builtin_amdgcn_sched_barrier(0);
                LD_K(GC_AT, 0);
                __builtin_amdgcn_sched_barrier(0);
#pragma unroll
                for (int s = 0; s < 2; ++s)
#pragma unroll
                    for (int mt = 0; mt < 4; ++mt) { o[mt][0] = mfma16(f[mt * 2 + s], vb[s][0], o[mt][0]); o[mt][1] = mfma16(f[mt * 2 + s], vb[s][1], o[mt][1]); }
#pragma unroll
                for (int i = 0; i < 8; ++i) { S[i][0] = S[i][0] * egl; S[i][1] = S[i][1] * egl; }
#pragma unroll
                for (int mh = 0; mh < 2; ++mh) {
                    __builtin_amdgcn_sched_barrier(0);
                    LD_K(GC_KT, 4 * mh);
                    __builtin_amdgcn_sched_barrier(0);
#pragma unroll
                    for (int s = 0; s < 2; ++s)
#pragma unroll
                        for (int md = 0; md < 4; ++md) { S[4 * mh + md][0] = mfma16(f[md * 2 + s], vb[s][0], S[4 * mh + md][0]); S[4 * mh + md][1] = mfma16(f[md * 2 + s], vb[s][1], S[4 * mh + md][1]); }
                }
#undef LD_NWQT
#undef LD_K
#pragma unroll
                for (int mt = 0; mt < 4; ++mt)
#pragma unroll
                    for (int j = 0; j < 2; ++j)
#pragma unroll
                        for (int r = 0; r < 4; ++r) UT[(16 * mt + 4 * g + r) * 128 + e0 + 16 * j + c] = f2bfs(o[mt][j][r]);
            }
            asm volatile("s_waitcnt lgkmcnt(0)" ::: "memory");
            __syncthreads();
        }
        float* sp = outq(C) + O_GDNP + (size_t)((l * NBP + b) * 4 + h) * 128 * 128;
#pragma unroll
        for (int i = 0; i < 8; ++i)
#pragma unroll
            for (int j = 0; j < 2; ++j)
#pragma unroll
                for (int r = 0; r < 4; ++r) sp[(size_t)(16 * i + 4 * g + r) * 128 + e0 + 16 * j + c] = S[i][j][r];
    } else {
        const int trow = 16 * hw + (lane >> 2), cseg = (lane & 3) * 32;
        const bf16* gzp = U + (size_t)(b * TSEQ + trow) * LDU + C_GZ + h * 128 + cseg;
        bf16* orow = O + (size_t)(b * TSEQ + trow) * DM + 256 + h * 128 + cseg;
        const float* gnp = inptr(I_GNORM) + l * 128 + cseg;
        v4u gz[4], gzn[4];
#pragma unroll
        for (int k = 0; k < 4; ++k) { gz[k] = (v4u){0u, 0u, 0u, 0u}; gzn[k] = *(const v4u*)(gzp + 8 * k); }
        for (int n = 0; n <= 32; ++n) {
            v4u orw[4];
            if (n > 0) {
                const LAS unsigned short* ot = (const LAS unsigned short*)(lds + ((n - 1) & 1) * GC_BUF + GC_UT) + trow * 128 + cseg;
#pragma unroll
                for (int k = 0; k < 4; ++k) orw[k] = *(const LAS v4u*)(ot + 8 * k);
                asm volatile("s_waitcnt lgkmcnt(0)" ::: "memory");
            }
            if (n + 1 < 32) gdn_chain_issue_h(lds, wsq(C), idx0 + n + 1, (n + 1) & 1, ht, hw);
#pragma unroll
            for (int k = 0; k < 4; ++k) gz[k] = gzn[k];
            if (n < 32) { const bf16* gp = gzp + (size_t)n * 64 * LDU;
#pragma unroll
                for (int k = 0; k < 4; ++k) gzn[k] = *(const v4u*)(gp + 8 * k); }
            if (n > 0) {
                float ov[32]; float ss = 0.f;
#pragma unroll
                for (int k = 0; k < 4; ++k) { const v4u r = orw[k];
                    ov[8 * k] = bflo(r.x); ov[8 * k + 1] = bfhi(r.x); ov[8 * k + 2] = bflo(r.y); ov[8 * k + 3] = bfhi(r.y); ov[8 * k + 4] = bflo(r.z); ov[8 * k + 5] = bfhi(r.z); ov[8 * k + 6] = bflo(r.w); ov[8 * k + 7] = bfhi(r.w); }
#pragma unroll
                for (int i = 0; i < 32; ++i) ss += ov[i] * ov[i];
                ss += __builtin_bit_cast(float, __builtin_amdgcn_update_dpp(0, __builtin_bit_cast(int, ss), 0xB1, 0xF, 0xF, true));
                ss += __builtin_bit_cast(float, __builtin_amdgcn_update_dpp(0, __builtin_bit_cast(int, ss), 0x4E, 0xF, 0xF, true));
                const float rs = __builtin_amdgcn_rsqf(ss * (1.f / 128.f) + EPS);
                bf16* od = orow + (size_t)(n - 1) * 64 * DM;
#pragma unroll
                for (int k = 0; k < 4; ++k) {
                    const v4u gq = gz[k]; const f32x4 n0 = *(const f32x4*)(gnp + 8 * k), n1 = *(const f32x4*)(gnp + 8 * k + 4);
                    v4u wv;
                    wv.x = pk2(ov[8 * k] * rs * n0.x * siluf(bflo(gq.x)), ov[8 * k + 1] * rs * n0.y * siluf(bfhi(gq.x)));
                    wv.y = pk2(ov[8 * k + 2] * rs * n0.z * siluf(bflo(gq.y)), ov[8 * k + 3] * rs * n0.w * siluf(bfhi(gq.y)));
                    wv.z = pk2(ov[8 * k + 4] * rs * n1.x * siluf(bflo(gq.z)), ov[8 * k + 5] * rs * n1.y * siluf(bfhi(gq.z)));
                    wv.w = pk2(ov[8 * k + 6] * rs * n1.z * siluf(bflo(gq.w)), ov[8 * k + 7] * rs * n1.w * siluf(bfhi(gq.w)));
                    *(v4u*)(od + 8 * k) = wv;
                }
            }
            if (tid == 256 && (n & 3) == 3 && n + 3 < 32) {
                for (int k = n + 3; k < n + 7 && k < 32; ++k) { unsigned sp = 0; while (__hip_atomic_load(gcnt + 64 * k, __ATOMIC_RELAXED, __HIP_MEMORY_SCOPE_AGENT) < 32u) { __builtin_amdgcn_s_sleep(2); if (++sp > (1u << 22)) break; } }
                __builtin_amdgcn_fence(__ATOMIC_ACQUIRE, "agent");
            }
            asm volatile("s_waitcnt vmcnt(0)" ::: "memory");
            __syncthreads();
        }
    }
    __syncthreads();
}

constexpr int HC_QM = 0, HC_KM = 9216, HC_QE = 18432, HC_VT = 27648, HC_KLT = 36864, HC_BUF = 46080, HC_SEG = 92160, HC_GLS = 94208, HC_PART = 94720;
__device__ __forceinline__ void hgrn_chain(Ctx& C, int l, int b, int h) {
    int tid_ = threadIdx.x; asm volatile("" : "+v"(tid_)); const int tid = tid_, lane = tid & 63, w = __builtin_amdgcn_readfirstlane(tid >> 6), g = lane >> 4, c = lane & 15, d = lane, ts = w;
    LAS unsigned char* lds = ldsq(C);
    const bf16* U = (const bf16*)(wsq(C) + WS_U); bf16* O = (bf16*)(wsq(C) + WS_O);
    float lb = 0.f;
    if (l == 1) { const float b0 = inptr(I_HGLB)[h * 64 + d], b1 = inptr(I_HGLB)[256 + h * 64 + d]; lb = __builtin_amdgcn_rcpf(1.f + __expf(b0 - b1)); }
    const float oml = 1.f - lb;
    const int nt = w >> 1, ep = w & 1;
    f32x4 S[4][2];
#pragma unroll
    for (int i = 0; i < 4; ++i) { S[i][0] = (f32x4){0.f, 0.f, 0.f, 0.f}; S[i][1] = (f32x4){0.f, 0.f, 0.f, 0.f}; }
    float hgn[2][4];
#pragma unroll
    for (int mi = 0; mi < 2; ++mi)
#pragma unroll
        for (int r = 0; r < 4; ++r) hgn[mi][r] = inptr(I_HGN)[l * 64 + 16 * (2 * ep + mi) + 4 * g + r];
    LAS float* SEG = (LAS float*)(lds + HC_SEG);
    unsigned short rq[8], rf[8], ri[8];
    {
        const bf16* up = U + (size_t)(b * TSEQ + 8 * ts) * LDU + h * 64 + d;
#pragma unroll
        for (int j = 0; j < 8; ++j) { rq[j] = up[(size_t)j * LDU + C_HQ]; rf[j] = up[(size_t)j * LDU + C_HF]; ri[j] = up[(size_t)j * LDU + C_HI]; }
    }
    for (int n = 0; n < 32; ++n) {
        const int buf = n & 1; const int row0 = b * TSEQ + n * 64;
        float q[8], kk[8], cs[8], v[8];
        float run = 0.f;
#pragma unroll
        for (int j = 0; j < 8; ++j) {
            const float z = bf2f(rf[j]); const float ez = __expf(-z); const float sg = __builtin_amdgcn_rcpf(1.f + ez);
            const float f = lb + oml * sg; run += __logf(f); cs[j] = run;
            kk[j] = oml * (1.f - sg);
            q[j] = siluf(bf2f(rq[j])); v[j] = bf2f(ri[j]);
        }
        SEG[ts * 64 + d] = run;
        u32x2 hz[2];
#pragma unroll
        for (int mi = 0; mi < 2; ++mi) hz[mi] = *(const u32x2*)(U + (size_t)(row0 + 16 * nt + c) * LDU + C_HZ + h * 64 + 16 * (2 * ep + mi) + 4 * g);
        if (n + 1 < 32) {
            const bf16* up = U + (size_t)(row0 + 64 + 8 * ts) * LDU + h * 64 + d;
#pragma unroll
            for (int j = 0; j < 8; ++j) { rq[j] = up[(size_t)j * LDU + C_HQ]; rf[j] = up[(size_t)j * LDU + C_HF]; ri[j] = up[(size_t)j * LDU + C_HI]; }
        }
        __syncthreads();
        float base = 0.f, gmid = 0.f, gl = 0.f;
#pragma unroll
        for (int k = 0; k < 8; ++k) { const float sv = SEG[k * 64 + d]; if (k < ts) base += sv; if (k < 4) gmid += sv; gl += sv; }
        LAS unsigned short* T = (LAS unsigned short*)(lds + buf * HC_BUF);
        {
            const int dpos = (d & ~31) + permpos(d & 31);
            float klv[8];
#pragma unroll
            for (int j = 0; j < 8; ++j) {
                const int t = 8 * ts + j; const float G = base + cs[j];
                const float e1 = fminf(fmaxf(G - gmid, -80.f), 80.f);
                T[HC_QM / 2 + t * 72 + d] = f2bfs(q[j] * __expf(e1));
                T[HC_KM / 2 + t * 72 + d] = f2bfs(kk[j] * __expf(-e1));
                T[HC_QE / 2 + t * 72 + dpos] = f2bfs(q[j] * __expf(G));
                klv[j] = kk[j] * __expf(gl - G);
            }
            const int p0 = 32 * (ts >> 2) + 16 * (ts & 1) + 4 * ((ts >> 1) & 1);
            u32x2 wv0, wv1, wk0, wk1;
            wv0.x = pk2(v[0], v[1]); wv0.y = pk2(v[2], v[3]); wv1.x = pk2(v[4], v[5]); wv1.y = pk2(v[6], v[7]);
            wk0.x = pk2(klv[0], klv[1]); wk0.y = pk2(klv[2], klv[3]); wk1.x = pk2(klv[4], klv[5]); wk1.y = pk2(klv[6], klv[7]);
            *(LAS u32x2*)(T + HC_VT / 2 + d * 72 + p0) = wv0; *(LAS u32x2*)(T + HC_VT / 2 + d * 72 + p0 + 8) = wv1;
            *(LAS u32x2*)(T + HC_KLT / 2 + d * 72 + p0) = wk0; *(LAS u32x2*)(T + HC_KLT / 2 + d * 72 + p0 + 8) = wk1;
            if (ts == 0) ((LAS float*)(lds + HC_GLS))[buf * 64 + d] = gl;
        }
        __syncthreads();
        f32x4 at[4];
#pragma unroll
        for (int ms = 0; ms < 4; ++ms) {
            at[ms] = (f32x4){0.f, 0.f, 0.f, 0.f};
            if (ms <= nt) {
#pragma unroll
                for (int s = 0; s < 2; ++s)
                    at[ms] = mfma16(*(const LAS bf16x8*)(T + HC_KM / 2 + (16 * ms + c) * 72 + 32 * s + 8 * g), *(const LAS bf16x8*)(T + HC_QM / 2 + (16 * nt + c) * 72 + 32 * s + 8 * g), at[ms]);
                if (ms == nt) {
#pragma unroll
                    for (int r = 0; r < 4; ++r) at[ms][r] = (4 * g + r <= c) ? at[ms][r] : 0.f;
                }
            }
        }
        bf16x8 atb[2]; atb[0] = pack8(at[0], at[1]); atb[1] = pack8(at[2], at[3]);
        f32x4 oT[2];
#pragma unroll
        for (int mi = 0; mi < 2; ++mi) {
            const int me = 2 * ep + mi; f32x4 acc = (f32x4){0.f, 0.f, 0.f, 0.f};
#pragma unroll
            for (int s = 0; s < 2; ++s)
                acc = mfma16(pack8(S[2 * s][mi], S[2 * s + 1][mi]), *(const LAS bf16x8*)(T + HC_QE / 2 + (16 * nt + c) * 72 + 32 * s + 8 * g), acc);
#pragma unroll
            for (int s = 0; s < 2; ++s)
                acc = mfma16(*(const LAS bf16x8*)(T + HC_VT / 2 + (16 * me + c) * 72 + 32 * s + 8 * g), atb[s], acc);
            oT[mi] = acc;
        }
        {
            const LAS float* GLS = (const LAS float*)(lds + HC_GLS) + buf * 64;
#pragma unroll
            for (int md = 0; md < 4; ++md) {
                const f32x4 lg = *(const LAS f32x4*)(GLS + 16 * md + 4 * g);
                const f32x4 lam = (f32x4){__expf(lg.x), __expf(lg.y), __expf(lg.z), __expf(lg.w)};
#pragma unroll
                for (int mi = 0; mi < 2; ++mi) {
                    const int me = 2 * ep + mi; f32x4 acc = S[md][mi] * lam;
#pragma unroll
                    for (int s = 0; s < 2; ++s)
                        acc = mfma16(*(const LAS bf16x8*)(T + HC_KLT / 2 + (16 * md + c) * 72 + 32 * s + 8 * g), *(const LAS bf16x8*)(T + HC_VT / 2 + (16 * me + c) * 72 + 32 * s + 8 * g), acc);
                    S[md][mi] = acc;
                }
            }
        }
        LAS float* PART = (LAS float*)(lds + HC_PART) + buf * 128;
        float ss = 0.f;
#pragma unroll
        for (int mi = 0; mi < 2; ++mi)
#pragma unroll
            for (int r = 0; r < 4; ++r) ss += oT[mi][r] * oT[mi][r];
        ss += __shfl_xor(ss, 16); ss += __shfl_xor(ss, 32);
        if (g == 0) PART[(16 * nt + c) * 2 + ep] = ss;
        __syncthreads();
        const float tot = PART[(16 * nt + c) * 2] + PART[(16 * nt + c) * 2 + 1];
        const float rs = rsqrtf(tot * (1.f / 64.f) + EPS);
#pragma unroll
        for (int mi = 0; mi < 2; ++mi) {
            const float z0 = bflo(hz[mi].x), z1 = bfhi(hz[mi].x), z2 = bflo(hz[mi].y), z3 = bfhi(hz[mi].y);
            u32x2 wv; wv.x = pk2(oT[mi][0] * rs * hgn[mi][0] * siluf(z0), oT[mi][1] * rs * hgn[mi][1] * siluf(z1));
            wv.y = pk2(oT[mi][2] * rs * hgn[mi][2] * siluf(z2), oT[mi][3] * rs * hgn[mi][3] * siluf(z3));
            *(u32x2*)(O + (size_t)(row0 + 16 * nt + c) * DM + h * 64 + 16 * (2 * ep + mi) + 4 * g) = wv;
        }
    }
    if (nt == 0) {
        float* sp = outq(C) + O_HGP + (size_t)((l * NBP + b) * 4 + h) * 64 * 64;
#pragma unroll
        for (int md = 0; md < 4; ++md)
#pragma unroll
            for (int mi = 0; mi < 2; ++mi)
#pragma unroll
                for (int r = 0; r < 4; ++r) sp[(size_t)(16 * md + 4 * g + r) * 64 + 16 * (2 * ep + mi) + c] = S[md][mi][r];
    }
    __syncthreads();
}

constexpr int L1_WT = 0, L1_XCB = 73728, L1_STA = 0, L1_STH = 32768;
__device__ __forceinline__ void lru_pass1_item(Ctx& C, int l, int b, int n, unsigned* cnt) {
    int tid_ = threadIdx.x; asm volatile("" : "+v"(tid_)); const int tid = tid_, lane = tid & 63, w = __builtin_amdgcn_readfirstlane(tid >> 6), g = lane >> 4, c = lane & 15;
    LAS unsigned char* lds = ldsq(C);
    const bf16* U = (const bf16*)(wsq(C) + WS_U); bf16* O = (bf16*)(wsq(C) + WS_O);
    LAS unsigned short* WT = (LAS unsigned short*)(lds + L1_WT);
    LAS unsigned short* XCB = (LAS unsigned short*)(lds + L1_XCB);
    const int row0 = b * TSEQ + n * 64;
    {
        const float* wa = inptr(I_LWA) + (size_t)l * 16384; const float* wx = inptr(I_LWX) + (size_t)l * 16384;
        for (int idx = tid; idx < 8192; idx += NTHR) {
            const int gate = idx >> 12, rem = idx & 4095, blk = rem >> 10, i = (rem >> 4) & 63, j4 = (rem & 15) * 4;
            const f32x4 v = *(const f32x4*)((gate ? wx : wa) + ((size_t)blk * 64 + i) * 64 + j4);
            LAS unsigned short* dst = WT + ((gate * 4 + blk) * 64 + j4) * 72 + i;
            dst[0] = f2bfs(v.x); dst[72] = f2bfs(v.y); dst[144] = f2bfs(v.z); dst[216] = f2bfs(v.w);
        }
    }
    {
        const int cg = tid & 31, rs = tid >> 5, ch0 = cg * 8, t0 = rs * 4;
        float cw[4][8], cb[8];
        const float* cwp = inptr(I_LCW) + (size_t)l * 4 * 256 + ch0; const float* cbp = inptr(I_LCB) + (size_t)l * 256 + ch0;
#pragma unroll
        for (int k = 0; k < 4; ++k) { const f32x4 a = *(const f32x4*)(cwp + k * 256), bq = *(const f32x4*)(cwp + k * 256 + 4);
            cw[k][0] = a.x; cw[k][1] = a.y; cw[k][2] = a.z; cw[k][3] = a.w; cw[k][4] = bq.x; cw[k][5] = bq.y; cw[k][6] = bq.z; cw[k][7] = bq.w; }
        { const f32x4 a = *(const f32x4*)cbp, bq = *(const f32x4*)(cbp + 4); cb[0] = a.x; cb[1] = a.y; cb[2] = a.z; cb[3] = a.w; cb[4] = bq.x; cb[5] = bq.y; cb[6] = bq.z; cb[7] = bq.w; }
        float x[7][8];
#pragma unroll
        for (int k = 0; k < 7; ++k) {
            const int tg = n * 64 + t0 - 3 + k;
            if (tg >= 0) { const v4u r = *(const v4u*)(U + (size_t)(b * TSEQ + tg) * LDU + C_LX + ch0);
                x[k][0] = bflo(r.x); x[k][1] = bfhi(r.x); x[k][2] = bflo(r.y); x[k][3] = bfhi(r.y); x[k][4] = bflo(r.z); x[k][5] = bfhi(r.z); x[k][6] = bflo(r.w); x[k][7] = bfhi(r.w);
                if (n == 31 && tg >= TSEQ - 3) { float* cp = outq(C) + O_LCP + ((size_t)(l * NBP + b) * 3 + (tg - (TSEQ - 3))) * 256 + ch0;
                    *(f32x4*)cp = (f32x4){x[k][0], x[k][1], x[k][2], x[k][3]}; *(f32x4*)(cp + 4) = (f32x4){x[k][4], x[k][5], x[k][6], x[k][7]}; }
            } else {
#pragma unroll
                for (int i = 0; i < 8; ++i) x[k][i] = 0.f; }
        }
#pragma unroll
        for (int j = 0; j < 4; ++j) {
            float y[8];
#pragma unroll
            for (int i = 0; i < 8; ++i) y[i] = cw[0][i] * x[j][i] + cw[1][i] * x[j + 1][i] + cw[2][i] * x[j + 2][i] + cw[3][i] * x[j + 3][i] + cb[i];
            v4u wv; wv.x = pk2(y[0], y[1]); wv.y = pk2(y[2], y[3]); wv.z = pk2(y[4], y[5]); wv.w = pk2(y[6], y[7]);
            *(LAS v4u*)(XCB + (t0 + j) * 264 + ch0) = wv;
            const v4u r = *(const v4u*)(U + (size_t)(row0 + t0 + j) * LDU + C_LZ + ch0);
            v4u gv; gv.x = pk2(gelu_tanh(bflo(r.x)), gelu_tanh(bfhi(r.x))); gv.y = pk2(gelu_tanh(bflo(r.y)), gelu_tanh(bfhi(r.y)));
            gv.z = pk2(gelu_tanh(bflo(r.z)), gelu_tanh(bfhi(r.z))); gv.w = pk2(gelu_tanh(bflo(r.w)), gelu_tanh(bfhi(r.w)));
            st16_wt(wsq(C), WS_O + ((size_t)(row0 + t0 + j) * DM + 768 + ch0) * 2, gv);
        }
    }
    __syncthreads();
    const int nb = w >> 1, njb = 2 * (w & 1);
    f32x4 pa[4][2], px[4][2];
    {
        bf16x8 fa[8], fb[8];
#pragma unroll
        for (int mt = 0; mt < 4; ++mt)
#pragma unroll
            for (int s = 0; s < 2; ++s) fa[mt * 2 + s] = *(const LAS bf16x8*)(XCB + (16 * mt + c) * 264 + 64 * nb + 32 * s + 8 * g);
#pragma unroll
        for (int gate = 0; gate < 2; ++gate)
#pragma unroll
            for (int q = 0; q < 2; ++q)
#pragma unroll
                for (int s = 0; s < 2; ++s) fb[(gate * 2 + q) * 2 + s] = *(const LAS bf16x8*)(WT + ((gate * 4 + nb) * 64 + 16 * (njb + q) + c) * 72 + 32 * s + 8 * g);
        __builtin_amdgcn_sched_barrier(0);
#pragma unroll
        for (int mt = 0; mt < 4; ++mt)
#pragma unroll
            for (int q = 0; q < 2; ++q) {
                f32x4 a = (f32x4){0.f, 0.f, 0.f, 0.f}, x = a;
#pragma unroll
                for (int s = 0; s < 2; ++s) { a = mfma16(fa[mt * 2 + s], fb[q * 2 + s], a); x = mfma16(fa[mt * 2 + s], fb[(2 + q) * 2 + s], x); }
                pa[mt][q] = a; px[mt][q] = x;
            }
    }
    unsigned short oa[2][4][4], oh[2][4][4];
    const float* bap = inptr(I_LBA) + l * 256; const float* bxp = inptr(I_LBX) + l * 256; const float* lamp = inptr(I_LLAM) + l * 256;
#pragma unroll
    for (int q = 0; q < 2; ++q) {
        const int ch = 64 * nb + 16 * (njb + q) + c;
        const float ba = bap[ch], bx = bxp[ch], sp = softplusf(-lamp[ch]);
        float pc = 1.f, hc = 0.f;
#pragma unroll
        for (int mt = 0; mt < 4; ++mt) {
            float a[4], bb[4];
#pragma unroll
            for (int r = 0; r < 4; ++r) {
                const float xcv = bf2f(XCB[(16 * mt + 4 * g + r) * 264 + ch]);
                const float rr = sigm(pa[mt][q][r] + ba), ii = sigm(px[mt][q][r] + bx);
                const float la = -8.f * rr * sp, x2 = 2.f * la;
                a[r] = __expf(la);
                const float omp = -x2 * (1.f + x2 * (0.5f + x2 * (0.16666667f + x2 * (0.041666668f + x2 * 0.0083333338f))));
                const float om = x2 > -0.25f ? omp : 1.f - a[r] * a[r];
                bb[r] = sqrtf(fmaxf(om, 0.f)) * ii * xcv;
            }
            const float P = a[0] * a[1] * a[2] * a[3];
            const float H = ((bb[0] * a[1] + bb[1]) * a[2] + bb[2]) * a[3] + bb[3];
            float ps = pc, hs = hc, pstart = pc, hstart = hc;
#pragma unroll
            for (int k = 0; k < 4; ++k) {
                const float Pk = __shfl(P, c + 16 * k), Hk = __shfl(H, c + 16 * k);
                hs = Pk * hs + Hk; ps = Pk * ps;
                if (g == k + 1) { hstart = hs; pstart = ps; }
            }
            pc = ps; hc = hs;
            float pp = pstart, hh = hstart;
#pragma unroll
            for (int r = 0; r < 4; ++r) { pp = pp * a[r]; hh = a[r] * hh + bb[r]; oa[q][mt][r] = f2bfs(pp); oh[q][mt][r] = f2bfs(hh); }
        }
        if (g == 0) { float* sp_ = (float*)(wsq(C) + WS_LSUM) + ((size_t)(b * 32 + n) * 2) * 256 + ch; st4_wt(sp_, pc); st4_wt(sp_ + 256, hc); }
    }
    __syncthreads();
    {
        LAS unsigned short* STA = (LAS unsigned short*)(lds + L1_STA); LAS unsigned short* STH = (LAS unsigned short*)(lds + L1_STH);
#pragma unroll
        for (int q = 0; q < 2; ++q)
#pragma unroll
            for (int mt = 0; mt < 4; ++mt)
#pragma unroll
                for (int r = 0; r < 4; ++r) { const int off = (16 * mt + 4 * g + r) * 256 + 64 * nb + 16 * (njb + q) + c; STA[off] = oa[q][mt][r]; STH[off] = oh[q][mt][r]; }
    }
    __syncthreads();
    {
        unsigned char* wsb = wsq(C);
#pragma unroll
        for (int k = 0; k < 4; ++k) { const int e = (tid + 512 * k) * 8;
            st16_wt(wsb, WS_ACUM + ((size_t)row0 * 256 + e) * 2, *(const LAS v4u*)(lds + L1_STA + e * 2)); st16_wt(wsb, WS_HLOC + ((size_t)row0 * 256 + e) * 2, *(const LAS v4u*)(lds + L1_STH + e * 2)); }
    }
    publish_add(cnt);
}
__device__ __forceinline__ void lru_pass3_item(Ctx& C, int l, int b, int n) {
    int tid_ = threadIdx.x; asm volatile("" : "+v"(tid_)); const int tid = tid_;
    const int cg = tid & 31, rs = tid >> 5, ch0 = cg * 8, row0 = b * TSEQ + n * 64;
    const float* sum = (const float*)(wsq(C) + WS_LSUM) + (size_t)(b * 32) * 2 * 256 + ch0;
    float hin[8];
#pragma unroll
    for (int i = 0; i < 8; ++i) hin[i] = 0.f;
    for (int k0 = 0; k0 < n; k0 += 4) {
        f32x4 pp[4][2], hh[4][2];
#pragma unroll
        for (int q = 0; q < 4; ++q) { const int k = (k0 + q < n) ? k0 + q : 0;
            pp[q][0] = *(const f32x4*)(sum + (size_t)k * 512); pp[q][1] = *(const f32x4*)(sum + (size_t)k * 512 + 4); hh[q][0] = *(const f32x4*)(sum + (size_t)k * 512 + 256); hh[q][1] = *(const f32x4*)(sum + (size_t)k * 512 + 260); }
#pragma unroll
        for (int q = 0; q < 4; ++q) if (k0 + q < n) {
            hin[0] = pp[q][0].x * hin[0] + hh[q][0].x; hin[1] = pp[q][0].y * hin[1] + hh[q][0].y; hin[2] = pp[q][0].z * hin[2] + hh[q][0].z; hin[3] = pp[q][0].w * hin[3] + hh[q][0].w;
            hin[4] = pp[q][1].x * hin[4] + hh[q][1].x; hin[5] = pp[q][1].y * hin[5] + hh[q][1].y; hin[6] = pp[q][1].z * hin[6] + hh[q][1].z; hin[7] = pp[q][1].w * hin[7] + hh[q][1].w;
        }
    }
    const bf16* ga = (const bf16*)(wsq(C) + WS_ACUM); const bf16* gh = (const bf16*)(wsq(C) + WS_HLOC); bf16* O = (bf16*)(wsq(C) + WS_O);
    v4u av[4], hv[4], gv[4];
#pragma unroll
    for (int j = 0; j < 4; ++j) { const int row = row0 + rs * 4 + j;
        av[j] = *(const v4u*)(ga + (size_t)row * 256 + ch0); hv[j] = *(const v4u*)(gh + (size_t)row * 256 + ch0); gv[j] = *(const v4u*)(O + (size_t)row * DM + 768 + ch0); }
#pragma unroll
    for (int j = 0; j < 4; ++j) {
        const int row = row0 + rs * 4 + j;
        const v4u a = av[j], h = hv[j], gl = gv[j];
        v4u o;
        o.x = pk2((bflo(h.x) + bflo(a.x) * hin[0]) * bflo(gl.x), (bfhi(h.x) + bfhi(a.x) * hin[1]) * bfhi(gl.x));
        o.y = pk2((bflo(h.y) + bflo(a.y) * hin[2]) * bflo(gl.y), (bfhi(h.y) + bfhi(a.y) * hin[3]) * bfhi(gl.y));
        o.z = pk2((bflo(h.z) + bflo(a.z) * hin[4]) * bflo(gl.z), (bfhi(h.z) + bfhi(a.z) * hin[5]) * bfhi(gl.z));
        o.w = pk2((bflo(h.w) + bflo(a.w) * hin[6]) * bflo(gl.w), (bfhi(h.w) + bfhi(a.w) * hin[7]) * bfhi(gl.w));
        *(v4u*)(O + (size_t)row * DM + 768 + ch0) = o;
    }
    if (n == 31 && rs == 0) {
        const f32x4 p0 = *(const f32x4*)(sum + (size_t)31 * 512), p1 = *(const f32x4*)(sum + (size_t)31 * 512 + 4), h0 = *(const f32x4*)(sum + (size_t)31 * 512 + 256), h1 = *(const f32x4*)(sum + (size_t)31 * 512 + 260);
        float* lp = outq(C) + O_LRUP + (size_t)(l * NBP + b) * 256 + ch0;
        *(f32x4*)lp = (f32x4){p0.x * hin[0] + h0.x, p0.y * hin[1] + h0.y, p0.z * hin[2] + h0.z, p0.w * hin[3] + h0.w};
        *(f32x4*)(lp + 4) = (f32x4){p1.x * hin[4] + h1.x, p1.y * hin[5] + h1.y, p1.z * hin[6] + h1.z, p1.w * hin[7] + h1.w};
    }
}

__device__ __forceinline__ void gdn_dec_item(Ctx& C, int l, int seq, int h) {
    int tid_ = threadIdx.x; asm volatile("" : "+v"(tid_)); const int tid = tid_, lane = tid & 63, w = __builtin_amdgcn_readfirstlane(tid >> 6);
    LAS float* XQ = (LAS float*)(ldsq(C));
    LAS float* SCd = (LAS float*)(ldsq(C) + 6144);
    LAS float* RED = (LAS float*)(ldsq(C) + 6400);
    LAS float* SS = (LAS float*)(ldsq(C) + 6400 + 16384);
    const bf16* U = (const bf16*)(wsq(C) + WS_U); bf16* O = (bf16*)(wsq(C) + WS_O);
    const int row0 = MP + seq * 4;
    const int e = tid & 127, dq = tid >> 7;
    const size_t sbase = ((size_t)((l * NSQ + seq) * 4 + h) * 128 + dq * 32) * 128 + e;
    float S[32];
    { const float* sp_ = inptr(I_SGDN) + sbase;
#pragma unroll
      for (int i = 0; i < 32; ++i) S[i] = sp_[(size_t)i * 128]; }
    if (tid < 384) {
        const int which = tid >> 7, cc = tid & 127, ucol = C_Q + which * 512 + h * 128 + cc, wcol = which * 512 + h * 128 + cc;
        float xs[7], cw[4];
#pragma unroll
        for (int k = 0; k < 3; ++k) xs[k] = inptr(I_SGC)[((size_t)(l * NSQ + seq) * 3 + k) * 1536 + wcol];
#pragma unroll
        for (int t = 0; t < 4; ++t) xs[3 + t] = bf2f(U[(size_t)(row0 + t) * LDU + ucol]);
#pragma unroll
        for (int k = 0; k < 4; ++k) cw[k] = inptr(I_GCW)[(size_t)(l * 4 + k) * 1536 + wcol];
#pragma unroll
        for (int t = 0; t < 4; ++t) XQ[t * 384 + tid] = siluf(cw[0] * xs[t] + cw[1] * xs[t + 1] + cw[2] * xs[t + 2] + cw[3] * xs[t + 3]);
#pragma unroll
        for (int k = 0; k < 3; ++k) outq(C)[O_GCS + ((size_t)(l * NSQ + seq) * 3 + k) * 1536 + wcol] = xs[4 + k];
    }
    __syncthreads();
    {
        const int t = w & 3, which = w >> 2;
        const float a = XQ[t * 384 + which * 128 + lane], bq = XQ[t * 384 + which * 128 + 64 + lane];
        const float s = wave_sum(a * a + bq * bq);
        if (lane == 0) SCd[which * 4 + t] = rsqrtf(s + EPS) * (which == 0 ? 0.08838834764831845f : 1.f);
        if (tid < 4) {
            const bf16* ur = U + (size_t)(row0 + tid) * LDU;
            const float g = -__expf(inptr(I_GALOG)[l * 4 + h]) * softplusf(bf2f(ur[C_GA + h]) + inptr(I_GDTB)[l * 4 + h]);
            SCd[8 + tid] = __expf(g); SCd[12 + tid] = sigm(bf2f(ur[C_GB + h]));
        }
    }
    __syncthreads();
#pragma unroll
    for (int t = 0; t < 4; ++t) {
        const float a = SCd[8 + t], beta = SCd[12 + t], rk = SCd[4 + t], rq = SCd[t];
        const LAS float* kp = XQ + t * 384 + 128 + dq * 32; const LAS float* qp = XQ + t * 384 + dq * 32;
        float part = 0.f;
#pragma unroll
        for (int i = 0; i < 32; ++i) { S[i] *= a; part += kp[i] * S[i]; }
        RED[((t * 2 + 0) * 4 + dq) * 128 + e] = part * rk;
        __syncthreads();
        const float kS = (RED[((t * 2) * 4 + 0) * 128 + e] + RED[((t * 2) * 4 + 1) * 128 + e]) + (RED[((t * 2) * 4 + 2) * 128 + e] + RED[((t * 2) * 4 + 3) * 128 + e]);
        const float dv = beta * (XQ[t * 384 + 256 + e] - kS) * rk;
        float part2 = 0.f;
#pragma unroll
        for (int i = 0; i < 32; ++i) { S[i] += kp[i] * dv; part2 += qp[i] * S[i]; }
        RED[((t * 2 + 1) * 4 + dq) * 128 + e] = part2 * rq;
    }
    __syncthreads();
    {
        const int t = tid >> 7;
        const float o = (RED[((t * 2 + 1) * 4 + 0) * 128 + e] + RED[((t * 2 + 1) * 4 + 1) * 128 + e]) + (RED[((t * 2 + 1) * 4 + 2) * 128 + e] + RED[((t * 2 + 1) * 4 + 3) * 128 + e]);
        const float ss = wave_sum(o * o);
        if (lane == 0) SS[w] = ss;
        __syncthreads();
        const float rs = rsqrtf((SS[2 * t] + SS[2 * t + 1]) * (1.f / 128.f) + EPS);
        const float gz = bf2f(U[(size_t)(row0 + t) * LDU + C_GZ + h * 128 + e]);
        O[(size_t)(row0 + t) * DM + 256 + h * 128 + e] = f2bfs(o * rs * inptr(I_GNORM)[l * 128 + e] * siluf(gz));
    }
    { float* op_ = outq(C) + O_GDNS + sbase;
#pragma unroll
      for (int i = 0; i < 32; ++i) op_[(size_t)i * 128] = S[i]; }
    __syncthreads();
}
__device__ __forceinline__ void gdn_dec4_item(Ctx& C, int l, int seq) {
    int tid_ = threadIdx.x; asm volatile("" : "+v"(tid_)); const int tid = tid_, lane = tid & 63, w = __builtin_amdgcn_readfirstlane(tid >> 6);
    LAS float* XQ = (LAS float*)(ldsq(C));
    LAS float* SCd = (LAS float*)(ldsq(C) + 24576);
    LAS float* SS = (LAS float*)(ldsq(C) + 24576 + 256);
    const bf16* U = (const bf16*)(wsq(C) + WS_U); bf16* O = (bf16*)(wsq(C) + WS_O);
    const int row0 = MP + seq * 4, h = w >> 1, e = tid & 127;
    const size_t sbase = ((size_t)((l * NSQ + seq) * 4 + h) * 128) * 128 + e;
    float S[128];
    { const float* sp_ = inptr(I_SGDN) + sbase;
#pragma unroll
      for (int d = 0; d < 128; ++d) S[d] = sp_[(size_t)d * 128]; }
    {
        const float* sgc = inptr(I_SGC) + (size_t)(l * NSQ + seq) * 3 * 1536; const float* gcw = inptr(I_GCW) + (size_t)l * 4 * 1536; float* gcs = outq(C) + O_GCS + (size_t)(l * NSQ + seq) * 3 * 1536;
#pragma unroll
        for (int k3 = 0; k3 < 3; ++k3) {
            const int col = tid + 512 * k3;
            float xs[7], cw[4];
#pragma unroll
            for (int k = 0; k < 3; ++k) xs[k] = sgc[k * 1536 + col];
#pragma unroll
            for (int t = 0; t < 4; ++t) xs[3 + t] = bf2f(U[(size_t)(row0 + t) * LDU + C_Q + col]);
#pragma unroll
            for (int k = 0; k < 4; ++k) cw[k] = gcw[k * 1536 + col];
#pragma unroll
            for (int t = 0; t < 4; ++t) XQ[t * 1536 + col] = siluf(cw[0] * xs[t] + cw[1] * xs[t + 1] + cw[2] * xs[t + 2] + cw[3] * xs[t + 3]);
#pragma unroll
            for (int k = 0; k < 3; ++k) gcs[k * 1536 + col] = xs[4 + k];
        }
    }
    __syncthreads();
#pragma unroll
    for (int i = 0; i < 4; ++i) {
        const int v = w * 4 + i, t = v & 3, hh = (v >> 2) & 3, which = v >> 4;
        const float a = XQ[t * 1536 + which * 512 + hh * 128 + lane], bq = XQ[t * 1536 + which * 512 + hh * 128 + 64 + lane];
        const float s = wave_sum(a * a + bq * bq);
        if (lane == 0) SCd[which * 16 + t * 4 + hh] = rsqrtf(s + EPS) * (which == 0 ? 0.08838834764831845f : 1.f);
    }
    if (tid < 16) {
        const int t = tid & 3, hh = tid >> 2; const bf16* ur = U + (size_t)(row0 + t) * LDU;
        const float g = -__expf(inptr(I_GALOG)[l * 4 + hh]) * softplusf(bf2f(ur[C_GA + hh]) + inptr(I_GDTB)[l * 4 + hh]);
        SCd[32 + t * 4 + hh] = __expf(g); SCd[48 + t * 4 + hh] = sigm(bf2f(ur[C_GB + hh]));
    }
    __syncthreads();
    float ov[4];
#pragma unroll
    for (int t = 0; t < 4; ++t) {
        const float rq = SCd[t * 4 + h], rk = SCd[16 + t * 4 + h], a = SCd[32 + t * 4 + h], beta = SCd[48 + t * 4 + h];
        const LAS f32x4* kp = (const LAS f32x4*)(XQ + t * 1536 + 512 + h * 128); const LAS f32x4* qp = (const LAS f32x4*)(XQ + t * 1536 + h * 128);
        float k0 = 0.f, k1 = 0.f, k2 = 0.f, k3 = 0.f;
#pragma unroll
        for (int d4 = 0; d4 < 32; ++d4) { if ((d4 & 3) == 0) __builtin_amdgcn_sched_barrier(0);
            const f32x4 kv = kp[d4];
            S[4 * d4] *= a; S[4 * d4 + 1] *= a; S[4 * d4 + 2] *= a; S[4 * d4 + 3] *= a;
            k0 += kv.x * S[4 * d4]; k1 += kv.y * S[4 * d4 + 1]; k2 += kv.z * S[4 * d4 + 2]; k3 += kv.w * S[4 * d4 + 3]; }
        const float kS = ((k0 + k1) + (k2 + k3)) * rk;
        const float dv = beta * (XQ[t * 1536 + 1024 + h * 128 + e] - kS) * rk;
        float o0 = 0.f, o1 = 0.f, o2 = 0.f, o3 = 0.f;
#pragma unroll
        for (int d4 = 0; d4 < 32; ++d4) { if ((d4 & 3) == 0) __builtin_amdgcn_sched_barrier(0);
            const f32x4 kv = kp[d4], qv = qp[d4];
            S[4 * d4] += kv.x * dv; S[4 * d4 + 1] += kv.y * dv; S[4 * d4 + 2] += kv.z * dv; S[4 * d4 + 3] += kv.w * dv;
            o0 += qv.x * S[4 * d4]; o1 += qv.y * S[4 * d4 + 1]; o2 += qv.z * S[4 * d4 + 2]; o3 += qv.w * S[4 * d4 + 3]; }
        ov[t] = ((o0 + o1) + (o2 + o3)) * rq;
        const float ss = wave_sum(ov[t] * ov[t]);
        if (lane == 0) SS[t * 8 + w] = ss;
    }
    __syncthreads();
    const float gn = inptr(I_GNORM)[l * 128 + e];
#pragma unroll
    for (int t = 0; t < 4; ++t) {
        const float rs = rsqrtf((SS[t * 8 + 2 * h] + SS[t * 8 + 2 * h + 1]) * (1.f / 128.f) + EPS);
        const float gz = bf2f(U[(size_t)(row0 + t) * LDU + C_GZ + h * 128 + e]);
        O[(size_t)(row0 + t) * DM + 256 + h * 128 + e] = f2bfs(ov[t] * rs * gn * siluf(gz));
    }
    { float* op_ = outq(C) + O_GDNS + sbase;
#pragma unroll
      for (int d = 0; d < 128; ++d) op_[(size_t)d * 128] = S[d]; }
    __syncthreads();
}
__device__ __forceinline__ void hl_dec_item(Ctx& C, int l, int seq) {
    int tid_ = threadIdx.x; asm volatile("" : "+v"(tid_)); const int tid = tid_, lane = tid & 63, wv_ = 0; (void)wv_;
    LAS float* QK = (LAS float*)(ldsq(C));
    LAS float* REDh = (LAS float*)(ldsq(C) + 16384);
    LAS float* XCs = (LAS float*)(ldsq(C) + 24576);
    const bf16* U = (const bf16*)(wsq(C) + WS_U); bf16* O = (bf16*)(wsq(C) + WS_O);
    const int row0 = MP + seq * 4;
    if (tid < 256) {
        const int ch = tid; float lb = 0.f;
        if (l == 1) { const float b0 = inptr(I_HGLB)[ch], b1 = inptr(I_HGLB)[256 + ch]; lb = __builtin_amdgcn_rcpf(1.f + __expf(b0 - b1)); }
        const float oml = 1.f - lb;
#pragma unroll
        for (int t = 0; t < 4; ++t) {
            const bf16* ur = U + (size_t)(row0 + t) * LDU;
            const float z = bf2f(ur[C_HF + ch]); const float sg = sigm(z);
            QK[t * 256 + ch] = siluf(bf2f(ur[C_HQ + ch])); QK[1024 + t * 256 + ch] = oml * (1.f - sg); QK[2048 + t * 256 + ch] = lb + oml * sg; QK[3072 + t * 256 + ch] = bf2f(ur[C_HI + ch]);
        }
    } else {
        const int ch = tid - 256; float xs[7], cw[4];
#pragma unroll
        for (int k = 0; k < 3; ++k) xs[k] = inptr(I_SLC)[((size_t)(l * NSQ + seq) * 3 + k) * 256 + ch];
#pragma unroll
        for (int t = 0; t < 4; ++t) xs[3 + t] = bf2f(U[(size_t)(row0 + t) * LDU + C_LX + ch]);
#pragma unroll
        for (int k = 0; k < 4; ++k) cw[k] = inptr(I_LCW)[(l * 4 + k) * 256 + ch];
        const float cb = inptr(I_LCB)[l * 256 + ch];
#pragma unroll
        for (int t = 0; t < 4; ++t) XCs[t * 256 + ch] = cw[0] * xs[t] + cw[1] * xs[t + 1] + cw[2] * xs[t + 2] + cw[3] * xs[t + 3] + cb;
#pragma unroll
        for (int k = 0; k < 3; ++k) outq(C)[O_LCS + ((size_t)(l * NSQ + seq) * 3 + k) * 256 + ch] = xs[4 + k];
    }
    __syncthreads();
    {
        const int hh = tid >> 7, dh = (tid >> 6) & 1, e = tid & 63;
        const size_t sbase = ((size_t)((l * NSQ + seq) * 4 + hh) * 64 + dh * 32) * 64 + e;
        float S[32];
#pragma unroll
        for (int i = 0; i < 32; ++i) S[i] = inptr(I_SHG)[sbase + (size_t)i * 64];
#pragma unroll
        for (int t = 0; t < 4; ++t) {
            const float v = QK[3072 + t * 256 + hh * 64 + e]; const int dd = hh * 64 + dh * 32;
            float part = 0.f;
#pragma unroll
            for (int i = 0; i < 32; ++i) { S[i] = QK[2048 + t * 256 + dd + i] * S[i] + QK[1024 + t * 256 + dd + i] * v; part += QK[t * 256 + dd + i] * S[i]; }
            REDh[((t * 4 + hh) * 2 + dh) * 64 + e] = part;
        }
#pragma unroll
        for (int i = 0; i < 32; ++i) outq(C)[O_HGS + sbase + (size_t)i * 64] = S[i];
    }
    __syncthreads();
#pragma unroll
    for (int rep = 0; rep < 2; ++rep) {
        const int id = tid + 512 * rep, t = id >> 8, hh = (id >> 6) & 3, e = id & 63;
        const float o = REDh[((t * 4 + hh) * 2) * 64 + e] + REDh[((t * 4 + hh) * 2 + 1) * 64 + e];
        const float rs = rsqrtf(wave_sum(o * o) * (1.f / 64.f) + EPS);
        const float hz = bf2f(U[(size_t)(row0 + t) * LDU + C_HZ + hh * 64 + e]);
        O[(size_t)(row0 + t) * DM + hh * 64 + e] = f2bfs(o * rs * inptr(I_HGN)[l * 64 + e] * siluf(hz));
    }
    if (tid < 256) {
        const int ch = tid, blk = ch >> 6, jl = ch & 63;
        float pa[4] = {0.f, 0.f, 0.f, 0.f}, px[4] = {0.f, 0.f, 0.f, 0.f};
        const float* wa = inptr(I_LWA) + (size_t)(l * 4 + blk) * 4096 + jl; const float* wx = inptr(I_LWX) + (size_t)(l * 4 + blk) * 4096 + jl;
#pragma unroll 32
        for (int i = 0; i < 64; ++i) {
            const float a = wa[i * 64], x = wx[i * 64];
#pragma unroll
            for (int t = 0; t < 4; ++t) { const float xc = XCs[t * 256 + blk * 64 + i]; pa[t] += xc * a; px[t] += xc * x; }
        }
        const float ba = inptr(I_LBA)[l * 256 + ch], bx = inptr(I_LBX)[l * 256 + ch], sp = softplusf(-inptr(I_LLAM)[l * 256 + ch]);
        float hcur = inptr(I_SLRU)[(size_t)(l * NSQ + seq) * 256 + ch];
#pragma unroll
        for (int t = 0; t < 4; ++t) {
            const float rr = sigm(pa[t] + ba), ii = sigm(px[t] + bx), la = -8.f * rr * sp;
            hcur = __expf(la) * hcur + sqrtf(fmaxf(0.f, -expm1f(2.f * la))) * ii * XCs[t * 256 + ch];
            const float lz = bf2f(U[(size_t)(row0 + t) * LDU + C_LZ + ch]);
            O[(size_t)(row0 + t) * DM + 768 + ch] = f2bfs(hcur * gelu_tanh(lz));
        }
        outq(C)[O_LRUS + (size_t)(l * NSQ + seq) * 256 + ch] = hcur;
    }
    __syncthreads();
}

template <int XM>
__device__ __forceinline__ void side_gemm_res(Ctx& C, const bf16* A, const bf16* Bt, int K, const float* xin, const bf16* XRin, bf16* XRout, const float* gvec, const float* scn, const float* gamma, bf16* XS, float* rss) {
    int tid_ = threadIdx.x; asm volatile("" : "+v"(tid_)); const int tid = tid_, lane = tid & 63, w = __builtin_amdgcn_readfirstlane(tid >> 6), g = lane >> 4, c = lane & 15;
    int bx_ = (int)blockIdx.x; asm volatile("" : "+s"(bx_));
    const int rb = bx_ >> 4, cb = bx_ & 15, rt = w >> 2, ct = w & 3;
    if (bx_ >= 256) return;
    const int row = rb * 32 + rt * 16 + c;
    LAS unsigned char* lds = ldsq(C);
    const int nch = K >> 7;
    const unsigned char* abase = (const unsigned char*)(A + (size_t)(rb * 32) * K); const unsigned char* bbase = (const unsigned char*)(Bt + (size_t)(cb * 64) * K);
    const int rA = tid >> 4, psA = tid & 15, qA = psA ^ (rA & 15);
    const int rB1 = (tid + 512) >> 4;
#define SIDE_ISSUE(ch, bufi) do { LAS unsigned char* d_ = lds + (bufi) * 24576; const size_t ko_ = (size_t)(ch) * 256; \
        glds16(abase + (size_t)rA * K * 2 + ko_ + qA * 16, d_ + w * 1024); \
        glds16(bbase + (size_t)rA * K * 2 + ko_ + qA * 16, d_ + 8192 + w * 1024); \
        glds16(bbase + (size_t)rB1 * K * 2 + ko_ + (psA ^ (rB1 & 15)) * 16, d_ + 8192 + 8192 + w * 1024); } while (0)
    const int xa = c * 256 + (((c & 12) + (g ^ (c & 3))) << 4);
    f32x4 acc0 = (f32x4){0.f, 0.f, 0.f, 0.f}, acc1 = acc0;
    SIDE_ISSUE(0, 0); SIDE_ISSUE(1, 1);
    int bcur = 0;
    for (int ch = 0; ch < nch; ++ch) {
        if (ch + 1 < nch) asm volatile("s_waitcnt vmcnt(3)" ::: "memory"); else asm volatile("s_waitcnt vmcnt(0)" ::: "memory");
        __syncthreads();
        { const int bnx = bcur == 0 ? 2 : bcur - 1; if (ch + 2 < nch) SIDE_ISSUE(ch + 2, bnx); }
        const LAS unsigned char* bfr = lds + bcur * 24576;
        bcur = bcur == 2 ? 0 : bcur + 1;
        bf16x8 fa[4], fb[4];
#pragma unroll
        for (int s = 0; s < 4; ++s) { fa[s] = *(const LAS bf16x8*)(bfr + rt * 4096 + (xa ^ (s << 6))); fb[s] = *(const LAS bf16x8*)(bfr + 8192 + ct * 4096 + (xa ^ (s << 6))); }
        acc0 = mfma16(fb[0], fa[0], acc0); acc1 = mfma16(fb[1], fa[1], acc1); acc0 = mfma16(fb[2], fa[2], acc0); acc1 = mfma16(fb[3], fa[3], acc1);
    }
#undef SIDE_ISSUE
    __syncthreads();
    const f32x4 acc = acc0 + acc1;
    const int col = cb * 64 + ct * 16 + 4 * g, grow = MP + row, s = NBP + (row >> 2);
    f32x4 x0;
    if (XM == 0) x0 = *(const f32x4*)(xin + (size_t)row * DM + col);
    else { const u32x2 r = *(const u32x2*)(XRin + (size_t)grow * DM + col); x0 = (f32x4){bflo(r.x), bfhi(r.x), bflo(r.y), bfhi(r.y)}; }
    const f32x4 xn = x0 + *(const f32x4*)(gvec + (size_t)s * 6144 + col) * acc;
    { u32x2 wq; wq.x = pk2(xn.x, xn.y); wq.y = pk2(xn.z, xn.w); *(u32x2*)(XRout + (size_t)grow * DM + col) = wq; }
    if (scn) { const f32x4 v = xn * *(const f32x4*)(gamma + col) * (*(const f32x4*)(scn + (size_t)s * 6144 + col) + 1.f);
        u32x2 wv; wv.x = pk2(v.x, v.y); wv.y = pk2(v.z, v.w); *(u32x2*)(XS + (size_t)grow * DM + col) = wv; }
    float ss = (xn.x * xn.x + xn.y * xn.y) + (xn.z * xn.z + xn.w * xn.w);
    ss += __shfl_xor(ss, 16); ss += __shfl_xor(ss, 32);
    LAS float* red = (LAS float*)(ldsq(C));
    if (g == 0) red[(rt * 16 + c) * 4 + ct] = ss;
    __syncthreads();
    if (tid < 32) { const f32x4 p = *(const LAS f32x4*)(red + tid * 4); rss[(size_t)(MP + rb * 32 + tid) * 16 + cb] = (p.x + p.y) + (p.z + p.w); }
    __syncthreads();
}

__device__ __forceinline__ void adaln_fused(Ctx& C) {
    int tid_ = threadIdx.x; asm volatile("" : "+v"(tid_)); const int tid = tid_, lane = tid & 63, w = __builtin_amdgcn_readfirstlane(tid >> 6), g = lane >> 4, c = lane & 15;
    int bx_ = (int)blockIdx.x; asm volatile("" : "+s"(bx_));
    if (bx_ >= 256) return;
    LAS unsigned char* lds = ldsq(C);
    constexpr int BUFB = 49152;
    const int col0 = 48 * bx_, l = col0 / 6144, cl0 = col0 - l * 6144;
    const float* W = inptr(I_WADA) + (size_t)l * DM * 6144 + cl0;
    const float* cp = inptr(I_CP); const float* cs = inptr(I_CS);
    for (int i = tid; i < 2 * 8 * 16; i += NTHR) { const int bufi = i >> 7, r = 136 + ((i >> 4) & 7), sl = i & 15; *(LAS v4u*)(lds + bufi * BUFB + r * 256 + sl * 16) = (v4u){0u, 0u, 0u, 0u}; }
    f32x4 ra[2][9], rb[2][3];
#define AD_LOAD(kc, S) do { _Pragma("unroll") for (int i_ = 0; i_ < 9; ++i_) { const int idx_ = tid + 512 * i_; if (idx_ < 4352) { const int r_ = idx_ >> 5, k4_ = idx_ & 31; \
            ra[S][i_] = *(const f32x4*)((r_ < NBP ? cp + (size_t)r_ * DM : cs + (size_t)(r_ - NBP) * DM) + (kc) * 128 + 4 * k4_); } } \
        _Pragma("unroll") for (int i_ = 0; i_ < 3; ++i_) { const int idx_ = tid + 512 * i_; const int kk_ = idx_ / 12, j4_ = idx_ - kk_ * 12; rb[S][i_] = *(const f32x4*)(W + (size_t)((kc) * 128 + kk_) * 6144 + 4 * j4_); } } while (0)
#define AD_STORE(bufi, S) do { LAS unsigned char* d_ = lds + (bufi) * BUFB; \
        _Pragma("unroll") for (int i_ = 0; i_ < 9; ++i_) { const int idx_ = tid + 512 * i_; if (idx_ < 4352) { const int r_ = idx_ >> 5, k4_ = idx_ & 31; \
            u32x2 w_; w_.x = pk2(siluf(ra[S][i_].x), siluf(ra[S][i_].y)); w_.y = pk2(siluf(ra[S][i_].z), siluf(ra[S][i_].w)); *(LAS u32x2*)(d_ + r_ * 256 + (((k4_ >> 1) ^ (r_ & 15)) << 4) + (k4_ & 1) * 8) = w_; } } \
        _Pragma("unroll") for (int i_ = 0; i_ < 3; ++i_) { const int idx_ = tid + 512 * i_; const int kk_ = idx_ / 12, j4_ = idx_ - kk_ * 12; const float v_[4] = {rb[S][i_].x, rb[S][i_].y, rb[S][i_].z, rb[S][i_].w}; \
            _Pragma("unroll") for (int jj_ = 0; jj_ < 4; ++jj_) { const int j_ = 4 * j4_ + jj_; *(LAS unsigned short*)(d_ + 36864 + j_ * 256 + (((kk_ >> 3) ^ (j_ & 15)) << 4) + (kk_ & 7) * 2) = f2bfs(v_[jj_]); } } } while (0)
    const int xa = c * 256 + (((c & 12) + (g ^ (c & 3))) << 4);
    f32x4 acc[2][3];
#pragma unroll
    for (int a = 0; a < 2; ++a)
#pragma unroll
        for (int n = 0; n < 3; ++n) acc[a][n] = (f32x4){0.f, 0.f, 0.f, 0.f};
    AD_LOAD(0, 0); AD_LOAD(1, 1); AD_STORE(0, 0);
    __syncthreads();
#pragma unroll
    for (int kc = 0; kc < 8; ++kc) {
        if (kc + 2 < 8) AD_LOAD(kc + 2, kc & 1);
        const LAS unsigned char* bfr = lds + (kc & 1) * BUFB;
#pragma unroll
        for (int s = 0; s < 4; ++s) {
            bf16x8 fb[3];
#pragma unroll
            for (int n = 0; n < 3; ++n) fb[n] = *(const LAS bf16x8*)(bfr + 36864 + n * 4096 + (xa ^ (s << 6)));
            const bf16x8 fa0 = *(const LAS bf16x8*)(bfr + w * 4096 + (xa ^ (s << 6)));
#pragma unroll
            for (int n = 0; n < 3; ++n) acc[0][n] = mfma16(fb[n], fa0, acc[0][n]);
            if (w == 0) { const bf16x8 fa1 = *(const LAS bf16x8*)(bfr + 8 * 4096 + (xa ^ (s << 6)));
#pragma unroll
                for (int n = 0; n < 3; ++n) acc[1][n] = mfma16(fb[n], fa1, acc[1][n]); }
        }
        if (kc + 1 < 8) AD_STORE((kc + 1) & 1, (kc + 1) & 1);
        __syncthreads();
    }
#undef AD_LOAD
#undef AD_STORE
    float* modp = (float*)(wsq(C) + WS_MOD); bf16* ash = (bf16*)(wsq(C) + WS_ASH); const float* bias = inptr(I_BADA);
#pragma unroll
    for (int a = 0; a < 2; ++a) {
        const int row = 16 * (a ? 8 : w) + c;
        if ((a == 0 || w == 0) && row < NSEQ) {
#pragma unroll
            for (int n = 0; n < 3; ++n) {
                const int col = col0 + 16 * n + 4 * g, cl = col - l * 6144, chunk = cl >> 10;
                const f32x4 v = acc[a][n] + *(const f32x4*)(bias + col);
                *(f32x4*)(modp + ((size_t)l * NSEQ + row) * 6144 + cl) = v;
                if (chunk == 0 || chunk == 3) { u32x2 wv; wv.x = pk2(v.x, v.y); wv.y = pk2(v.z, v.w); *(u32x2*)(ash + ((size_t)(2 * l + (chunk == 3)) * 256 + row) * DM + (cl & 1023)) = wv; }
            }
        }
    }
    __syncthreads();
}

__device__ __forceinline__ void cvec_units(Ctx& C, int r, int ashi, int ashi2, bool do1, bool dogu) {
    const bf16* ash = (const bf16*)(wsq(C) + WS_ASH) + (size_t)ashi * 256 * DM; const bf16* ash2 = (const bf16*)(wsq(C) + WS_ASH) + (size_t)ashi2 * 256 * DM;
    if (do1) {
        OneUnit S{(r >= 0 && r < 15) ? r : -1};
        pg8::Gemm g{ash, (const bf16*)(wsq(C) + WS_WIN), 256, LDU, DM};
        EpiModCvec E{(float*)(wsq(C) + WS_CV1), LDU, nullptr, NSEQ, 0, nullptr};
        pg8::gemm_phase<EpiModCvec, OneUnit, false, true>(ldsq(C), g, S, E);
    }
    if (dogu) {
        const int r2 = do1 ? r - 15 : r;
        { OneUnit S{(r2 >= 0 && r2 < 11) ? r2 : -1};
          pg8::Gemm g{ash2, (const bf16*)(wsq(C) + WS_WG), 256, DFF, DM};
          EpiModCvec E{(float*)(wsq(C) + WS_CVG), DFF, nullptr, NSEQ, 0, nullptr};
          pg8::gemm_phase<EpiModCvec, OneUnit, false, true>(ldsq(C), g, S, E); }
        { OneUnit S{(r2 >= 11 && r2 < 22) ? r2 - 11 : -1};
          pg8::Gemm g{ash2, (const bf16*)(wsq(C) + WS_WU), 256, DFF, DM};
          EpiModCvec E{(float*)(wsq(C) + WS_CVU), DFF, nullptr, NSEQ, 0, nullptr};
          pg8::gemm_phase<EpiModCvec, OneUnit, false, true>(ldsq(C), g, S, E); }
    }
}
constexpr int CW_QHEAD = 12288 + 256;
constexpr int Q_PREP = 1024, Q_LRU1 = Q_PREP + 256, Q_DEC = Q_LRU1 + 256, Q_CONV = Q_DEC + 64, Q_LRU3 = Q_CONV + 256;
__device__ __forceinline__ void phase_m12(Ctx& C, int l) {
    int v_ = (int)blockIdx.x; asm volatile("" : "+s"(v_)); const int v = v_;
    unsigned* gcnt = (unsigned*)((gu32*)(wsq(C) + WS_CTL) + CW_GCNT + l * 32 * 64);
    unsigned* lcnt = (unsigned*)((gu32*)(wsq(C) + WS_CTL) + CW_LCNT + l * 64);
    unsigned* qhead = (unsigned*)((gu32*)(wsq(C) + WS_CTL) + CW_QHEAD + l * 64);
    if (v < 32) gdn_chain(C, l, v >> 2, v & 3);
    else if (v < 64) { const int r = v - 32; hgrn_chain(C, l, r >> 2, r & 3); }
    LAS unsigned* qslot = (LAS unsigned*)(ldsq(C) + MISC_OFF + 96);
    bool lru_ok = false;
    unsigned* pend = nullptr;
    unsigned nxt = 0u;
    if (threadIdx.x == 0) nxt = __hip_atomic_fetch_add(qhead, 1u, __ATOMIC_RELAXED, __HIP_MEMORY_SCOPE_AGENT);
    for (;;) {
        __syncthreads();
        if (threadIdx.x == 0) *qslot = nxt;
        __syncthreads();
        const int j = (int)*qslot;
        const bool look = j < Q_PREP;
        if (threadIdx.x == 0 && look) nxt = __hip_atomic_fetch_add(qhead, 1u, __ATOMIC_RELAXED, __HIP_MEMORY_SCOPE_AGENT);
        if (j >= Q_PREP && pend) { publish_add(pend); pend = nullptr; }
        if (j >= Q_LRU3) break;
        if (j < Q_PREP) { const int n = j >> 5, bh = j & 31; gdn_prep_item(C, l, bh >> 2, bh & 3, n, pend); pend = gcnt + 64 * n; }
        else if (j < Q_LRU1) { const int it = j - Q_PREP; lru_pass1_item(C, l, it >> 5, it & 31, lcnt); }
        else if (j < Q_DEC) { const int it = j - Q_LRU1; if (it < 128) gdn_dec4_item(C, l, it); else hl_dec_item(C, l, it - 128); }
        else if (j < Q_CONV) {
            const int gw = (j - Q_DEC) * NWAVES + C.wave, ngw = 64 * NWAVES; int base = 0;
            tr_job(C, inptr(I_WOUT) + (size_t)l * DM * DM, (bf16*)(wsq(C) + WS_WOUT), DM, DM, 0, DM, gw, ngw, base);
            tr_job(C, inptr(I_WD) + (size_t)l * DFF * DM, (bf16*)(wsq(C) + WS_WD), DM, DFF, 0, DM, gw, ngw, base);
            if (l == 0) tr_job(C, inptr(I_WIN) + (size_t)DM * 3592, (bf16*)(wsq(C) + WS_WIN), 3592, DM, 1, LDU, gw, ngw, base);
        } else {
            if (!lru_ok) { if (threadIdx.x == 0) poll_acquire(lcnt, 256u); __syncthreads(); lru_ok = true; }
            const int it = j - Q_CONV; lru_pass3_item(C, l, it >> 5, it & 31);
        }
        if (threadIdx.x == 0 && !look) nxt = __hip_atomic_fetch_add(qhead, 1u, __ATOMIC_RELAXED, __HIP_MEMORY_SCOPE_AGENT);
    }
}

#ifndef MK_PER_PHASE
#define MK_PER_PHASE 0
#endif
constexpr int NPHASE = 18;
struct Args { const float* in[N_IN]; float* out; unsigned char* ws; int ph_lo, ph_hi; };
static_assert(sizeof(Args) == N_IN * 8 + 24, "Args has no padding");
__global__ void __launch_bounds__(NTHR, 2) mega_fwd(Args args) {
    extern __shared__ __attribute__((aligned(16))) unsigned char lds_raw[];
    Ctx C;
    C.lds_ = (LAS unsigned char*)lds_raw;
    C.wave = __builtin_amdgcn_readfirstlane((int)threadIdx.x >> 6);
    C.G = gridDim.x; { const int bx = blockIdx.x; C.vcu = (bx & 7) * (C.G >> 3) + (bx >> 3); }
    C.out_ = args.out; C.ws_ = args.ws;
    for (int u = threadIdx.x; u < (LDS_BYTES - LDSCTL_OFF) / 4; u += NTHR) ((LAS unsigned*)(ldsq(C) + LDSCTL_OFF))[u] = 0u;
    __syncthreads();
#if MK_PER_PHASE
    const int lo = args.ph_lo, hi = args.ph_hi;
#else
    constexpr int lo = 0, hi = NPHASE;
#endif
    if (hi - lo > 1) (void)xcd_barrier_post((unsigned*)((gu32*)(wsq(C) + WS_CTL) + CW_BAR), (volatile LAS unsigned*)(size_t)(MISC_OFF + 32));
#ifndef PROBE_MASK
#define PROBE_MASK 0u
#endif
#define PRB ((volatile LAS unsigned long long*)(ldsq(C) + MISC_OFF + 64))
#ifndef PROBE_PRE
#define PROBE_PRE 0
#endif
#define prb_thr ((PROBE_MASK != 0u || PROBE_REGION != 0) && C.vcu == PROBE_VCU && threadIdx.x == 0)
#define PH_BEGIN(k) do { if (prb_thr && ((PROBE_MASK >> (k)) & 1u)) PRB[0] = __builtin_amdgcn_s_memrealtime(); } while (0)
#define PH_END_(k) do { if (prb_thr && ((PROBE_MASK >> (k)) & 1u)) PRB[1] = PRB[1] + (__builtin_amdgcn_s_memrealtime() - PRB[0]); } while (0)
#define PH_END(k) do { if (!PROBE_PRE) PH_END_(k); } while (0)
#define PH_PRE(k) do { if (PROBE_PRE) PH_END_(k); } while (0)
#define IN(k) (lo <= (k) && (k) < hi)
#define SEAM(k) do { if (IN(k) && IN((k) + 1)) { XcdBarrier b2_; b2_.bar = (unsigned*)((gu32*)(wsq(C) + WS_CTL) + CW_BAR); b2_.x = xb_xcc_id(); b2_.st = (volatile LAS unsigned*)(size_t)(MISC_OFF + 32); xcd_barrier(b2_); } } while (0)
#define MODP ((const float*)(wsq(C) + WS_MOD))
#define RSSP ((float*)(wsq(C) + WS_RSS))
#define XSb ((bf16*)(wsq(C) + WS_XS))
#define Ub ((bf16*)(wsq(C) + WS_U))
#define Ob ((bf16*)(wsq(C) + WS_O))
#define GPb ((bf16*)(wsq(C) + WS_GP))
#define ACTb ((bf16*)(wsq(C) + WS_ACT))

    PH_BEGIN(0);
    if (IN(0)) {
        adaln_fused(C);
        const int gw = C.vcu * NWAVES + C.wave, ngw = C.G * NWAVES; int base = 0;
        tr_job(C, inptr(I_WIN), (bf16*)(wsq(C) + WS_WIN), 3592, DM, 1, LDU, gw, ngw, base);
        tr_job(C, inptr(I_WG), (bf16*)(wsq(C) + WS_WG), DFF, DM, 0, DFF, gw, ngw, base);
        tr_job(C, inptr(I_WU), (bf16*)(wsq(C) + WS_WU), DFF, DM, 0, DFF, gw, ngw, base);
    }
    PH_END(0); PH_BEGIN(1);
    SEAM(1);
    PH_END(1); PH_BEGIN(2);
    if (IN(2)) {
        if (C.vcu < 37) cvec_units(C, C.vcu, 0, 1, true, true);
        else x_to_xs(C, (C.vcu - 37) * NWAVES + C.wave, (C.G - 37) * NWAVES);
    }
    SEAM(2);
    PH_END(2);
#pragma unroll 1
    for (int l = 0; l < 2; ++l) {
        const int p = 3 + 7 * l;
        PH_BEGIN(p);
        if (IN(p)) {
            pg8::Gemm g{XSb, (const bf16*)(wsq(C) + WS_WIN), MROWS, LDU, DM};
            typedef pg8::StaticOrder<MROWS, LDU, 0> SO; SO S; S.init(C.G, bxq());
            EpiU E{Ub, RSSP, (const float*)(wsq(C) + WS_CV1), LDU, LDU};
            pg8::gemm_phase<EpiU, SO, true, true>(ldsq(C), g, S, E);
            if (l == 1) cvec_units(C, bxq() - 222, 3, 3, false, true);
        }
        SEAM(p);
        PH_END(p); PH_BEGIN(p + 1);
        if (IN(p + 1)) phase_m12(C, l);
        PH_PRE(p + 1);
        SEAM(p + 1);
        PH_END(p + 1); PH_BEGIN(p + 2);
        PH_PRE(p + 2);
        PH_END(p + 2); PH_BEGIN(p + 3);
        if (IN(p + 3)) {
            pg8::Gemm g{Ob, (const bf16*)(wsq(C) + WS_WOUT), MP, DM, DM};
            typedef pg8::StaticOrder<MP, DM> SO; SO S; S.init(C.G, bxq());
            const float* modl = MODP + (size_t)l * NSEQ * 6144;
            bf16* xrb = (bf16*)(wsq(C) + WS_XR); const bf16* ybb = (const bf16*)outq(C);
            if (l == 0) {
                EpiRes<0> E{inptr(I_XP), nullptr, xrb, modl + 2048, modl + 4096, inptr(I_NFFN), XSb, RSSP};
                pg8::gemm_phase<EpiRes<0>, SO, true, true>(ldsq(C), g, S, E);
                side_gemm_res<0>(C, Ob + (size_t)MP * DM, (const bf16*)(wsq(C) + WS_WOUT), DM, inptr(I_XS), nullptr, xrb, modl + 2048, modl + 4096, inptr(I_NFFN), XSb, RSSP);
            } else {
                EpiRes<1> E{nullptr, ybb, xrb, modl + 2048, modl + 4096, inptr(I_NFFN) + DM, XSb, RSSP};
                pg8::gemm_phase<EpiRes<1>, SO, true, true>(ldsq(C), g, S, E);
                side_gemm_res<1>(C, Ob + (size_t)MP * DM, (const bf16*)(wsq(C) + WS_WOUT), DM, nullptr, ybb, xrb, modl + 2048, modl + 4096, inptr(I_NFFN) + DM, XSb, RSSP);
            }
        }
        SEAM(p + 3);
        PH_END(p + 3); PH_BEGIN(p + 4);
        if (IN(p + 4)) {
            pg8::Gemm g{XSb, (const bf16*)(wsq(C) + WS_WG), MROWS, DFF, DM};
            typedef pg8::StaticOrder<MROWS, DFF, 2 * (DFF / 256)> SO; SO S; S.init(C.G, bxq());
            EpiGate E{GPb, RSSP, (const float*)(wsq(C) + WS_CVG), outq(C) + O_FCP + (size_t)l * NBP * 2 * DFF, outq(C) + O_FCS + (size_t)l * NSQ * 2 * DFF};
            pg8::gemm_phase<EpiGate, SO, true, true>(ldsq(C), g, S, E);
            if (l == 0) cvec_units(C, bxq() - 214, 2, 2, true, false);
        }
        SEAM(p + 4);
        PH_END(p + 4); PH_BEGIN(p + 5);
        if (IN(p + 5)) {
            pg8::Gemm g{XSb, (const bf16*)(wsq(C) + WS_WU), MROWS, DFF, DM};
            typedef pg8::StaticOrder<MROWS, DFF, 2 * (DFF / 256)> SO; SO S; S.init(C.G, bxq());
            EpiUp E{ACTb, GPb, RSSP, (const float*)(wsq(C) + WS_CVU), inptr(I_FCW) + (size_t)l * 3 * DFF, inptr(I_FCB) + (size_t)l * DFF, inptr(I_SFC) + (size_t)l * NSQ * 2 * DFF};
            pg8::gemm_phase<EpiUp, SO, true, true>(ldsq(C), g, S, E);
        }
        SEAM(p + 5);
        PH_END(p + 5); PH_BEGIN(p + 6);
        if (IN(p + 6)) {
            pg8::Gemm g{ACTb, (const bf16*)(wsq(C) + WS_WD), MP, DM, DFF};
            typedef pg8::StaticOrder<MP, DM> SO; SO S; S.init(C.G, bxq());
            const float* modl = MODP + (size_t)l * NSEQ * 6144; const float* mod1 = MODP + (size_t)NSEQ * 6144;
            bf16* xrb = (bf16*)(wsq(C) + WS_XR); bf16* ybb = (bf16*)outq(C);
            {
                EpiRes<1> E{nullptr, xrb, l == 0 ? ybb : xrb, modl + 5120, l == 0 ? mod1 + 1024 : nullptr, inptr(I_NMIX) + DM, XSb, RSSP};
                const int sfirst = (bxq() >> 3) & 1;
#pragma unroll 1
                for (int pass = 0; pass < 2; ++pass) {
                    if ((pass ^ sfirst) == 0) pg8::gemm_phase<EpiRes<1>, SO, true, true>(ldsq(C), g, S, E);
                    else side_gemm_res<1>(C, ACTb + (size_t)MP * DFF, (const bf16*)(wsq(C) + WS_WD), DFF, nullptr, xrb, l == 0 ? ybb : xrb, modl + 5120, l == 0 ? mod1 + 1024 : nullptr, inptr(I_NMIX) + DM, XSb, RSSP);
                }
            }
            if (l == 0) {
                const int gw = C.vcu * NWAVES + C.wave, ngw = C.G * NWAVES; int base = 0;
                tr_job(C, inptr(I_WG) + (size_t)DM * DFF, (bf16*)(wsq(C) + WS_WG), DFF, DM, 0, DFF, gw, ngw, base);
                tr_job(C, inptr(I_WU) + (size_t)DM * DFF, (bf16*)(wsq(C) + WS_WU), DFF, DM, 0, DFF, gw, ngw, base);
            }
        }
        SEAM(p + 6);
        PH_END(p + 6);
    }
    PH_BEGIN(17);
    if (IN(17)) phase_final(C);
    PH_END(17);
    if (prb_thr) { const unsigned long long tgt = __builtin_amdgcn_s_memrealtime() + 4ull * PRB[1]; while (__builtin_amdgcn_s_memrealtime() < tgt) __builtin_amdgcn_s_sleep(8); }
#undef IN
#undef SEAM
}

#ifndef MK_PER_PHASE
#define MK_PER_PHASE 0
#endif
extern "C" void kernel_launch(void* const* d_in, const int* in_sizes, int n_in, void* d_out, int out_size, void* d_ws, size_t ws_size, hipStream_t stream) {
    static int grid = 0;
    if (grid == 0) {
        int dev = 0, cus = 0;
        if (n_in != N_IN || (size_t)out_size != O_END || ws_size < WS_END) { fprintf(stderr, "kernel_launch: unexpected problem (n_in %d, out %d, ws %zu)\n", n_in, out_size, ws_size); grid = -1; return; }
        if (hipGetDevice(&dev) != hipSuccess || hipDeviceGetAttribute(&cus, hipDeviceAttributeMultiprocessorCount, dev) != hipSuccess) { grid = -1; return; }
        if (hipFuncSetAttribute((const void*)mega_fwd, hipFuncAttributeMaxDynamicSharedMemorySize, LDS_BYTES) != hipSuccess) { fprintf(stderr, "kernel_launch: hipFuncSetAttribute failed\n"); grid = -1; return; }
        int per_cu = 0;
        if (hipOccupancyMaxActiveBlocksPerMultiprocessor(&per_cu, (const void*)mega_fwd, NTHR, LDS_BYTES) != hipSuccess || per_cu < 1) fprintf(stderr, "kernel_launch: occupancy query says %d blocks per CU\n", per_cu);
        (void)hipGetLastError();
        grid = cus & ~7;
    }
    if (grid < 0) return;
    (void)hipMemsetAsync((char*)d_ws + WS_CTL, 0, CTL_ZERO_BYTES, stream);
    Args a{};
    for (int i = 0; i < N_IN; ++i) a.in[i] = (const float*)d_in[i];
    a.out = (float*)d_out; a.ws = (unsigned char*)d_ws;
#if MK_PER_PHASE
    for (int p = 0; p < NPHASE; ++p) { a.ph_lo = p; a.ph_hi = p + 1; hipLaunchKernelGGL(mega_fwd, dim3(grid), dim3(NTHR), LDS_BYTES, stream, a); }
#else
    a.ph_lo = 0; a.ph_hi = NPHASE;
    hipLaunchKernelGGL(mega_fwd, dim3(grid), dim3(NTHR), LDS_BYTES, stream, a);
#endif
}
```
